# Optimizing an MI355X kernel written in HIP

```python
import jax, jax.numpy as jnp
from jax import lax
import numpy as np

D_MODEL = 1024
BATCH = 4
SEQ = 8192
DEPTH = 4

HEAD_DIM = 64
N_HEADS_A = 8
N_HEADS_B = 8
IDX_HEADS = 4
IDX_DIM = 64
TOPK_MAX = 256
BLOCK_Q = 128
CHUNK = 128
C_WIDTH = 2048
C_GROUPS = 16
D_FF = 2816
EPS = 1e-6
N_EVEN = (DEPTH + 1) // 2
N_ODD = DEPTH // 2
EVEN_WIDTHS = (N_HEADS_A * HEAD_DIM, HEAD_DIM, HEAD_DIM, IDX_HEADS * IDX_DIM, IDX_DIM, IDX_HEADS,
               N_HEADS_B * HEAD_DIM, N_HEADS_B * HEAD_DIM, N_HEADS_B * HEAD_DIM)
EVEN_IN = sum(EVEN_WIDTHS)
EVEN_MIX = (N_HEADS_A + N_HEADS_B) * HEAD_DIM

kernel_name = "hybrid_dsa_stickbreak_gmlp_trunk"


def rms_norm(x, g):
    xf = x.astype(jnp.float32)
    y = xf * lax.rsqrt(jnp.mean(xf * xf, axis=-1, keepdims=True) + EPS)
    return (y * g.astype(jnp.float32)).astype(x.dtype)


def layer_norm(x, g, b):
    xf = x.astype(jnp.float32)
    mu = jnp.mean(xf, axis=-1, keepdims=True)
    var = jnp.mean(jnp.square(xf - mu), axis=-1, keepdims=True)
    y = (xf - mu) * lax.rsqrt(var + EPS)
    return (y * g.astype(jnp.float32) + b.astype(jnp.float32)).astype(x.dtype)


def to_blocks(a, blk):
    b, s = a.shape[:2]
    return jnp.moveaxis(a.reshape(b, s // blk, blk, *a.shape[2:]), 1, 0)


def from_blocks(a):
    a = jnp.moveaxis(a, 0, 1)
    return a.reshape(a.shape[0], a.shape[1] * a.shape[2], *a.shape[3:])


def dsa_attention(q, k, v, qi, ki, wi):
    s_len = k.shape[1]
    topk = min(TOPK_MAX, s_len // 4)
    key_pos = jnp.arange(s_len, dtype=jnp.int32)
    gather = jax.vmap(lambda table, idx: table[idx])

    def block(args):
        qb, qib, wib, start = args
        qpos = start + jnp.arange(BLOCK_Q, dtype=jnp.int32)
        causal = key_pos[None, :] <= qpos[:, None]
        dots = jnp.einsum('bqhd,bsd->bqhs', qib, ki).astype(jnp.float32) * (IDX_DIM ** -0.5)
        score = jnp.einsum('bqh,bqhs->bqs', wib.astype(jnp.float32), jax.nn.relu(dots))
        score = jnp.where(causal[None], score, -jnp.inf)
        _, idx = lax.top_k(score, topk)
        valid = idx <= qpos[None, :, None]
        k_sel = gather(k, idx)
        v_sel = gather(v, idx)
        logits = jnp.einsum('bqhd,bqkd->bhqk', qb, k_sel).astype(jnp.float32) * (HEAD_DIM ** -0.5)
        logits = jnp.where(valid[:, None], logits, -jnp.inf)
        p = jax.nn.softmax(logits, axis=-1).astype(v.dtype)
        return jnp.einsum('bhqk,bqkd->bqhd', p, v_sel)

    starts = jnp.arange(s_len // BLOCK_Q, dtype=jnp.int32) * BLOCK_Q
    out = lax.map(block, (to_blocks(q, BLOCK_Q), to_blocks(qi, BLOCK_Q), to_blocks(wi, BLOCK_Q), starts))
    return from_blocks(out)


def stick_breaking_attention(q, k, v):
    s_len = k.shape[1]
    key_pos = jnp.arange(s_len, dtype=jnp.int32)

    def block(args):
        qb, start = args
        qpos = start + jnp.arange(BLOCK_Q, dtype=jnp.int32)
        strict = (key_pos[None, :] < qpos[:, None])[None, None]
        z = jnp.einsum('bqhd,bshd->bhqs', qb, k).astype(jnp.float32) * (HEAD_DIM ** -0.5)
        log_fail = jnp.where(strict, jax.nn.log_sigmoid(-z), 0.0)
        after = lax.cumsum(log_fail, axis=3, reverse=True) - log_fail
        a = jnp.where(strict, jnp.exp(jax.nn.log_sigmoid(z) + after), 0.0)
        return jnp.einsum('bhqs,bshd->bqhd', a.astype(v.dtype), v)

    starts = jnp.arange(s_len // BLOCK_Q, dtype=jnp.int32) * BLOCK_Q
    out = lax.map(block, (to_blocks(q, BLOCK_Q), starts))
    return from_blocks(out)


def spatial_gating(h, w_in, w_s, b_s, g_v, b_v, w_out):
    b, s_len, _ = h.shape
    z = jax.nn.gelu(h @ w_in)
    u, v = jnp.split(z, 2, axis=-1)
    v = layer_norm(v, g_v, b_v)
    v = v.reshape(b, s_len // CHUNK, CHUNK, C_GROUPS, C_WIDTH // C_GROUPS)
    w = w_s * jnp.tril(jnp.ones((CHUNK, CHUNK), w_s.dtype))
    sv = jnp.einsum('gts,bnsgc->bntgc', w, v) + b_s.T[None, None, :, :, None]
    return (u * sv.reshape(b, s_len, C_WIDTH)) @ w_out


def swiglu(h, w_in, w_out):
    gate, up = jnp.split(h @ w_in, 2, axis=-1)
    return (jax.nn.silu(gate) * up) @ w_out


def setup_inputs(seed: int = 0) -> dict:
    key = jax.random.key(seed)
    ks = jax.random.split(key, 14)
    f32 = jnp.float32
    nrm = lambda k, shape, fan_in: jax.random.normal(k, shape, f32) * (fan_in ** -0.5)
    return {
        "x": jax.random.normal(ks[0], (BATCH, SEQ, D_MODEL), f32),
        "norm_gains": 1.0 + 0.02 * jax.random.normal(ks[1], (DEPTH, 4, D_MODEL), f32),
        "w_in_even": nrm(ks[2], (N_EVEN, D_MODEL, EVEN_IN), D_MODEL),
        "w_out_even": nrm(ks[3], (N_EVEN, EVEN_MIX, D_MODEL), EVEN_MIX),
        "w_in_odd": nrm(ks[4], (N_ODD, D_MODEL, 2 * C_WIDTH), D_MODEL),
        "spatial_w": nrm(ks[5], (N_ODD, C_GROUPS, CHUNK, CHUNK), CHUNK),
        "spatial_b": 1.0 + 0.02 * jax.random.normal(ks[6], (N_ODD, C_GROUPS, CHUNK), f32),
        "v_norm_gain": 1.0 + 0.02 * jax.random.normal(ks[7], (N_ODD, C_WIDTH), f32),
        "v_norm_bias": 0.02 * jax.random.normal(ks[8], (N_ODD, C_WIDTH), f32),
        "w_out_odd": nrm(ks[9], (N_ODD, C_WIDTH, D_MODEL), C_WIDTH),
        "w_ffn_in": nrm(ks[10], (DEPTH, D_MODEL, 2 * D_FF), D_MODEL),
        "w_ffn_out": nrm(ks[11], (DEPTH, D_FF, D_MODEL), D_FF),
    }


def reference(x, norm_gains, w_in_even, w_out_even, w_in_odd, spatial_w, spatial_b,
              v_norm_gain, v_norm_bias, w_out_odd, w_ffn_in, w_ffn_out):
    b, s_len, _ = x.shape
    split_points = np.cumsum(EVEN_WIDTHS)[:-1].tolist()
    h = x
    for layer in range(DEPTH):
        g = norm_gains[layer]
        a = rms_norm(h, g[0])
        i = layer // 2
        if layer % 2 == 0:
            proj = a @ w_in_even[i]
            qa, ka, va, qi, ki, wi, qb, kb, vb = jnp.split(proj, split_points, axis=-1)
            ya = dsa_attention(qa.reshape(b, s_len, N_HEADS_A, HEAD_DIM), ka, va,
                               qi.reshape(b, s_len, IDX_HEADS, IDX_DIM), ki,
                               wi * (IDX_HEADS ** -0.5))
            yb = stick_breaking_attention(qb.reshape(b, s_len, N_HEADS_B, HEAD_DIM),
                                          kb.reshape(b, s_len, N_HEADS_B, HEAD_DIM),
                                          vb.reshape(b, s_len, N_HEADS_B, HEAD_DIM))
            y = jnp.concatenate([ya.reshape(b, s_len, -1), yb.reshape(b, s_len, -1)], axis=-1) @ w_out_even[i]
        else:
            y = spatial_gating(a, w_in_odd[i], spatial_w[i], spatial_b[i],
                               v_norm_gain[i], v_norm_bias[i], w_out_odd[i])
        h = h + rms_norm(y, g[1])
        f = swiglu(rms_norm(h, g[2]), w_ffn_in[layer], w_ffn_out[layer])
        h = h + rms_norm(f, g[3])
    return h
```

```cpp
#define DBG_DUMB_ATT 1
#include <hip/hip_runtime.h>
#include <cstdio>
#include <cstdint>
#include <cmath>
namespace pg8 {
#define PG8_LAS __attribute__((address_space(3)))
typedef unsigned short bf16_t;
typedef short bf16x8 __attribute__((ext_vector_type(8)));
typedef float f32x4 __attribute__((ext_vector_type(4)));
typedef unsigned u32x4 __attribute__((ext_vector_type(4)));
constexpr int BM = 256, BK = 64, HALF = 128, HTB = HALF * BK * 2  , STAGE_BYTES = 8 * HTB, NXCD = 8, WGM = 8;

__host__ __device__ __forceinline__ int lds_byte(int r, int c) { const int st = (r >> 4) * 2 + (c >> 5), rr = r & 15, cc = c & 31, ob = rr * 64 + cc * 2; return st * 1024 + (ob ^ (((ob >> 9) & 1) << 5)); }
__host__ __device__ __forceinline__ void stage_rc(int b, int& R, int& C) { const int st = b / 1024, sb = b % 1024, swz = sb ^ (((sb >> 9) & 1) << 5); R = (st >> 1) * 16 + swz / 64; C = (st & 1) * 32 + (swz % 64) / 2; }
__host__ __device__ __forceinline__ int perm32(int rho) { const int n = rho >> 4, i = rho & 15; return 8 * (i >> 2) + 4 * n + (i & 3); }

struct Unit { int pm, pn; };
struct Gemm { const bf16_t* A; const bf16_t* Bt; int M, N, K; };

struct StaticOrder {
    int nM, nN, nwg, G, c;
    __host__ __device__ void init(int M, int N, int G_, int c_) { nM = M / BM; nN = N / BM; nwg = nM * nN; G = G_; c = c_; }
    __host__ __device__ bool next(int i, Unit& u) const {
        const long L = (long)i * G + c; if (L >= nwg) return false;
        int wgid = (int)L; { const int q = nwg / NXCD, r = nwg % NXCD, xcd = wgid % NXCD, off = wgid / NXCD; wgid = (xcd < r ? xcd * (q + 1) : r * (q + 1) + (xcd - r) * q) + off; }
        const int nig = WGM * nN, gid = wgid / nig, fm = gid * WGM, gsz = (nM - fm) < WGM ? (nM - fm) : WGM;
        u.pm = fm + ((wgid % nig) % gsz); u.pn = (wgid % nig) / gsz; return true;
    }
    __device__ __forceinline__ void a_ready(const Unit&) const {}
    __device__ __forceinline__ void done(const Unit&) const {}
};

__device__ __forceinline__ unsigned cvt_pk_bf16(float lo, float hi) { unsigned r; asm volatile("v_cvt_pk_bf16_f32 %0, %1, %2" : "=v"(r) : "v"(lo), "v"(hi)); return r; }
typedef float f32x2 __attribute__((ext_vector_type(2)));
__device__ __forceinline__ f32x2 gelu_pk(f32x2 v) {
    const f32x2 av = __builtin_elementwise_abs(v), d = av * 0.2316418882f + 1.0f;
    f32x2 t; t.x = __builtin_amdgcn_rcpf(d.x); t.y = __builtin_amdgcn_rcpf(d.y);
    f32x2 q = t * 0.5307027145f + (-0.7265760135f); q = q * t + 0.7107068705f; q = q * t + (-0.142248368f); q = q * t + 0.127414796f; q = q * t;
    const f32x2 s = (v * v) * (-0.72134752044f);
    f32x2 e; e.x = __builtin_amdgcn_exp2f(s.x); e.y = __builtin_amdgcn_exp2f(s.y);
    const f32x2 m = v * (q * e), r = v - m;
    f32x2 o; o.x = v.x < 0.f ? m.x : r.x; o.y = v.y < 0.f ? m.y : r.y; return o;
}

template <int ACT  > struct EpiBf16 {
    static constexpr bool PERM = true, AFTER_DRAIN = false; static_assert(ACT == 0 || ACT == 1, "EpiBf16: ACT is 0 (none) or 1 (gelu_pk)");
    bf16_t* O; int ldc; const float* bias; int split_cols; size_t split_stride; float scale0;
    __device__ __forceinline__ void operator()(const f32x4 (&acc)[2][2][4][2], const Unit& u, int wr, int wc, int fr, int fq) const {
        const int row0 = u.pm * BM + wr * 64 + fr; int colt = u.pn * BM; bf16_t* base = O;
        float sc = 1.f; if (split_cols) { const int t = colt / split_cols; base += (size_t)t * split_stride; colt -= t * split_cols; if (t == 0) sc = scale0; }
        const int col0 = colt + wc * 32 + 8 * fq, bcol0 = u.pn * BM + wc * 32 + 8 * fq;
        f32x4 bv[2][2];
#pragma unroll
        for (int bj = 0; bj < 2; ++bj)
#pragma unroll
            for (int n = 0; n < 2; ++n) bv[bj][n] = bias ? *(const f32x4*)(bias + bcol0 + bj * HALF + 4 * n) : (f32x4){0.f, 0.f, 0.f, 0.f};
#pragma unroll
        for (int ai = 0; ai < 2; ++ai)
#pragma unroll
            for (int m = 0; m < 4; ++m) { bf16_t* rowp = base + (size_t)(row0 + ai * HALF + m * 16) * ldc + col0;
#pragma unroll
                for (int bj = 0; bj < 2; ++bj) { f32x4 v0 = acc[ai][bj][m][0] + bv[bj][0], v1 = acc[ai][bj][m][1] + bv[bj][1];
                    if (ACT == 1) { f32x2 a = gelu_pk((f32x2){v0[0], v0[1]}), b = gelu_pk((f32x2){v0[2], v0[3]}), c = gelu_pk((f32x2){v1[0], v1[1]}), d = gelu_pk((f32x2){v1[2], v1[3]});
                        v0 = (f32x4){a.x, a.y, b.x, b.y}; v1 = (f32x4){c.x, c.y, d.x, d.y}; }
                    v0 = v0 * sc; v1 = v1 * sc; u32x4 w; w.x = cvt_pk_bf16(v0[0], v0[1]); w.y = cvt_pk_bf16(v0[2], v0[3]); w.z = cvt_pk_bf16(v1[0], v1[1]); w.w = cvt_pk_bf16(v1[2], v1[3]);
                    *(u32x4*)(rowp + bj * HALF) = w; } }
    }
};
__device__ __forceinline__ float sigmoid_f(float x) { return __builtin_amdgcn_rcpf(1.0f + __builtin_amdgcn_exp2f(-1.4426950408889634f * x)); }
__device__ __forceinline__ float gelu_tanh_f(float x) { const float y = 0.7978845608028654f * (x + 0.044715f * x * x * x); return x * sigmoid_f(2.0f * y); }
struct EpiSwiglu {
    static constexpr bool PERM = true, AFTER_DRAIN = false;
    bf16_t* O; int ldc;
    __device__ __forceinline__ void operator()(const f32x4 (&acc)[2][2][4][2], const Unit& u, int wr, int wc, int fr, int fq) const {
        const int row0 = u.pm * BM + wr * 64 + fr, col0 = u.pn * HALF + wc * 32 + 8 * fq;
#pragma unroll
        for (int ai = 0; ai < 2; ++ai)
#pragma unroll
            for (int m = 0; m < 4; ++m) { bf16_t* rowp = O + (size_t)(row0 + ai * HALF + m * 16) * ldc + col0;
                float o[8];
#pragma unroll
                for (int n = 0; n < 2; ++n)
#pragma unroll
                    for (int e = 0; e < 4; ++e) { const float g = acc[ai][0][m][n][e], up = acc[ai][1][m][n][e]; o[4 * n + e] = g * sigmoid_f(g) * up; }
                u32x4 w; w.x = cvt_pk_bf16(o[0], o[1]); w.y = cvt_pk_bf16(o[2], o[3]); w.z = cvt_pk_bf16(o[4], o[5]); w.w = cvt_pk_bf16(o[6], o[7]);
                *(u32x4*)rowp = w; }
    }
};
struct EpiGeluStats {
    static constexpr bool PERM = true, AFTER_DRAIN = false;
    bf16_t* U; bf16_t* V; float* stats;
    __device__ __forceinline__ void operator()(const f32x4 (&acc)[2][2][4][2], const Unit& u, int wr, int wc, int fr, int fq) const {
        const bool isv = u.pn >= 8; bf16_t* base = isv ? V : U;
        const int row0 = u.pm * BM + wr * 64 + fr, col0 = (u.pn & 7) * BM + wc * 32 + 8 * fq;
#pragma unroll
        for (int ai = 0; ai < 2; ++ai)
#pragma unroll
            for (int m = 0; m < 4; ++m) { const int row = row0 + ai * HALF + m * 16; bf16_t* rowp = base + (size_t)row * 2048 + col0; float s = 0.f, q = 0.f;
#pragma unroll
                for (int bj = 0; bj < 2; ++bj) { float o[8];
#pragma unroll
                    for (int n = 0; n < 2; ++n)
#pragma unroll
                        for (int e = 0; e < 4; ++e) { const float v = gelu_tanh_f(acc[ai][bj][m][n][e]); o[4 * n + e] = v; s += v; q += v * v; }
                    u32x4 w; w.x = cvt_pk_bf16(o[0], o[1]); w.y = cvt_pk_bf16(o[2], o[3]); w.z = cvt_pk_bf16(o[4], o[5]); w.w = cvt_pk_bf16(o[6], o[7]);
                    *(u32x4*)(rowp + bj * HALF) = w; }
                if (isv) { s += __shfl_xor(s, 16); s += __shfl_xor(s, 32); q += __shfl_xor(q, 16); q += __shfl_xor(q, 32);
                    if (fq == 0) { f32x2 sq; sq.x = s; sq.y = q; *(f32x2*)(stats + ((size_t)row * 32 + (u.pn - 8) * 4 + wc) * 2) = sq; } } }
    }
};
template <class Epi, class Sched, bool ALIGN_EPI = false, bool SP2 = false>
__device__ __forceinline__ void gemm_phase(PG8_LAS unsigned char* lds, const Gemm g, const Sched& S, const Epi& E) {
    int tid_ = threadIdx.x; asm volatile("" : "+v"(tid_));
    const int tid = tid_, wid = __builtin_amdgcn_readfirstlane(tid >> 6), lane = tid & 63, wr = wid >> 2, wc = wid & 3, fr = lane & 15, fq = lane >> 4;
    const int K = g.K, nt = K / BK;
    unsigned voffA[2], voffB[2];
#pragma unroll
    for (int i = 0; i < 2; ++i) { int R, C; stage_rc(tid * 16 + i * 8192, R, C); const int Rb = Epi::PERM ? ((R & ~31) + perm32(R & 31)) : R;
        voffA[i] = (unsigned)(R * K + C) * 2u; voffB[i] = (unsigned)(Rb * K + C) * 2u; }
    const size_t kstep = (size_t)(BK * 2);
    const size_t hstep = (size_t)HALF * K * 2;
    const size_t tstep = 2 * hstep;
    const unsigned ldsw = (unsigned)wid * 1024u;
    const int aoff = lds_byte(wr * 64 + fr, fq * 8), boff = lds_byte(wc * 32 + fr, fq * 8);
#define PG8_SA(b, h) (((b) * 2 + (h)) * HTB)
#define PG8_SB(b, h) ((4 + (b) * 2 + (h)) * HTB)
#define PG8_STAGE(bufoff, gbase, voff) do { _Pragma("unroll") for (int _i = 0; _i < 2; ++_i) \
        __builtin_amdgcn_global_load_lds((const unsigned*)((const char*)(gbase) + (voff)[_i]), (PG8_LAS unsigned*)(lds + (bufoff) + ldsw + _i * 8192), 16, 0, 0); } while (0)
#define PG8_LDA(dst, b, h) do { _Pragma("unroll") for (int m = 0; m < 4; ++m) _Pragma("unroll") for (int k = 0; k < 2; ++k) dst[m][k] = *(const PG8_LAS bf16x8*)(lds + PG8_SA(b, h) + aoff + m * 2048 + k * 1024); } while (0)
#define PG8_LDB(dst, b, h) do { _Pragma("unroll") for (int n = 0; n < 2; ++n) _Pragma("unroll") for (int k = 0; k < 2; ++k) dst[n][k] = *(const PG8_LAS bf16x8*)(lds + PG8_SB(b, h) + boff + n * 2048 + k * 1024); } while (0)
#define PG8_MMA(ai, bj, At, Bt) do { __builtin_amdgcn_s_setprio(1); _Pragma("unroll") for (int m = 0; m < 4; ++m) _Pragma("unroll") for (int n = 0; n < 2; ++n) _Pragma("unroll") for (int k = 0; k < 2; ++k) \
        acc[ai][bj][m][n] = __builtin_amdgcn_mfma_f32_16x16x32_bf16(Bt[n][k], At[m][k], acc[ai][bj][m][n], 0, 0, 0); __builtin_amdgcn_s_setprio(0); } while (0)
#define PG8_WAIT_V(n) asm volatile("s_waitcnt vmcnt(" #n ")" ::: "memory")
#define PG8_WAIT_L(n) asm volatile("s_waitcnt lgkmcnt(" #n ")" ::: "memory")
#define PG8_BAR __builtin_amdgcn_s_barrier()
#define PG8_SCHED __builtin_amdgcn_sched_barrier(0)
    Unit cur, nxt; int ui = 0;
    if (!S.next(0, cur)) return;
    f32x4 acc[2][2][4][2];
#pragma unroll
    for (int a = 0; a < 2; ++a)
#pragma unroll
        for (int b = 0; b < 2; ++b)
#pragma unroll
            for (int m = 0; m < 4; ++m)
#pragma unroll
                for (int n = 0; n < 2; ++n) acc[a][b][m][n] = (f32x4){0.f, 0.f, 0.f, 0.f};
    bf16x8 At[4][2], B0[2][2], B1[2][2];
    const char* cA = (const char*)g.A + (size_t)cur.pm * tstep; const char* cB = (const char*)g.Bt + (size_t)cur.pn * tstep;
    S.a_ready(cur);
    if constexpr (SP2) {
        PG8_STAGE(PG8_SB(0, 0), cB, voffB); PG8_STAGE(PG8_SB(0, 1), cB + hstep, voffB); PG8_STAGE(PG8_SA(0, 0), cA, voffA); PG8_STAGE(PG8_SA(0, 1), cA + hstep, voffA);
        if (wr == 1) PG8_BAR;
        PG8_WAIT_V(2); PG8_BAR;
        PG8_STAGE(PG8_SB(1, 0), cB + kstep, voffB); PG8_STAGE(PG8_SA(1, 0), cA + kstep, voffA); PG8_STAGE(PG8_SB(1, 1), cB + hstep + kstep, voffB);
        PG8_WAIT_V(6); PG8_BAR;
    } else {
        PG8_STAGE(PG8_SB(0, 0), cB, voffB); PG8_STAGE(PG8_SA(0, 0), cA, voffA); PG8_STAGE(PG8_SB(0, 1), cB + hstep, voffB); PG8_STAGE(PG8_SA(0, 1), cA + hstep, voffA);
        if (wr == 1) PG8_BAR;
        PG8_WAIT_V(4); PG8_BAR;
        PG8_STAGE(PG8_SB(1, 0), cB + kstep, voffB); PG8_STAGE(PG8_SA(1, 0), cA + kstep, voffA); PG8_STAGE(PG8_SB(1, 1), cB + hstep + kstep, voffB);
        PG8_WAIT_V(6); PG8_BAR;
    }
    for (;;) {
        const bool has_next = S.next(ui + 1, nxt);
        const char* nA = has_next ? (const char*)g.A + (size_t)nxt.pm * tstep : cA; const char* nB = has_next ? (const char*)g.Bt + (size_t)nxt.pn * tstep : cB;
        for (int t = 0; t < nt; t += 2) {
            const bool last = (t == nt - 2);
            const char* a1 = cA + (size_t)(t + 1) * kstep;
            const char* a2 = last ? nA : cA + (size_t)(t + 2) * kstep; const char* b2 = last ? nB : cB + (size_t)(t + 2) * kstep;
            const char* a3 = a2 + kstep; const char* b3 = b2 + kstep;
            if (last && has_next) S.a_ready(nxt);
            if constexpr (SP2) {
            PG8_LDB(B0, 0, 0); PG8_LDB(B1, 0, 1); PG8_SCHED; PG8_LDA(At, 0, 0); PG8_STAGE(PG8_SA(1, 1), a1 + hstep, voffA);
            PG8_WAIT_V(8); PG8_WAIT_L(0); PG8_BAR; PG8_MMA(0, 0, At, B0); PG8_MMA(0, 1, At, B1); PG8_BAR; PG8_SCHED;
            PG8_LDA(At, 0, 1); PG8_STAGE(PG8_SB(0, 0), b2, voffB); PG8_STAGE(PG8_SB(0, 1), b2 + hstep, voffB); PG8_STAGE(PG8_SA(0, 0), a2, voffA);
            PG8_WAIT_V(8); PG8_WAIT_L(0); PG8_BAR; PG8_MMA(1, 0, At, B0); PG8_MMA(1, 1, At, B1); PG8_BAR; PG8_SCHED;
            PG8_LDB(B0, 1, 0); PG8_LDB(B1, 1, 1); PG8_SCHED; PG8_LDA(At, 1, 0); PG8_STAGE(PG8_SA(0, 1), a2 + hstep, voffA);
            PG8_WAIT_V(8); PG8_WAIT_L(0); PG8_BAR; PG8_MMA(0, 0, At, B0); PG8_MMA(0, 1, At, B1); PG8_BAR; PG8_SCHED;
            PG8_LDA(At, 1, 1); PG8_STAGE(PG8_SB(1, 0), b3, voffB); PG8_STAGE(PG8_SB(1, 1), b3 + hstep, voffB); PG8_STAGE(PG8_SA(1, 0), a3, voffA);
            PG8_WAIT_V(8); PG8_WAIT_L(0); PG8_BAR; PG8_MMA(1, 0, At, B0); PG8_MMA(1, 1, At, B1); PG8_BAR; PG8_SCHED;
            } else {
            PG8_LDB(B0, 0, 0); PG8_SCHED; PG8_LDA(At, 0, 0); PG8_STAGE(PG8_SA(1, 1), a1 + hstep, voffA);
            PG8_WAIT_L(8); PG8_BAR; PG8_WAIT_L(0); PG8_MMA(0, 0, At, B0); PG8_BAR; PG8_SCHED;
            PG8_LDB(B1, 0, 1); PG8_STAGE(PG8_SB(0, 0), b2, voffB);
            PG8_BAR; PG8_WAIT_L(0); PG8_MMA(0, 1, At, B1); PG8_BAR;
            PG8_LDA(At, 0, 1); PG8_STAGE(PG8_SA(0, 0), a2, voffA);
            PG8_BAR; PG8_WAIT_L(0); PG8_MMA(1, 0, At, B0); PG8_BAR; PG8_SCHED;
            PG8_STAGE(PG8_SB(0, 1), b2 + hstep, voffB);
            PG8_WAIT_V(6); PG8_BAR; PG8_MMA(1, 1, At, B1); PG8_BAR;
            PG8_LDB(B0, 1, 0); PG8_SCHED; PG8_LDA(At, 1, 0); PG8_STAGE(PG8_SA(0, 1), a2 + hstep, voffA);
            PG8_WAIT_L(8); PG8_BAR; PG8_WAIT_L(0); PG8_MMA(0, 0, At, B0); PG8_BAR; PG8_SCHED;
            PG8_LDB(B1, 1, 1); PG8_STAGE(PG8_SB(1, 0), b3, voffB);
            PG8_BAR; PG8_WAIT_L(0); PG8_MMA(0, 1, At, B1); PG8_BAR;
            PG8_LDA(At, 1, 1); PG8_STAGE(PG8_SA(1, 0), a3, voffA);
            PG8_BAR; PG8_WAIT_L(0); PG8_MMA(1, 0, At, B0); PG8_BAR; PG8_SCHED;
            PG8_STAGE(PG8_SB(1, 1), b3 + hstep, voffB);
            PG8_WAIT_V(6); PG8_BAR; PG8_MMA(1, 1, At, B1); PG8_BAR;
            }
        }
        if constexpr (ALIGN_EPI) { if (wr == 0) PG8_BAR; }
        if constexpr (!Epi::AFTER_DRAIN) { E(acc, cur, wr, wc, fr, fq); S.done(cur); }
        if (!has_next) break;
#pragma unroll
        for (int a = 0; a < 2; ++a)
#pragma unroll
            for (int b = 0; b < 2; ++b)
#pragma unroll
                for (int m = 0; m < 4; ++m)
#pragma unroll
                    for (int n = 0; n < 2; ++n) acc[a][b][m][n] = (f32x4){0.f, 0.f, 0.f, 0.f};
        cur = nxt; cA = nA; cB = nB; ++ui;
        if constexpr (ALIGN_EPI) { if (wr == 1) PG8_BAR; }
    }
    PG8_WAIT_V(0);
    if constexpr (!ALIGN_EPI) { if (wr == 0) PG8_BAR; }
    PG8_BAR;
    if constexpr (Epi::AFTER_DRAIN) { E.fused(acc, cur, wr, wc, fr, fq, lds, wid, lane); S.done(cur); }
#undef PG8_SA
#undef PG8_SB
#undef PG8_STAGE
#undef PG8_LDA
#undef PG8_LDB
#undef PG8_MMA
#undef PG8_WAIT_V
#undef PG8_WAIT_L
#undef PG8_BAR
#undef PG8_SCHED
}
}
#ifndef PG8_SP2
#define PG8_SP2 true
#endif
#ifndef PG8_ALIGN
#define PG8_ALIGN true
#endif
#define GAS __attribute__((address_space(1)))
#define LAS __attribute__((address_space(3)))
typedef unsigned short bf16;
typedef unsigned v4u __attribute__((ext_vector_type(4)));
typedef float f32x4 __attribute__((ext_vector_type(4)));
typedef short bf16x8 __attribute__((ext_vector_type(8)));
typedef GAS unsigned gu32;
typedef GAS unsigned long long gu64;
#define RLX_AGENT __ATOMIC_RELAXED, __HIP_MEMORY_SCOPE_AGENT
#define LDS_WAIT() asm volatile("s_waitcnt lgkmcnt(0)" ::: "memory")
#define VM_WAIT() asm volatile("s_waitcnt vmcnt(0)" ::: "memory")
__device__ __forceinline__ unsigned long long rt() { return __builtin_amdgcn_s_memrealtime(); }
__device__ __forceinline__ unsigned f2bf(float f) { unsigned u = __builtin_bit_cast(unsigned, f); return (u + 0x7fffu + ((u >> 16) & 1u)) >> 16; }
__device__ __forceinline__ unsigned pk2(float lo, float hi) { return f2bf(lo) | (f2bf(hi) << 16); }

#define XB_TMO      128
#define XB_XCNT(j)  (256  + 64 * (j))
#define XB_XSUB(j)  (1280 + 64 * (j))
#define XB_XGEN(j)  (2304 + 64 * (j))
#define XB_TOP      3328
#define XB_TOPGEN   3392
#define XCD_BAR_WORDS 3456
#define XB_SPIN_CAP (1u << 18)

__device__ __forceinline__ unsigned xb_ld(unsigned* p)              { return __hip_atomic_load(p, __ATOMIC_RELAXED, __HIP_MEMORY_SCOPE_AGENT); }
__device__ __forceinline__ unsigned xb_add(unsigned* p, unsigned v) { return __hip_atomic_fetch_add(p, v, __ATOMIC_RELAXED, __HIP_MEMORY_SCOPE_AGENT); }
__device__ __forceinline__ unsigned xb_xcc_id() { return (unsigned)__builtin_amdgcn_s_getreg((3 << 11) | 20) & 0xFu; }
#define XB_SPIN(cond, bar) do { unsigned _sp = 0; while (cond) { __builtin_amdgcn_s_sleep(1); \
    if ((++_sp & 255u) == 0u) { if (xb_ld(&(bar)[XB_TMO])) break; if (_sp > XB_SPIN_CAP) { atomicAdd(&(bar)[XB_TMO], 1u); break; } } } } while (0)

struct XcdBarrier {
    unsigned* bar; unsigned x;
    volatile LAS unsigned* st;
};

__device__ __forceinline__ XcdBarrier xcd_barrier_post(unsigned* bar, volatile LAS unsigned* st) {
    XcdBarrier b; b.bar = bar; b.x = xb_xcc_id(); b.st = st;
    if (threadIdx.x == 0) (void)xb_add(&bar[XB_XCNT(b.x)], 1u);
    return b;
}
__device__ __forceinline__ void xcd_barrier_complete(unsigned* bar, unsigned x, unsigned& nloc, unsigned& nx) {
    const unsigned G = gridDim.x * gridDim.y * gridDim.z;
    unsigned sum, cnt, mine, sp = 0u;
    for (;;) {
        sum = 0u; cnt = 0u; mine = 0u;
#pragma unroll
        for (unsigned j = 0; j < 16; ++j) { const unsigned c = xb_ld(&bar[XB_XCNT(j)]); sum += c; cnt += (c > 0u) ? 1u : 0u; mine = (j == x) ? c : mine; }
        if (sum == G) break;
        __builtin_amdgcn_s_sleep(1);
        if ((++sp & 255u) == 0u) { if (xb_ld(&bar[XB_TMO])) break; if (sp > XB_SPIN_CAP) { atomicAdd(&bar[XB_TMO], 1u); break; } }
    }
    nloc = mine > 0u ? mine : 1u; nx = cnt > 0u ? cnt : 1u;
}

__device__ __forceinline__ void xcd_barrier(const XcdBarrier& b) {
    asm volatile("s_waitcnt vmcnt(0)" ::: "memory");
    __syncthreads();
    if (threadIdx.x == 0) {
        unsigned* bar = b.bar;
        __builtin_amdgcn_s_waitcnt(0);
        unsigned nloc = b.st[0], nx = b.st[1];
        if (nloc == 0u) { xcd_barrier_complete(bar, b.x, nloc, nx); b.st[0] = nloc; b.st[1] = nx; }
        const unsigned old = xb_add(&bar[XB_XSUB(b.x)], 1u);
        const unsigned gen = old / nloc;
        if (old + 1u == (gen + 1u) * nloc) {
            __builtin_amdgcn_fence(__ATOMIC_RELEASE, "agent");
            asm volatile("s_waitcnt vmcnt(0)" ::: "memory");
            const unsigned og = xb_add(&bar[XB_TOP], 1u);
            const unsigned tg = og / nx;
            if (og + 1u == (tg + 1u) * nx) xb_add(&bar[XB_TOPGEN], 1u);
            else XB_SPIN(xb_ld(&bar[XB_TOPGEN]) == tg, bar);
            __builtin_amdgcn_fence(__ATOMIC_ACQUIRE, "agent");
            xb_add(&bar[XB_XGEN(b.x)], 1u);
            asm volatile("s_waitcnt vmcnt(0)" ::: "memory");
        } else {
            XB_SPIN(xb_ld(&bar[XB_XGEN(b.x)]) == gen, bar);
            __builtin_amdgcn_fence(__ATOMIC_ACQUIRE, "agent");
            asm volatile("s_waitcnt vmcnt(0)" ::: "memory");
        }
    }
    __syncthreads();
}
constexpr int NWAVES = 8;
constexpr int BATCH = 4, SEQ = 8192, DM = 1024, M = BATCH * SEQ, DEPTH = 4;
constexpr int PP = 2560;
constexpr int QA_OFF = 0, KA_OFF = 512, VA_OFF = 576, QI_OFF = 640, KI_OFF = 896, QB_OFF = 960, KB_OFF = 1472, VB_OFF = 1984, WI_OFF = 2496;
constexpr int EVEN_IN = 2500, DFF = 2816, CWID = 2048, TOPK = 256;
constexpr float EPS = 1e-6f;
constexpr int N_PHASES = 1 + 7 * DEPTH;

constexpr size_t MiB = 1u << 20;
constexpr size_t WS_CTL = 0, CTL_ZERO_BYTES = 1 * MiB;
constexpr size_t WS_WINE = 1 * MiB, WS_WOUTE = 11 * MiB, WS_WINO = 15 * MiB, WS_WOUTO = 31 * MiB, WS_WFFI = 39 * MiB, WS_WFFO = 83 * MiB, WS_WSP = 105 * MiB;
constexpr size_t WS_STATS = 106 * MiB, WS_A = 114 * MiB, WS_R1 = 178 * MiB, WS_Y = WS_R1 + 192 * MiB, WS_END = 434 * MiB;
constexpr size_t SZ_WINE = (size_t)PP * DM * 2, SZ_WOUTE = (size_t)DM * DM * 2, SZ_WINO = (size_t)4096 * DM * 2, SZ_WOUTO = (size_t)DM * CWID * 2, SZ_WFFI = (size_t)2 * DFF * DM * 2, SZ_WFFO = (size_t)DM * DFF * 2, SZ_WSP = (size_t)16 * 128 * 128 * 2;
static_assert(WS_WINE + 2 * SZ_WINE <= WS_WOUTE && WS_WOUTE + 2 * SZ_WOUTE <= WS_WINO && WS_WINO + 2 * SZ_WINO <= WS_WOUTO && WS_WOUTO + 2 * SZ_WOUTO <= WS_WFFI && WS_WFFI + 4 * SZ_WFFI <= WS_WFFO && WS_WFFO + 4 * SZ_WFFO <= WS_WSP && WS_WSP + 2 * SZ_WSP <= WS_STATS, "weights map");
static_assert(WS_STATS + (size_t)M * 32 * 8 <= WS_A && WS_A + (size_t)M * DM * 2 <= WS_R1 && WS_R1 + (size_t)M * PP * 2 <= WS_Y && WS_R1 + (size_t)M * DFF * 2 <= WS_Y && WS_Y + (size_t)M * DM * 2 <= WS_END, "activation map");
constexpr int CW_BAR = 4096;

constexpr int RING_OFF = 0, RING_BYTES = 131072;
constexpr int LDSCTL_OFF = RING_BYTES, MISC_OFF = LDSCTL_OFF + 320;
constexpr int LDS_BYTES = 147456;
constexpr int LIST_OFF = RING_BYTES + 1024;

typedef float f32x16 __attribute__((ext_vector_type(16)));
typedef __bf16 bf16x2_t __attribute__((ext_vector_type(2)));
typedef unsigned u32x2 __attribute__((ext_vector_type(2)));
typedef float f32x2 __attribute__((ext_vector_type(2)));

__device__ __forceinline__ float bflo(unsigned u) { return __uint_as_float(u << 16); }
__device__ __forceinline__ float bfhi(unsigned u) { return __uint_as_float(u & 0xffff0000u); }
__device__ __forceinline__ unsigned cvtpk(float lo, float hi) { return pg8::cvt_pk_bf16(lo, hi); }
__device__ __forceinline__ float wave_sum(float v) {
#pragma unroll
    for (int o = 1; o < 64; o <<= 1) v += __shfl_xor(v, o);
    return v;
}
__device__ __forceinline__ float wave_max(float v) {
#pragma unroll
    for (int o = 1; o < 64; o <<= 1) v = fmaxf(v, __shfl_xor(v, o));
    return v;
}
__device__ __forceinline__ unsigned wave_sum_u(unsigned v) {
#pragma unroll
    for (int o = 1; o < 64; o <<= 1) v += (unsigned)__shfl_xor((int)v, o);
    return v;
}

struct Frame {
    LAS unsigned char* lds;
    volatile LAS unsigned* MISC;
    gu32* ctl;
    int tid, lane, wave, G, c;
    const float *x, *gains, *w_in_even, *w_out_even, *w_in_odd, *spatial_w, *spatial_b, *vgain, *vbias, *w_out_odd, *w_ffn_in, *w_ffn_out;
    float* out;
    bf16 *WinE, *WoutE, *WinO, *WoutO, *Wffi, *Wffo, *Wsp;
    float* stats;
    bf16 *A, *R1, *Y;
};

__device__ __forceinline__ int src_col(int mode, int d) {
    if (mode == 0) return d;
    if (mode == 1) { if (d < 960) return d; if (d < 2496) return d + 4; if (d < 2500) return d - 2496 + 960; return -1; }
    const int pn = d >> 8, xx = d & 255; return (xx >> 7) * DFF + 128 * pn + (xx & 127);
}
__device__ __forceinline__ void transpose_item(const float* W, int K, int Nsrc, int ND, int mode, bf16* WT, LAS float* scr, int item, int lane) {
    const int nblk = ND / 32, kb = item / nblk, nb = item % nblk, k0 = 64 * kb, n0 = 32 * nb;
    const int sc = src_col(mode, n0 + (lane & 31));
#pragma unroll 8
    for (int i = 0; i < 32; ++i) { const int kk = 2 * i + (lane >> 5); scr[kk * 33 + (lane & 31)] = sc >= 0 ? W[(size_t)(k0 + kk) * Nsrc + sc] : 0.f; }
    LDS_WAIT(); asm volatile("" ::: "memory");
    const int c = lane & 7;
#pragma unroll
    for (int j = 0; j < 4; ++j) { const int n = (lane >> 3) + 8 * j; const LAS float* s = scr + (8 * c) * 33 + n;
        v4u o; o.x = cvtpk(s[0 * 33], s[1 * 33]); o.y = cvtpk(s[2 * 33], s[3 * 33]); o.z = cvtpk(s[4 * 33], s[5 * 33]); o.w = cvtpk(s[6 * 33], s[7 * 33]);
        *(GAS v4u*)(WT + (size_t)(n0 + n) * K + k0 + 8 * c) = o; }
    LDS_WAIT(); asm volatile("" ::: "memory");
}
__device__ __forceinline__ void rms_row_to_bf16(const float* xrow, const float* g, bf16* orow, int lane) {
    const f32x4* xr = (const f32x4*)xrow + lane; f32x4 v[4]; float s = 0.f;
#pragma unroll
    for (int j = 0; j < 4; ++j) { v[j] = xr[64 * j]; s += (v[j].x * v[j].x + v[j].y * v[j].y) + (v[j].z * v[j].z + v[j].w * v[j].w); }
    const float r = 1.0f / sqrtf(wave_sum(s) * (1.f / DM) + EPS);
#pragma unroll
    for (int j = 0; j < 4; ++j) { const f32x4 gg = ((const f32x4*)g)[lane + 64 * j]; const f32x4 y = (v[j] * r) * gg;
        u32x2 o; o.x = cvtpk(y.x, y.y); o.y = cvtpk(y.z, y.w); ((u32x2*)orow)[lane + 64 * j] = o; }
}
__device__ __forceinline__ void res_row(const float* hin, const bf16* yrow, const float* gpost, const float* gnext, float* hout, bf16* arow, int lane) {
    f32x4 h[4], y[4]; float s = 0.f;
#pragma unroll
    for (int j = 0; j < 4; ++j) { h[j] = ((const f32x4*)hin)[lane + 64 * j]; const u32x2 yy = ((const u32x2*)yrow)[lane + 64 * j];
        y[j] = (f32x4){bflo(yy.x), bfhi(yy.x), bflo(yy.y), bfhi(yy.y)}; s += (y[j].x * y[j].x + y[j].y * y[j].y) + (y[j].z * y[j].z + y[j].w * y[j].w); }
    const float r = 1.0f / sqrtf(wave_sum(s) * (1.f / DM) + EPS); float s2 = 0.f;
#pragma unroll
    for (int j = 0; j < 4; ++j) { const f32x4 gp = ((const f32x4*)gpost)[lane + 64 * j]; h[j] = h[j] + (y[j] * r) * gp;
        s2 += (h[j].x * h[j].x + h[j].y * h[j].y) + (h[j].z * h[j].z + h[j].w * h[j].w); ((f32x4*)hout)[lane + 64 * j] = h[j]; }
    if (arow) { const float r2 = 1.0f / sqrtf(wave_sum(s2) * (1.f / DM) + EPS);
#pragma unroll
        for (int j = 0; j < 4; ++j) { const f32x4 gn = ((const f32x4*)gnext)[lane + 64 * j]; const f32x4 a = (h[j] * r2) * gn;
            u32x2 o; o.x = cvtpk(a.x, a.y); o.y = cvtpk(a.z, a.w); ((u32x2*)arow)[lane + 64 * j] = o; } }
}
constexpr int I_WINE = 16 * 80, I_WOUTE = 16 * 32, I_WINO = 16 * 128, I_WOUTO = 32 * 32, I_WFFI = 16 * 176, I_WFFO = 44 * 32;
__device__ __forceinline__ void p0_prologue(Frame& F) {
    LAS float* scr = (LAS float*)(F.lds + RING_OFF + F.wave * 16384);
    const int gw = F.c * NWAVES + F.wave, NGW = F.G * NWAVES;
    constexpr int NITEMS = 2 * (I_WINE + I_WOUTE + I_WINO + I_WOUTO) + 4 * (I_WFFI + I_WFFO);
    for (int it = gw; it < NITEMS; it += NGW) {
        int r = it;
        if (r < 2 * I_WINE) { const int i = r / I_WINE; r -= i * I_WINE; transpose_item(F.w_in_even + (size_t)i * DM * EVEN_IN, DM, EVEN_IN, PP, 1, F.WinE + (size_t)i * PP * DM, scr, r, F.lane); continue; } r -= 2 * I_WINE;
        if (r < 2 * I_WOUTE) { const int i = r / I_WOUTE; r -= i * I_WOUTE; transpose_item(F.w_out_even + (size_t)i * DM * DM, DM, DM, DM, 0, F.WoutE + (size_t)i * DM * DM, scr, r, F.lane); continue; } r -= 2 * I_WOUTE;
        if (r < 2 * I_WINO) { const int i = r / I_WINO; r -= i * I_WINO; transpose_item(F.w_in_odd + (size_t)i * DM * 4096, DM, 4096, 4096, 0, F.WinO + (size_t)i * 4096 * DM, scr, r, F.lane); continue; } r -= 2 * I_WINO;
        if (r < 2 * I_WOUTO) { const int i = r / I_WOUTO; r -= i * I_WOUTO; transpose_item(F.w_out_odd + (size_t)i * CWID * DM, CWID, DM, DM, 0, F.WoutO + (size_t)i * DM * CWID, scr, r, F.lane); continue; } r -= 2 * I_WOUTO;
        if (r < 4 * I_WFFI) { const int i = r / I_WFFI; r -= i * I_WFFI; transpose_item(F.w_ffn_in + (size_t)i * DM * 2 * DFF, DM, 2 * DFF, 2 * DFF, 2, F.Wffi + (size_t)i * 2 * DFF * DM, scr, r, F.lane); continue; } r -= 4 * I_WFFI;
        { const int i = r / I_WFFO; r -= i * I_WFFO; transpose_item(F.w_ffn_out + (size_t)i * DFF * DM, DFF, DM, DM, 0, F.Wffo + (size_t)i * DM * DFF, scr, r, F.lane); }
    }
    for (int idx = (F.c * NWAVES * 64 + F.tid); idx < 2 * 16 * 128 * 128 / 2; idx += F.G * NWAVES * 64) {
        const int e0 = 2 * idx, t = (e0 >> 7) & 127, s = e0 & 127; const f32x2 wv = *(const f32x2*)(F.spatial_w + e0);
        ((unsigned*)F.Wsp)[idx] = cvtpk(s <= t ? wv.x : 0.f, (s + 1) <= t ? wv.y : 0.f); }
    for (int m = gw; m < M; m += NGW) rms_row_to_bf16(F.x + (size_t)m * DM, F.gains, F.A + (size_t)m * DM, F.lane);
}
__device__ __forceinline__ void thin_phase(Frame& F, const float* hin, const float* gpost, const float* gnext, bool write_a) {
    const int gw = F.c * NWAVES + F.wave, NGW = F.G * NWAVES;
    for (int m = gw; m < M; m += NGW) res_row(hin + (size_t)m * DM, F.Y + (size_t)m * DM, gpost, gnext, F.out + (size_t)m * DM, write_a ? F.A + (size_t)m * DM : nullptr, F.lane);
#ifdef DBG_ZERO_EARLY
    if (!write_a) { asm volatile("s_waitcnt vmcnt(0)" ::: "memory");
        for (int m = gw; m < M; m += NGW) if ((m & 8191) < DBG_ZERO_EARLY) { for (int j = 0; j < 4; ++j) ((f32x4*)(F.out + (size_t)m * DM))[F.lane + 64 * j] = (f32x4){0.f, 0.f, 0.f, 0.f}; } }
#endif
}

#ifdef DBG_SB_FULL
constexpr float SB_STOP = -1e30f;
#else
constexpr float SB_STOP = -60.0f;
#endif
__device__ __forceinline__ void sb_task(const bf16* P, bf16* mix, int task, int lane) {
    const int b = task >> 10, h = (task >> 7) & 7, t = ((task & 127) << 6) + lane;
    const size_t rowq = (size_t)b * SEQ + t;
    float q[64], o[64];
    { const v4u* qp = (const v4u*)(P + rowq * PP + QB_OFF + h * 64);
#pragma unroll
      for (int i = 0; i < 8; ++i) { const v4u w = qp[i]; q[8 * i + 0] = bflo(w.x) * 0.125f; q[8 * i + 1] = bfhi(w.x) * 0.125f; q[8 * i + 2] = bflo(w.y) * 0.125f; q[8 * i + 3] = bfhi(w.y) * 0.125f;
          q[8 * i + 4] = bflo(w.z) * 0.125f; q[8 * i + 5] = bfhi(w.z) * 0.125f; q[8 * i + 6] = bflo(w.w) * 0.125f; q[8 * i + 7] = bfhi(w.w) * 0.125f; } }
#pragma unroll
    for (int d = 0; d < 64; ++d) o[d] = 0.f;
    float after = 0.f; int s = t - 1; bool act = s >= 0;
    while (__any(act)) {
        if (act) {
            const v4u* kp = (const v4u*)(P + ((size_t)b * SEQ + s) * PP + KB_OFF + h * 64);
            const v4u* vp = (const v4u*)(P + ((size_t)b * SEQ + s) * PP + VB_OFF + h * 64);
            float z = 0.f;
#pragma unroll
            for (int i = 0; i < 8; ++i) { const v4u w = kp[i]; z += q[8 * i + 0] * bflo(w.x) + q[8 * i + 1] * bfhi(w.x) + q[8 * i + 2] * bflo(w.y) + q[8 * i + 3] * bfhi(w.y)
                                                                 + q[8 * i + 4] * bflo(w.z) + q[8 * i + 5] * bfhi(w.z) + q[8 * i + 6] * bflo(w.w) + q[8 * i + 7] * bfhi(w.w); }
            const float l1p = __logf(1.0f + __expf(-fabsf(z)));
            const float ls_pos = fminf(z, 0.f) - l1p, ls_neg = fminf(-z, 0.f) - l1p;
            const float wgt = __expf(ls_pos + after);
#pragma unroll
            for (int i = 0; i < 8; ++i) { const v4u w = vp[i]; o[8 * i + 0] += wgt * bflo(w.x); o[8 * i + 1] += wgt * bfhi(w.x); o[8 * i + 2] += wgt * bflo(w.y); o[8 * i + 3] += wgt * bfhi(w.y);
                                           o[8 * i + 4] += wgt * bflo(w.z); o[8 * i + 5] += wgt * bfhi(w.z); o[8 * i + 6] += wgt * bflo(w.w); o[8 * i + 7] += wgt * bfhi(w.w); }
            after += ls_neg; --s; act = (s >= 0) && (after > SB_STOP);
        }
    }
    v4u* op = (v4u*)(mix + rowq * DM + 512 + h * 64);
#ifdef DBG_ZERO_YB
#pragma unroll
    for (int d = 0; d < 64; ++d) o[d] = 0.f;
#endif
#pragma unroll
    for (int i = 0; i < 8; ++i) { v4u w; w.x = cvtpk(o[8 * i + 0], o[8 * i + 1]); w.y = cvtpk(o[8 * i + 2], o[8 * i + 3]); w.z = cvtpk(o[8 * i + 4], o[8 * i + 5]); w.w = cvtpk(o[8 * i + 6], o[8 * i + 7]); op[i] = w; }
}

__device__ __forceinline__ unsigned f2key16(float x) {
    x = fminf(fmaxf(x, -65504.f), 65504.f) + 0.0f;
    const _Float16 hf = (_Float16)x; const unsigned bits = (unsigned)__builtin_bit_cast(unsigned short, hf);
    return (bits & 0x8000u) ? (~bits & 0xffffu) : (bits | 0x8000u);
}
__device__ __forceinline__ unsigned cnt_ge(const LAS unsigned short* Sw, int nch, unsigned cand, int lane) {
    unsigned cnt = 0;
    for (int c = 0; c < nch; ++c) { const v4u x4 = *(const LAS v4u*)(Sw + c * 512 + 8 * lane);
#pragma unroll
        for (int d = 0; d < 4; ++d) { const unsigned x = x4[d]; cnt += ((x & 0xffffu) >= cand ? 1u : 0u) + ((x >> 16) >= cand ? 1u : 0u); } }
    return wave_sum_u(cnt);
}
__device__ __forceinline__ unsigned cnt_eq_lt(const LAS unsigned short* Sw, int nch, unsigned T, unsigned bound, int lane) {
    unsigned cnt = 0;
    for (int c = 0; c < nch; ++c) { const v4u x4 = *(const LAS v4u*)(Sw + c * 512 + 8 * lane);
#pragma unroll
        for (int d = 0; d < 4; ++d) { const unsigned x = x4[d], i0 = (unsigned)(c * 512 + 8 * lane + 2 * d);
            cnt += (((x & 0xffffu) == T && i0 < bound) ? 1u : 0u) + (((x >> 16) == T && (i0 + 1u) < bound) ? 1u : 0u); } }
    return wave_sum_u(cnt);
}
__device__ __forceinline__ void dsa_unit(Frame& F, const bf16* P, bf16* mix, int b, int qg) {
    const int lane = F.lane, w = F.wave, r = lane & 31, hh = lane >> 5;
    const int t0 = qg * 8; const size_t rowb = (size_t)b * SEQ;
    LAS unsigned short* S = (LAS unsigned short*)(F.lds + RING_OFF);
    const int N = t0 + 8, ntiles = ((N + 511) >> 9) << 4;
    pg8::bf16x8 Af[4];
    { const bf16* ap = P + (rowb + t0 + (r >> 2)) * PP + QI_OFF + (r & 3) * 64 + 8 * hh;
#pragma unroll
      for (int s = 0; s < 4; ++s) Af[s] = *(const pg8::bf16x8*)(ap + 16 * s); }
    float wg[4][4];
#pragma unroll
    for (int bq = 0; bq < 4; ++bq) { const u32x2 ww = *(const u32x2*)(P + (rowb + t0 + 2 * bq + hh) * PP + WI_OFF);
        wg[bq][0] = bflo(ww.x) * 0.0625f; wg[bq][1] = bfhi(ww.x) * 0.0625f; wg[bq][2] = bflo(ww.y) * 0.0625f; wg[bq][3] = bfhi(ww.y) * 0.0625f; }
#ifdef DBG_DUMB_SCORE
    { const int tq = t0 + w; const bf16* qp = P + (rowb + tq) * PP + QI_OFF; const bf16* wp = P + (rowb + tq) * PP + WI_OFF;
      for (int key = lane; key < ntiles * 32; key += 64) { unsigned short k16 = 0;
          if (key <= tq) { const bf16* kp = P + (rowb + key) * PP + KI_OFF; float sc = 0.f;
              for (int h = 0; h < 4; ++h) { float d = 0.f; for (int dd = 0; dd < 64; ++dd) d += bflo((unsigned)qp[h * 64 + dd]) * bflo((unsigned)kp[dd]); sc += bflo((unsigned)wp[h]) * 0.0625f * fmaxf(d, 0.f); }
              k16 = (unsigned short)f2key16(sc); }
          S[w * 8192 + key] = k16; } }
    if (false)
#endif
    for (int tile = w; tile < ntiles; tile += 8) {
        const int key = tile * 32 + r;
        if (tile * 32 >= N) {
#pragma unroll
            for (int bq = 0; bq < 4; ++bq) S[(2 * bq + hh) * 8192 + key] = (unsigned short)0;
            continue; }
        const int keyc = key < N ? key : N - 1;
        const bf16* kp = P + (rowb + keyc) * PP + KI_OFF + 8 * hh;
        pg8::bf16x8 Bf[4];
#pragma unroll
        for (int s = 0; s < 4; ++s) Bf[s] = *(const pg8::bf16x8*)(kp + 16 * s);
        f32x16 acc;
#pragma unroll
        for (int i = 0; i < 16; ++i) acc[i] = 0.f;
#pragma unroll
        for (int s = 0; s < 4; ++s) acc = __builtin_amdgcn_mfma_f32_32x32x16_bf16(Af[s], Bf[s], acc, 0, 0, 0);
#pragma unroll
        for (int bq = 0; bq < 4; ++bq) {
            const float sc = wg[bq][0] * fmaxf(acc[4 * bq + 0], 0.f) + wg[bq][1] * fmaxf(acc[4 * bq + 1], 0.f) + wg[bq][2] * fmaxf(acc[4 * bq + 2], 0.f) + wg[bq][3] * fmaxf(acc[4 * bq + 3], 0.f);
            S[(2 * bq + hh) * 8192 + key] = (key <= t0 + 2 * bq + hh) ? (unsigned short)f2key16(sc) : (unsigned short)0; }
    }
    __syncthreads();
#ifndef DSA_NO_SEL
    const int t = t0 + w, nch = (t >> 9) + 1;
    LAS unsigned short* Sw = S + w * 8192;
    LAS unsigned short* Lw = (LAS unsigned short*)(F.lds + LIST_OFF) + w * 256;
    int count;
    if (t + 1 <= TOPK) {
        count = t + 1;
#pragma unroll
        for (int j = 0; j < 4; ++j) if (lane + 64 * j < count) Lw[lane + 64 * j] = (unsigned short)(lane + 64 * j);
    } else {
        count = TOPK;
        unsigned T = 0u;
        for (int bit = 15; bit >= 0; --bit) { const unsigned cand = T | (1u << bit); if (cnt_ge(Sw, nch, cand, lane) >= (unsigned)TOPK) T = cand; }
        const unsigned n_gt = (T == 0xffffu) ? 0u : cnt_ge(Sw, nch, T + 1u, lane), n_ge = cnt_ge(Sw, nch, T, lane);
        const unsigned need = (unsigned)TOPK - n_gt, n_eq = n_ge - n_gt;
        unsigned B = 16384u;
        if (n_eq > need) { B = 0u; for (int bit = 13; bit >= 0; --bit) { const unsigned cand = B | (1u << bit); if (cnt_eq_lt(Sw, nch, T, cand, lane) <= need) B = cand; } }
        unsigned base = 0u;
        for (int c = 0; c < nch; ++c) { const v4u x4 = *(const LAS v4u*)(Sw + c * 512 + 8 * lane);
#pragma unroll
            for (int e = 0; e < 8; ++e) { const unsigned x = (e & 1) ? (x4[e >> 1] >> 16) : (x4[e >> 1] & 0xffffu); const unsigned idx = (unsigned)(c * 512 + 8 * lane + e);
                const bool sel = (x > T) || (x == T && idx < B);
                const unsigned long long mk = __ballot(sel);
                if (sel) Lw[base + __builtin_amdgcn_mbcnt_hi((unsigned)(mk >> 32), __builtin_amdgcn_mbcnt_lo((unsigned)mk, 0u))] = (unsigned short)idx;
                base += (unsigned)__builtin_popcountll(mk); } }
    }
    asm volatile("s_waitcnt lgkmcnt(0)" ::: "memory");
#endif
#ifdef DSA_NO_SEL
    const int t = t0 + w; LAS unsigned short* Sw = S + w * 8192; LAS unsigned short* Lw = (LAS unsigned short*)(F.lds + LIST_OFF) + w * 256; int count = 256;
#endif
#ifdef DBG_DUMB_ATT
    { const int hd = lane >> 3, dc = lane & 7; float q[64];
      for (int d = 0; d < 64; ++d) q[d] = bflo((unsigned)P[(rowb + t) * PP + QA_OFF + hd * 64 + d]);
      float mxx = -INFINITY, l = 0.f, acc[8] = {0.f, 0.f, 0.f, 0.f, 0.f, 0.f, 0.f, 0.f};
      for (int j = 0; j < count; ++j) { const int idx = (int)Lw[j]; const bf16* kr = P + (rowb + idx) * PP + KA_OFF; float z = 0.f;
          for (int d = 0; d < 64; ++d) z += q[d] * bflo((unsigned)kr[d]);
          z *= 0.125f; const float mn = fmaxf(mxx, z), sc = expf(mxx - mn), p = expf(z - mn); l = l * sc + p;
          const bf16* vr = P + (rowb + idx) * PP + VA_OFF + 8 * dc;
          for (int e = 0; e < 8; ++e) acc[e] = acc[e] * sc + p * bflo((unsigned)vr[e]);
          mxx = mn; }
      v4u wv; wv.x = cvtpk(acc[0] / l, acc[1] / l); wv.y = cvtpk(acc[2] / l, acc[3] / l); wv.z = cvtpk(acc[4] / l, acc[5] / l); wv.w = cvtpk(acc[6] / l, acc[7] / l);
      *(v4u*)(mix + (rowb + t) * DM + hd * 64 + 8 * dc) = wv; }
#define DSA_NO_ATT 1
#endif
#ifndef DSA_NO_ATT
    LAS unsigned* Qs = (LAS unsigned*)(Sw + 256);
    LAS float* Pm = (LAS float*)(Sw + 1024);
    { const v4u qv = *(const v4u*)(P + (rowb + t) * PP + QA_OFF + 8 * lane); *(LAS v4u*)(Qs + 4 * lane) = qv; }
    asm volatile("s_waitcnt lgkmcnt(0)" ::: "memory");
    float mx[8];
#pragma unroll
    for (int hd = 0; hd < 8; ++hd) mx[hd] = -INFINITY;
#pragma unroll 1
    for (int i = 0; i < 4; ++i) {
        const int j = lane + 64 * i; const bool valid = j < count; const int idx = valid ? (int)Lw[j] : 0;
        const v4u* kp = (const v4u*)(P + (rowb + idx) * PP + KA_OFF);
        unsigned kk[32];
#pragma unroll
        for (int d = 0; d < 8; ++d) { const v4u wv = kp[d]; kk[4 * d] = wv.x; kk[4 * d + 1] = wv.y; kk[4 * d + 2] = wv.z; kk[4 * d + 3] = wv.w; }
        float lgt[8];
#pragma unroll
        for (int hd = 0; hd < 8; ++hd) { float a = 0.f;
#pragma unroll
            for (int d = 0; d < 8; ++d) { const v4u qv = *(const LAS v4u*)(Qs + hd * 32 + 4 * d);
                a = __builtin_amdgcn_fdot2_f32_bf16(__builtin_bit_cast(bf16x2_t, kk[4 * d]), __builtin_bit_cast(bf16x2_t, qv.x), a, false);
                a = __builtin_amdgcn_fdot2_f32_bf16(__builtin_bit_cast(bf16x2_t, kk[4 * d + 1]), __builtin_bit_cast(bf16x2_t, qv.y), a, false);
                a = __builtin_amdgcn_fdot2_f32_bf16(__builtin_bit_cast(bf16x2_t, kk[4 * d + 2]), __builtin_bit_cast(bf16x2_t, qv.z), a, false);
                a = __builtin_amdgcn_fdot2_f32_bf16(__builtin_bit_cast(bf16x2_t, kk[4 * d + 3]), __builtin_bit_cast(bf16x2_t, qv.w), a, false); }
            lgt[hd] = valid ? a * 0.125f : -INFINITY; mx[hd] = fmaxf(mx[hd], lgt[hd]); }
        LAS f32x4* pp = (LAS f32x4*)(Pm + j * 8);
        pp[0] = (f32x4){lgt[0], lgt[1], lgt[2], lgt[3]}; pp[1] = (f32x4){lgt[4], lgt[5], lgt[6], lgt[7]};
    }
    float inv[8];
    {
        float sm[8];
#pragma unroll
        for (int hd = 0; hd < 8; ++hd) { mx[hd] = wave_max(mx[hd]); sm[hd] = 0.f; }
        asm volatile("s_waitcnt lgkmcnt(0)" ::: "memory");
#pragma unroll 1
        for (int i = 0; i < 4; ++i) { LAS f32x4* pp = (LAS f32x4*)(Pm + (lane + 64 * i) * 8); f32x4 a = pp[0], c = pp[1];
            a.x = __expf(a.x - mx[0]); a.y = __expf(a.y - mx[1]); a.z = __expf(a.z - mx[2]); a.w = __expf(a.w - mx[3]);
            c.x = __expf(c.x - mx[4]); c.y = __expf(c.y - mx[5]); c.z = __expf(c.z - mx[6]); c.w = __expf(c.w - mx[7]);
            sm[0] += a.x; sm[1] += a.y; sm[2] += a.z; sm[3] += a.w; sm[4] += c.x; sm[5] += c.y; sm[6] += c.z; sm[7] += c.w;
            pp[0] = a; pp[1] = c; }
#pragma unroll
        for (int hd = 0; hd < 8; ++hd) inv[hd] = 1.0f / wave_sum(sm[hd]);
    }
    asm volatile("s_waitcnt lgkmcnt(0)" ::: "memory");
    {
        const int ks = lane >> 3, dc = lane & 7;
        float o[8][8];
#pragma unroll
        for (int hd = 0; hd < 8; ++hd)
#pragma unroll
            for (int e = 0; e < 8; ++e) o[hd][e] = 0.f;
#pragma unroll 4
        for (int jj = 0; jj < 32; ++jj) {
            const int j = jj * 8 + ks; const int idx = j < count ? (int)Lw[j] : 0;
            const v4u vv = *(const v4u*)(P + (rowb + idx) * PP + VA_OFF + 8 * dc);
            const f32x4 p0 = *(const LAS f32x4*)(Pm + j * 8), p1 = *(const LAS f32x4*)(Pm + j * 8 + 4);
            const float vf[8] = {bflo(vv.x), bfhi(vv.x), bflo(vv.y), bfhi(vv.y), bflo(vv.z), bfhi(vv.z), bflo(vv.w), bfhi(vv.w)};
            const float pf[8] = {p0.x, p0.y, p0.z, p0.w, p1.x, p1.y, p1.z, p1.w};
#pragma unroll
            for (int hd = 0; hd < 8; ++hd)
#pragma unroll
                for (int e = 0; e < 8; ++e) o[hd][e] += pf[hd] * vf[e];
        }
#pragma unroll
        for (int hd = 0; hd < 8; ++hd)
#pragma unroll
            for (int e = 0; e < 8; ++e) { float x = o[hd][e]; x += __shfl_xor(x, 8); x += __shfl_xor(x, 16); x += __shfl_xor(x, 32); o[hd][e] = x * inv[hd]; }
        if (ks == 0) {
#pragma unroll
            for (int hd = 0; hd < 8; ++hd) { v4u wv; wv.x = cvtpk(o[hd][0], o[hd][1]); wv.y = cvtpk(o[hd][2], o[hd][3]); wv.z = cvtpk(o[hd][4], o[hd][5]); wv.w = cvtpk(o[hd][6], o[hd][7]);
#ifdef DBG_ZERO_YA
                wv = (v4u){0u, 0u, 0u, 0u};
#endif
                *(v4u*)(mix + (rowb + t) * DM + hd * 64 + 8 * dc) = wv; } }
    }
#endif
    __syncthreads();
}

__device__ __forceinline__ void spatial_unit(Frame& F, int li, int ch, int g, bf16* U, const bf16* V) {
    LAS unsigned short* VT = (LAS unsigned short*)(F.lds + RING_OFF);
    LAS float* MU = (LAS float*)(F.lds + RING_OFF + 36864); LAS float* RS = MU + 128;
    const size_t r0 = (size_t)ch * 128; const int c0 = g * 128; const int lane = F.lane;
    { const int row = F.tid >> 2, part = F.tid & 3; const f32x2* sp = (const f32x2*)F.stats + (r0 + row) * 32 + part * 8; float s = 0.f, q = 0.f;
#pragma unroll
      for (int k = 0; k < 8; ++k) { const f32x2 a = sp[k]; s += a.x; q += a.y; }
      s += __shfl_xor(s, 1); s += __shfl_xor(s, 2); q += __shfl_xor(q, 1); q += __shfl_xor(q, 2);
      if (part == 0) { const float mu = s * (1.f / CWID); const float var = fmaxf(q * (1.f / CWID) - mu * mu, 0.f); MU[row] = mu; RS[row] = 1.0f / sqrtf(var + EPS); } }
    __syncthreads();
#pragma unroll
    for (int it = 0; it < 4; ++it) { const int idx = F.tid + 512 * it, s = idx >> 4, cc = idx & 15;
        const v4u raw = *(const v4u*)(V + (r0 + s) * CWID + c0 + 8 * cc); const float mu = MU[s], rs = RS[s];
        const f32x4 g0 = *(const f32x4*)(F.vgain + li * CWID + c0 + 8 * cc), g1 = *(const f32x4*)(F.vgain + li * CWID + c0 + 8 * cc + 4);
        const f32x4 b0 = *(const f32x4*)(F.vbias + li * CWID + c0 + 8 * cc), b1 = *(const f32x4*)(F.vbias + li * CWID + c0 + 8 * cc + 4);
        const float xv[8] = {bflo(raw.x), bfhi(raw.x), bflo(raw.y), bfhi(raw.y), bflo(raw.z), bfhi(raw.z), bflo(raw.w), bfhi(raw.w)};
        const float gg[8] = {g0.x, g0.y, g0.z, g0.w, g1.x, g1.y, g1.z, g1.w}, bb[8] = {b0.x, b0.y, b0.z, b0.w, b1.x, b1.y, b1.z, b1.w};
#pragma unroll
        for (int e = 0; e < 8; e += 2) { const float y0 = (xv[e] - mu) * rs * gg[e] + bb[e], y1 = (xv[e + 1] - mu) * rs * gg[e + 1] + bb[e + 1]; const unsigned pk = cvtpk(y0, y1);
            VT[(8 * cc + e) * 136 + s] = (unsigned short)(pk & 0xffffu); VT[(8 * cc + e + 1) * 136 + s] = (unsigned short)(pk >> 16); } }
    __syncthreads();
    const int cb = F.wave >> 1, tb0 = (F.wave & 1) * 2, r = lane & 31, hh = lane >> 5;
    f32x16 acc[2];
#pragma unroll
    for (int x = 0; x < 2; ++x)
#pragma unroll
        for (int i = 0; i < 16; ++i) acc[x][i] = 0.f;
    const bf16* wbase = F.Wsp + (size_t)(li * 16 + g) * 128 * 128;
#pragma unroll
    for (int ks = 0; ks < 8; ++ks) { const pg8::bf16x8 a = *(const LAS pg8::bf16x8*)(VT + (32 * cb + r) * 136 + 16 * ks + 8 * hh);
#pragma unroll
        for (int x = 0; x < 2; ++x) { const int tb = tb0 + x; if (ks < 2 * tb + 2) { const pg8::bf16x8 bfr = *(const pg8::bf16x8*)(wbase + (32 * tb + r) * 128 + 16 * ks + 8 * hh);
            acc[x] = __builtin_amdgcn_mfma_f32_32x32x16_bf16(a, bfr, acc[x], 0, 0, 0); } } }
#pragma unroll
    for (int x = 0; x < 2; ++x) { const int t = 32 * (tb0 + x) + r; const float bs = F.spatial_b[(li * 16 + g) * 128 + t]; bf16* up = U + (r0 + t) * CWID + c0 + 32 * cb + 4 * hh;
#pragma unroll
        for (int ig = 0; ig < 4; ++ig) { const u32x2 uu = *(const u32x2*)(up + 8 * ig);
            u32x2 o; o.x = cvtpk(bflo(uu.x) * (acc[x][4 * ig + 0] + bs), bfhi(uu.x) * (acc[x][4 * ig + 1] + bs)); o.y = cvtpk(bflo(uu.y) * (acc[x][4 * ig + 2] + bs), bfhi(uu.y) * (acc[x][4 * ig + 3] + bs));
            *(u32x2*)(up + 8 * ig) = o; } }
    __syncthreads();
}


#ifdef DBG_DUMB_SP
__device__ __forceinline__ void dumb_stats(Frame& F, const bf16* V) {
    const int gw = F.c * NWAVES + F.wave, NGW = F.G * NWAVES;
    for (int m = gw; m < M; m += NGW) { float s = 0.f, q = 0.f;
        for (int c = F.lane; c < CWID; c += 64) { const float x = bflo((unsigned)V[(size_t)m * CWID + c]); s += x; q += x * x; }
        s = wave_sum(s); q = wave_sum(q); const float mu = s / CWID, var = fmaxf(q / CWID - mu * mu, 0.f);
        if (F.lane == 0) { F.stats[(size_t)m * 2] = mu; F.stats[(size_t)m * 2 + 1] = 1.0f / sqrtf(var + EPS); } }
}
__device__ __forceinline__ void dumb_spatial(Frame& F, int li, bf16* U, const bf16* V) {
    const size_t total = (size_t)M * CWID;
    for (size_t e = (size_t)F.c * 512 + F.tid; e < total; e += (size_t)F.G * 512) {
        const size_t row = e / CWID; const int c = (int)(e % CWID), g = c >> 7, t = (int)(row & 127); const size_t rb = row - t;
        float acc = 0.f;
        for (int s = 0; s <= t; ++s) { const float x = bflo((unsigned)V[(rb + s) * CWID + c]); const float mu = F.stats[(rb + s) * 2], rs = F.stats[(rb + s) * 2 + 1];
            const float vn = (x - mu) * rs * F.vgain[li * CWID + c] + F.vbias[li * CWID + c];
            acc += F.spatial_w[(((size_t)li * 16 + g) * 128 + t) * 128 + s] * vn; }
        const float sv = acc + F.spatial_b[(li * 16 + g) * 128 + t];
        const float u = bflo((unsigned)U[e]);
        U[e] = (bf16)(cvtpk(u * sv, 0.f) & 0xffffu);
    }
}
#endif

#ifdef DBG_DUMB_GEMM
template <int MODE> __device__ __forceinline__ void dumb_gemm(Frame& F, const bf16* A, int lda, const float* W, int ldw, int K, int N, bf16* O, int ldo) {
    const size_t total = (size_t)(M / 4) * N;
    for (size_t idx = (size_t)F.c * 512 + F.tid; idx < total; idx += (size_t)F.G * 512) {
        const int mb = (int)(idx / N), n = (int)(idx % N);
        float acc[4] = {0.f, 0.f, 0.f, 0.f}, acu[4] = {0.f, 0.f, 0.f, 0.f};
        for (int k = 0; k < K; ++k) { const float w = W[(size_t)k * ldw + n]; const float w2 = MODE == 2 ? W[(size_t)k * ldw + N + n] : 0.f;
#pragma unroll
            for (int i = 0; i < 4; ++i) { const float a = bflo((unsigned)A[(size_t)(4 * mb + i) * lda + k]); acc[i] += a * w; if (MODE == 2) acu[i] += a * w2; } }
#pragma unroll
        for (int i = 0; i < 4; ++i) { const size_t row = (size_t)(4 * mb + i); float v = acc[i]; size_t off;
            if (MODE == 0) off = row * ldo + n;
            else if (MODE == 1) off = row * ldo + (n < 960 ? n : (n < 964 ? 2496 + (n - 960) : n - 4));
            else if (MODE == 2) { v = v / (1.0f + expf(-v)) * acu[i]; off = row * ldo + n; }
            else { const float y = 0.7978845608028654f * (v + 0.044715f * v * v * v); v = 0.5f * v * (1.0f + tanhf(y)); off = (n < 2048 ? 0 : (size_t)M * 2048) + row * 2048 + (n & 2047); }
            O[off] = (bf16)(cvtpk(v, 0.f) & 0xffffu); }
    }
}
#endif
struct Args { const float* in[12]; float* out; unsigned char* ws; int ph_lo, ph_hi; };
__global__ void __launch_bounds__(NWAVES * 64, 2) fwd_kernel(Args args) {
    extern __shared__ __attribute__((aligned(16))) unsigned char lds[];
    Frame F;
    F.lds = (LAS unsigned char*)lds;
    F.MISC = (volatile LAS unsigned*)(F.lds + MISC_OFF);
    F.tid = threadIdx.x; F.lane = F.tid & 63; F.wave = __builtin_amdgcn_readfirstlane(F.tid >> 6);
    F.G = gridDim.x; F.c = blockIdx.x;
    unsigned char* ws = args.ws;
    F.ctl = (gu32*)(ws + WS_CTL);
    F.x = args.in[0]; F.gains = args.in[1]; F.w_in_even = args.in[2]; F.w_out_even = args.in[3]; F.w_in_odd = args.in[4]; F.spatial_w = args.in[5]; F.spatial_b = args.in[6];
    F.vgain = args.in[7]; F.vbias = args.in[8]; F.w_out_odd = args.in[9]; F.w_ffn_in = args.in[10]; F.w_ffn_out = args.in[11]; F.out = args.out;
    F.WinE = (bf16*)(ws + WS_WINE); F.WoutE = (bf16*)(ws + WS_WOUTE); F.WinO = (bf16*)(ws + WS_WINO); F.WoutO = (bf16*)(ws + WS_WOUTO); F.Wffi = (bf16*)(ws + WS_WFFI); F.Wffo = (bf16*)(ws + WS_WFFO); F.Wsp = (bf16*)(ws + WS_WSP);
    F.stats = (float*)(ws + WS_STATS); F.A = (bf16*)(ws + WS_A); F.R1 = (bf16*)(ws + WS_R1); F.Y = (bf16*)(ws + WS_Y);
    for (int u = F.tid; u < (LDS_BYTES - LDSCTL_OFF) / 4; u += NWAVES * 64) ((LAS unsigned*)(F.lds + LDSCTL_OFF))[u] = 0u;
    __syncthreads();
    const int lo = args.ph_lo, hi = args.ph_hi;
    XcdBarrier bar; bar.bar = (unsigned*)(F.ctl + CW_BAR); bar.x = 0; bar.st = nullptr;
    if (hi - lo > 1) bar = xcd_barrier_post((unsigned*)(F.ctl + CW_BAR), F.MISC + 8);
#define IN(k) (lo <= (k) && (k) < hi)
#define REFRESH() do { int t_ = threadIdx.x; asm volatile("" : "+v"(t_)); F.tid = t_; F.lane = t_ & 63; } while (0)
#define SEAM(k) do { if (IN(k) && IN((k) + 1)) xcd_barrier(bar); } while (0)

    #ifndef NO_P0
#ifdef DBG_DUMB_SP
    if (lo >= 100) { dumb_stats(F, F.R1 + (size_t)M * CWID); return; }
#endif
    if (IN(0)) { REFRESH(); p0_prologue(F); SEAM(0); }
#endif
    for (int L = 0; L < DEPTH; ++L) {
        const int pb = 1 + 7 * L, li = L >> 1;
        const float* gl = F.gains + (size_t)L * 4 * DM;
        if ((L & 1) == 0) {
            if (IN(pb + 0)) {
                pg8::Gemm g{F.A, F.WinE + (size_t)li * PP * DM, M, PP, DM}; pg8::StaticOrder S; S.init(M, PP, F.G, F.c);
                pg8::EpiBf16<0> E{F.R1, PP, nullptr, 0, 0, 1.f};
#if defined(DBG_DUMB_GEMM) && (DBG_DUMB_GEMM & (1 << 1))
                dumb_gemm<1>(F, F.A, DM, F.w_in_even + (size_t)li * DM * EVEN_IN, EVEN_IN, DM, EVEN_IN, F.R1, PP);
#else
                pg8::gemm_phase<pg8::EpiBf16<0>, pg8::StaticOrder, PG8_ALIGN, PG8_SP2>(F.lds + RING_OFF, g, S, E);
#endif
                SEAM(pb + 0);
            }
            if (IN(pb + 1)) {
                REFRESH();
                if (F.G == 256) {
                    const int b = F.c >> 6, j = F.c & 63;
                    #ifndef NO_DSA
                    for (int k = 0; k < 16; ++k) dsa_unit(F, F.R1, F.A, b, (k & 1) ? (64 * k + 63 - j) : (64 * k + j));
#endif
                    #ifndef NO_SB
                    for (int task = F.c * NWAVES + F.wave; task < 4096; task += 256 * NWAVES) sb_task(F.R1, F.A, task, F.lane);
#endif
                }
                SEAM(pb + 1);
            }
            if (IN(pb + 2)) {
                pg8::Gemm g{F.A, F.WoutE + (size_t)li * DM * DM, M, DM, DM}; pg8::StaticOrder S; S.init(M, DM, F.G, F.c);
                pg8::EpiBf16<0> E{F.Y, DM, nullptr, 0, 0, 1.f};
#if defined(DBG_DUMB_GEMM) && (DBG_DUMB_GEMM & (1 << 2))
                dumb_gemm<0>(F, F.A, DM, F.w_out_even + (size_t)li * DM * DM, DM, DM, DM, F.Y, DM);
#else
                pg8::gemm_phase<pg8::EpiBf16<0>, pg8::StaticOrder, PG8_ALIGN, PG8_SP2>(F.lds + RING_OFF, g, S, E);
#endif
                SEAM(pb + 2);
            }
        } else {
            bf16* U = F.R1; bf16* V = F.R1 + (size_t)M * CWID;
            if (IN(pb + 0)) {
                pg8::Gemm g{F.A, F.WinO + (size_t)li * 4096 * DM, M, 4096, DM}; pg8::StaticOrder S; S.init(M, 4096, F.G, F.c);
                pg8::EpiGeluStats E{U, V, F.stats};
#if defined(DBG_DUMB_GEMM) && (DBG_DUMB_GEMM & (1 << 3))
                dumb_gemm<3>(F, F.A, DM, F.w_in_odd + (size_t)li * DM * 4096, 4096, DM, 4096, F.R1, 0);
#else
                pg8::gemm_phase<pg8::EpiGeluStats, pg8::StaticOrder, PG8_ALIGN, PG8_SP2>(F.lds + RING_OFF, g, S, E);
#endif
                SEAM(pb + 0);
            }
            if (IN(pb + 1)) {
                REFRESH();
#ifndef NO_SP
#ifdef DBG_DUMB_SP
                dumb_spatial(F, li, U, V);
#else
                for (int u = F.c; u < 256 * 16; u += F.G) spatial_unit(F, li, u >> 4, u & 15, U, V);
#endif
#endif
                SEAM(pb + 1);
            }
            if (IN(pb + 2)) {
                pg8::Gemm g{U, F.WoutO + (size_t)li * DM * CWID, M, DM, CWID}; pg8::StaticOrder S; S.init(M, DM, F.G, F.c);
                pg8::EpiBf16<0> E{F.Y, DM, nullptr, 0, 0, 1.f};
#if defined(DBG_DUMB_GEMM) && (DBG_DUMB_GEMM & (1 << 4))
                dumb_gemm<0>(F, U, CWID, F.w_out_odd + (size_t)li * CWID * DM, DM, CWID, DM, F.Y, DM);
#else
                pg8::gemm_phase<pg8::EpiBf16<0>, pg8::StaticOrder, PG8_ALIGN, PG8_SP2>(F.lds + RING_OFF, g, S, E);
#endif
                SEAM(pb + 2);
            }
        }
#ifndef NO_THIN
        if (IN(pb + 3)) { REFRESH(); thin_phase(F, L == 0 ? F.x : F.out, gl + DM, gl + 2 * DM, true); SEAM(pb + 3); }
#endif
        if (IN(pb + 4)) {
            pg8::Gemm g{F.A, F.Wffi + (size_t)L * 2 * DFF * DM, M, 2 * DFF, DM}; pg8::StaticOrder S; S.init(M, 2 * DFF, F.G, F.c);
            pg8::EpiSwiglu E{F.R1, DFF};
#if defined(DBG_DUMB_GEMM) && (DBG_DUMB_GEMM & (1 << 5))
                dumb_gemm<2>(F, F.A, DM, F.w_ffn_in + (size_t)L * DM * 2 * DFF, 2 * DFF, DM, DFF, F.R1, DFF);
#else
            pg8::gemm_phase<pg8::EpiSwiglu, pg8::StaticOrder, PG8_ALIGN, PG8_SP2>(F.lds + RING_OFF, g, S, E);
#endif
            SEAM(pb + 4);
        }
        if (IN(pb + 5)) {
            pg8::Gemm g{F.R1, F.Wffo + (size_t)L * DM * DFF, M, DM, DFF}; pg8::StaticOrder S; S.init(M, DM, F.G, F.c);
            pg8::EpiBf16<0> E{F.Y, DM, nullptr, 0, 0, 1.f};
#if defined(DBG_DUMB_GEMM) && (DBG_DUMB_GEMM & (1 << 6))
                dumb_gemm<0>(F, F.R1, DFF, F.w_ffn_out + (size_t)L * DFF * DM, DM, DFF, DM, F.Y, DM);
#else
            pg8::gemm_phase<pg8::EpiBf16<0>, pg8::StaticOrder, PG8_ALIGN, PG8_SP2>(F.lds + RING_OFF, g, S, E);
#endif
            SEAM(pb + 5);
        }
#ifndef NO_THIN
        if (IN(pb + 6)) { REFRESH(); thin_phase(F, F.out, gl + 3 * DM, gl + 4 * DM, L + 1 < DEPTH); if (L + 1 < DEPTH) SEAM(pb + 6); }
#endif
    }
#undef IN
#undef SEAM
}

#ifndef MK_ONE_LAUNCH
#define MK_ONE_LAUNCH 0
#endif
extern "C" void kernel_launch(void* const* d_in, const int* in_sizes, int n_in, void* d_out, int out_size, void* d_ws, size_t ws_size, hipStream_t stream) {
    static int ready = 0;
    if (ready == 0) {
        if (n_in != 12 || in_sizes[0] != M * DM || out_size != M * DM || ws_size < WS_END) { fprintf(stderr, "kernel_launch: unexpected shapes (n_in %d, in0 %d, out %d, ws %zu)\n", n_in, n_in > 0 ? in_sizes[0] : -1, out_size, ws_size); ready = -1; return; }
        if (hipFuncSetAttribute((const void*)fwd_kernel, hipFuncAttributeMaxDynamicSharedMemorySize, LDS_BYTES) != hipSuccess) { fprintf(stderr, "kernel_launch: hipFuncSetAttribute failed\n"); ready = -1; return; }
        int per_cu = 0;
        if (hipOccupancyMaxActiveBlocksPerMultiprocessor(&per_cu, (const void*)fwd_kernel, NWAVES * 64, LDS_BYTES) != hipSuccess || per_cu < 1) fprintf(stderr, "kernel_launch: note: occupancy query reports %d blocks per CU\n", per_cu);
        (void)hipGetLastError();
        ready = 1;
    }
    if (ready < 0) return;
    if (hipMemsetAsync((char*)d_ws + WS_CTL, 0, CTL_ZERO_BYTES, stream) != hipSuccess) { fprintf(stderr, "kernel_launch: memset failed\n"); return; }
    Args a{};
    for (int i = 0; i < 12; ++i) a.in[i] = (const float*)d_in[i];
    a.out = (float*)d_out; a.ws = (unsigned char*)d_ws;
#if MK_ONE_LAUNCH
    a.ph_lo = 0; a.ph_hi = N_PHASES;
    hipLaunchKernelGGL(fwd_kernel, dim3(256), dim3(NWAVES * 64), LDS_BYTES, stream, a);
#else
    for (int k = 0; k < N_PHASES; ++k) {
#ifdef DBG_DUMB_SP
        if (k == 9 || k == 23) { a.ph_lo = 100; a.ph_hi = 101; hipLaunchKernelGGL(fwd_kernel, dim3(256), dim3(NWAVES * 64), LDS_BYTES, stream, a); }
#endif
        a.ph_lo = k; a.ph_hi = k + 1; hipLaunchKernelGGL(fwd_kernel, dim3(256), dim3(NWAVES * 64), LDS_BYTES, stream, a); }
#endif
}
```

```cpp
#include <hip/hip_runtime.h>
#include <cstdio>
#include <cstdint>
#include <cmath>
namespace pg8 {
#define PG8_LAS __attribute__((address_space(3)))
typedef unsigned short bf16_t;
typedef short bf16x8 __attribute__((ext_vector_type(8)));
typedef float f32x4 __attribute__((ext_vector_type(4)));
typedef unsigned u32x4 __attribute__((ext_vector_type(4)));
constexpr int BM = 256, BK = 64, HALF = 128, HTB = HALF * BK * 2  , STAGE_BYTES = 8 * HTB, NXCD = 8, WGM = 8;

__host__ __device__ __forceinline__ int lds_byte(int r, int c) { const int st = (r >> 4) * 2 + (c >> 5), rr = r & 15, cc = c & 31, ob = rr * 64 + cc * 2; return st * 1024 + (ob ^ (((ob >> 9) & 1) << 5)); }
__host__ __device__ __forceinline__ void stage_rc(int b, int& R, int& C) { const int st = b / 1024, sb = b % 1024, swz = sb ^ (((sb >> 9) & 1) << 5); R = (st >> 1) * 16 + swz / 64; C = (st & 1) * 32 + (swz % 64) / 2; }
__host__ __device__ __forceinline__ int perm32(int rho) { const int n = rho >> 4, i = rho & 15; return 8 * (i >> 2) + 4 * n + (i & 3); }

struct Unit { int pm, pn; };
struct Gemm { const bf16_t* A; const bf16_t* Bt; int M, N, K; };

struct StaticOrder {
    int nM, nN, nwg, G, c;
    __host__ __device__ void init(int M, int N, int G_, int c_) { nM = M / BM; nN = N / BM; nwg = nM * nN; G = G_; c = c_; }
    __host__ __device__ bool next(int i, Unit& u) const {
        const long L = (long)i * G + c; if (L >= nwg) return false;
        int wgid = (int)L; { const int q = nwg / NXCD, r = nwg % NXCD, xcd = wgid % NXCD, off = wgid / NXCD; wgid = (xcd < r ? xcd * (q + 1) : r * (q + 1) + (xcd - r) * q) + off; }
        const int nig = WGM * nN, gid = wgid / nig, fm = gid * WGM, gsz = (nM - fm) < WGM ? (nM - fm) : WGM;
        u.pm = fm + ((wgid % nig) % gsz); u.pn = (wgid % nig) / gsz; return true;
    }
    __device__ __forceinline__ void a_ready(const Unit&) const {}
    __device__ __forceinline__ void done(const Unit&) const {}
};

__device__ __forceinline__ unsigned cvt_pk_bf16(float lo, float hi) { unsigned r; asm volatile("v_cvt_pk_bf16_f32 %0, %1, %2" : "=v"(r) : "v"(lo), "v"(hi)); return r; }
typedef float f32x2 __attribute__((ext_vector_type(2)));
__device__ __forceinline__ f32x2 gelu_pk(f32x2 v) {
    const f32x2 av = __builtin_elementwise_abs(v), d = av * 0.2316418882f + 1.0f;
    f32x2 t; t.x = __builtin_amdgcn_rcpf(d.x); t.y = __builtin_amdgcn_rcpf(d.y);
    f32x2 q = t * 0.5307027145f + (-0.7265760135f); q = q * t + 0.7107068705f; q = q * t + (-0.142248368f); q = q * t + 0.127414796f; q = q * t;
    const f32x2 s = (v * v) * (-0.72134752044f);
    f32x2 e; e.x = __builtin_amdgcn_exp2f(s.x); e.y = __builtin_amdgcn_exp2f(s.y);
    const f32x2 m = v * (q * e), r = v - m;
    f32x2 o; o.x = v.x < 0.f ? m.x : r.x; o.y = v.y < 0.f ? m.y : r.y; return o;
}

template <int ACT  > struct EpiBf16 {
    static constexpr bool PERM = true, AFTER_DRAIN = false, PROBE = false; static_assert(ACT == 0 || ACT == 1, "EpiBf16: ACT is 0 (none) or 1 (gelu_pk)");
    bf16_t* O; int ldc; const float* bias; int split_cols; size_t split_stride; float scale0;
    static constexpr bool HAS_RS = false; const float* rs_rows(const Unit&) const { return nullptr; }
    __device__ __forceinline__ void load_rs(const PG8_LAS float*, int, int, float (&)[8]) const {}
    __device__ __forceinline__ void operator()(const f32x4 (&acc)[2][2][4][2], const Unit& u, int wr, int wc, int fr, int fq, const float (&)[8]) const {
        const int row0 = u.pm * BM + wr * 64 + fr; int colt = u.pn * BM; bf16_t* base = O;
        float sc = 1.f; if (split_cols) { const int t = colt / split_cols; base += (size_t)t * split_stride; colt -= t * split_cols; if (t == 0) sc = scale0; }
        const int col0 = colt + wc * 32 + 8 * fq, bcol0 = u.pn * BM + wc * 32 + 8 * fq;
        f32x4 bv[2][2];
#pragma unroll
        for (int bj = 0; bj < 2; ++bj)
#pragma unroll
            for (int n = 0; n < 2; ++n) bv[bj][n] = bias ? *(const f32x4*)(bias + bcol0 + bj * HALF + 4 * n) : (f32x4){0.f, 0.f, 0.f, 0.f};
#pragma unroll
        for (int ai = 0; ai < 2; ++ai)
#pragma unroll
            for (int m = 0; m < 4; ++m) { bf16_t* rowp = base + (size_t)(row0 + ai * HALF + m * 16) * ldc + col0;
#pragma unroll
                for (int bj = 0; bj < 2; ++bj) { f32x4 v0 = acc[ai][bj][m][0] + bv[bj][0], v1 = acc[ai][bj][m][1] + bv[bj][1];
                    if (ACT == 1) { f32x2 a = gelu_pk((f32x2){v0[0], v0[1]}), b = gelu_pk((f32x2){v0[2], v0[3]}), c = gelu_pk((f32x2){v1[0], v1[1]}), d = gelu_pk((f32x2){v1[2], v1[3]});
                        v0 = (f32x4){a.x, a.y, b.x, b.y}; v1 = (f32x4){c.x, c.y, d.x, d.y}; }
                    v0 = v0 * sc; v1 = v1 * sc; u32x4 w; w.x = cvt_pk_bf16(v0[0], v0[1]); w.y = cvt_pk_bf16(v0[2], v0[3]); w.z = cvt_pk_bf16(v1[0], v1[1]); w.w = cvt_pk_bf16(v1[2], v1[3]);
                    *(u32x4*)(rowp + bj * HALF) = w; } }
    }
};
__device__ __forceinline__ float sigmoid_f(float x) { return __builtin_amdgcn_rcpf(1.0f + __builtin_amdgcn_exp2f(-1.4426950408889634f * x)); }
__device__ __forceinline__ float gelu_tanh_f(float x) { const float t = x * __builtin_fmaf(-0.10294324f, x * x, -2.3022082f); return x * __builtin_amdgcn_rcpf(1.0f + __builtin_amdgcn_exp2f(t)); }
struct EpiSwiglu {
    static constexpr bool PERM = true, AFTER_DRAIN = false, PROBE = true;
    bf16_t* O; int ldc; const float* rs;
    static constexpr bool HAS_RS = true;
    __device__ __forceinline__ const float* rs_rows(const Unit& u) const { return rs + u.pm * BM; }
    __device__ __forceinline__ void load_rs(const PG8_LAS float* tbl, int wr, int fr, float (&rsv)[8]) const {
#pragma unroll
        for (int ai = 0; ai < 2; ++ai)
#pragma unroll
            for (int m = 0; m < 4; ++m) rsv[ai * 4 + m] = tbl[wr * 64 + fr + ai * HALF + m * 16]; }
    __device__ __forceinline__ void operator()(const f32x4 (&acc)[2][2][4][2], const Unit& u, int wr, int wc, int fr, int fq, const float (&rsv)[8]) const {
        const int row0 = u.pm * BM + wr * 64 + fr, col0 = u.pn * HALF + wc * 32 + 8 * fq;
#pragma unroll
        for (int ai = 0; ai < 2; ++ai)
#pragma unroll
            for (int m = 0; m < 4; ++m) { bf16_t* rowp = O + (size_t)(row0 + ai * HALF + m * 16) * ldc + col0; const float r = rsv[ai * 4 + m];
                const float c1 = -1.4426950408889634f * r, r2 = r * r; unsigned ow[4];
#pragma unroll
                for (int n = 0; n < 2; ++n)
#pragma unroll
                    for (int h = 0; h < 2; ++h) { const f32x2 g = {acc[ai][0][m][n][2 * h], acc[ai][0][m][n][2 * h + 1]}, up = {acc[ai][1][m][n][2 * h], acc[ai][1][m][n][2 * h + 1]};
                        f32x2 t = g * c1; t.x = __builtin_amdgcn_exp2f(t.x); t.y = __builtin_amdgcn_exp2f(t.y);
                        const f32x2 d = t + 1.0f; f32x2 rc; rc.x = __builtin_amdgcn_rcpf(d.x); rc.y = __builtin_amdgcn_rcpf(d.y);
                        const f32x2 p = ((g * up) * r2) * rc;
                        ow[2 * n + h] = cvt_pk_bf16(p.x, p.y); }
                u32x4 w; w.x = ow[0]; w.y = ow[1]; w.z = ow[2]; w.w = ow[3];
                *(u32x4*)rowp = w; }
    }
};
struct EpiGeluStats {
    static constexpr bool PERM = true, AFTER_DRAIN = false, PROBE = false;
    bf16_t* U; bf16_t* V; float* stats; const float* rs;
    static constexpr bool HAS_RS = true;
    __device__ __forceinline__ const float* rs_rows(const Unit& u) const { return rs + u.pm * BM; }
    __device__ __forceinline__ void load_rs(const PG8_LAS float* tbl, int wr, int fr, float (&rsv)[8]) const {
#pragma unroll
        for (int ai = 0; ai < 2; ++ai)
#pragma unroll
            for (int m = 0; m < 4; ++m) rsv[ai * 4 + m] = tbl[wr * 64 + fr + ai * HALF + m * 16]; }
    __device__ __forceinline__ void operator()(const f32x4 (&acc)[2][2][4][2], const Unit& u, int wr, int wc, int fr, int fq, const float (&rsv)[8]) const {
        const bool isv = u.pn >= 8; bf16_t* base = isv ? V : U;
        const int row0 = u.pm * BM + wr * 64 + fr, col0 = (u.pn & 7) * BM + wc * 32 + 8 * fq;
#pragma unroll
        for (int ai = 0; ai < 2; ++ai)
#pragma unroll
            for (int m = 0; m < 4; ++m) { const int row = row0 + ai * HALF + m * 16; bf16_t* rowp = base + (size_t)row * 2048 + col0; f32x2 s2 = {0.f, 0.f}, q2 = {0.f, 0.f}; const float r = rsv[ai * 4 + m];
#pragma unroll
                for (int bj = 0; bj < 2; ++bj) { unsigned ow[4];
#pragma unroll
                    for (int n = 0; n < 2; ++n)
#pragma unroll
                        for (int h = 0; h < 2; ++h) { const f32x2 a = {acc[ai][bj][m][n][2 * h], acc[ai][bj][m][n][2 * h + 1]};
                            const f32x2 x = a * r, x2 = x * x;
                            f32x2 t = x * (x2 * (-0.10294324f) + (-2.3022082f)); t.x = __builtin_amdgcn_exp2f(t.x); t.y = __builtin_amdgcn_exp2f(t.y);
                            const f32x2 d = t + 1.0f; f32x2 rc; rc.x = __builtin_amdgcn_rcpf(d.x); rc.y = __builtin_amdgcn_rcpf(d.y);
                            const f32x2 v = x * rc;
                            s2 += v; q2 += v * v;
                            ow[2 * n + h] = cvt_pk_bf16(v.x, v.y); }
                    u32x4 w; w.x = ow[0]; w.y = ow[1]; w.z = ow[2]; w.w = ow[3];
                    *(u32x4*)(rowp + bj * HALF) = w; }
                if (isv) { float s = s2.x + s2.y, q = q2.x + q2.y; s += __shfl_xor(s, 16); s += __shfl_xor(s, 32); q += __shfl_xor(q, 16); q += __shfl_xor(q, 32);
                    if (fq == 0) { f32x2 sq; sq.x = s; sq.y = q; *(f32x2*)(stats + ((size_t)row * 32 + (u.pn - 8) * 4 + wc) * 2) = sq; } } }
    }
};
struct EpiBf16R {
    static constexpr bool PERM = true, AFTER_DRAIN = false, PROBE = false;
    bf16_t* O; int ldc; const float* rs; bf16_t* KT;
    static constexpr bool HAS_RS = true;
    __device__ __forceinline__ const float* rs_rows(const Unit& u) const { return rs + u.pm * BM; }
    __device__ __forceinline__ void load_rs(const PG8_LAS float* tbl, int wr, int fr, float (&rsv)[8]) const {
#pragma unroll
        for (int ai = 0; ai < 2; ++ai)
#pragma unroll
            for (int m = 0; m < 4; ++m) rsv[ai * 4 + m] = tbl[wr * 64 + fr + ai * HALF + m * 16]; }
    __device__ __forceinline__ void operator()(const f32x4 (&acc)[2][2][4][2], const Unit& u, int wr, int wc, int fr, int fq, const float (&rsv)[8]) const {
        const int row0 = u.pm * BM + wr * 64 + fr, col0 = u.pn * BM + wc * 32 + 8 * fq;
        const bool kt = (u.pn == 3) && (wc < 2);
#pragma unroll
        for (int ai = 0; ai < 2; ++ai)
#pragma unroll
            for (int m = 0; m < 4; ++m) { const int row = row0 + ai * HALF + m * 16; bf16_t* rowp = O + (size_t)row * ldc + col0; const float r = rsv[ai * 4 + m];
#pragma unroll
                for (int bj = 0; bj < 2; ++bj) { const f32x4 v0 = acc[ai][bj][m][0] * r, v1 = acc[ai][bj][m][1] * r;
                    u32x4 w; w.x = cvt_pk_bf16(v0[0], v0[1]); w.y = cvt_pk_bf16(v0[2], v0[3]); w.z = cvt_pk_bf16(v1[0], v1[1]); w.w = cvt_pk_bf16(v1[2], v1[3]);
                    *(u32x4*)(rowp + bj * HALF) = w;
                    if (kt && bj == 1) { const int dimc = 32 * wc + 8 * fq, bb = row >> 13, tt = row & 8191;
                        *(u32x4*)(KT + ((((size_t)(bb * 256 + (tt >> 5)) * 4 + (dimc >> 4)) * 2 + ((dimc >> 3) & 1)) * 32 + (tt & 31)) * 8) = w; } } }
    }
};
template <class Epi, class Sched, bool ALIGN_EPI = false, bool SP2 = false>
__device__ __forceinline__ void gemm_phase(PG8_LAS unsigned char* lds, const Gemm g, const Sched& S, const Epi& E, const int wave_id) {
    int lane_; asm volatile("v_mbcnt_lo_u32_b32 %0, -1, 0\n\tv_mbcnt_hi_u32_b32 %0, -1, %0" : "=v"(lane_)); int tid_ = (wave_id << 6) | lane_;
    const int tid = tid_, wid = __builtin_amdgcn_readfirstlane(tid >> 6), lane = tid & 63, wr = wid >> 2, wc = wid & 3, fr = lane & 15, fq = lane >> 4;
    const int K = g.K, nt = K / BK;
    unsigned voffA[2], voffB[2];
#pragma unroll
    for (int i = 0; i < 2; ++i) { int R, C; stage_rc(tid * 16 + i * 8192, R, C); const int Rb = Epi::PERM ? ((R & ~31) + perm32(R & 31)) : R;
        voffA[i] = (unsigned)(R * K + C) * 2u; voffB[i] = (unsigned)(Rb * K + C) * 2u; }
    const size_t kstep = (size_t)(BK * 2);
    const size_t hstep = (size_t)HALF * K * 2;
    const size_t tstep = 2 * hstep;
    const unsigned ldsw = (unsigned)wid * 1024u;
    const int aoff = lds_byte(wr * 64 + fr, fq * 8), boff = lds_byte(wc * 32 + fr, fq * 8);
#define PG8_SA(b, h) (((b) * 2 + (h)) * HTB)
#define PG8_SB(b, h) ((4 + (b) * 2 + (h)) * HTB)
#define PG8_STAGE(bufoff, gbase, voff) do { _Pragma("unroll") for (int _i = 0; _i < 2; ++_i) \
        __builtin_amdgcn_global_load_lds((const unsigned*)((const char*)(gbase) + (voff)[_i]), (PG8_LAS unsigned*)(lds + (bufoff) + ldsw + _i * 8192), 16, 0, 0); } while (0)
#define PG8_LDA(dst, b, h) do { _Pragma("unroll") for (int m = 0; m < 4; ++m) _Pragma("unroll") for (int k = 0; k < 2; ++k) dst[m][k] = *(const PG8_LAS bf16x8*)(lds + PG8_SA(b, h) + aoff + m * 2048 + k * 1024); } while (0)
#define PG8_LDB(dst, b, h) do { _Pragma("unroll") for (int n = 0; n < 2; ++n) _Pragma("unroll") for (int k = 0; k < 2; ++k) dst[n][k] = *(const PG8_LAS bf16x8*)(lds + PG8_SB(b, h) + boff + n * 2048 + k * 1024); } while (0)
#define PG8_MMA(ai, bj, At, Bt) do { __builtin_amdgcn_s_setprio(1); _Pragma("unroll") for (int m = 0; m < 4; ++m) _Pragma("unroll") for (int n = 0; n < 2; ++n) _Pragma("unroll") for (int k = 0; k < 2; ++k) \
        acc[ai][bj][m][n] = __builtin_amdgcn_mfma_f32_16x16x32_bf16(Bt[n][k], At[m][k], acc[ai][bj][m][n], 0, 0, 0); __builtin_amdgcn_s_setprio(0); } while (0)
#define PG8_WAIT_V(n) asm volatile("s_waitcnt vmcnt(" #n ")" ::: "memory")
#define PG8_WAIT_L(n) asm volatile("s_waitcnt lgkmcnt(" #n ")" ::: "memory")
#define PG8_BAR __builtin_amdgcn_s_barrier()
#define PG8_SCHED __builtin_amdgcn_sched_barrier(0)
    Unit cur, nxt; int ui = 0;
    if (!S.next(0, cur)) return;
    f32x4 acc[2][2][4][2];
#pragma unroll
    for (int a = 0; a < 2; ++a)
#pragma unroll
        for (int b = 0; b < 2; ++b)
#pragma unroll
            for (int m = 0; m < 4; ++m)
#pragma unroll
                for (int n = 0; n < 2; ++n) acc[a][b][m][n] = (f32x4){0.f, 0.f, 0.f, 0.f};
    bf16x8 At[4][2], B0[2][2], B1[2][2];
    const char* cA = (const char*)g.A + (size_t)cur.pm * tstep; const char* cB = (const char*)g.Bt + (size_t)cur.pn * tstep;
    S.a_ready(cur);
    constexpr int RSTAB = 132096;
    int rslot = 0;
#define PG8_STAGE_RS(u, slot) do { if constexpr (Epi::HAS_RS) __builtin_amdgcn_global_load_lds((const unsigned*)(E.rs_rows(u) + (wid & 3) * 64 + lane), (PG8_LAS unsigned*)(lds + RSTAB + (slot) * 1024 + (wid & 3) * 256), 4, 0, 0); } while (0)
    PG8_STAGE_RS(cur, 0);
    if constexpr (SP2) {
        PG8_STAGE(PG8_SB(0, 0), cB, voffB); PG8_STAGE(PG8_SB(0, 1), cB + hstep, voffB); PG8_STAGE(PG8_SA(0, 0), cA, voffA); PG8_STAGE(PG8_SA(0, 1), cA + hstep, voffA);
        if (wr == 1) PG8_BAR;
        PG8_WAIT_V(2); PG8_BAR;
        PG8_STAGE(PG8_SB(1, 0), cB + kstep, voffB); PG8_STAGE(PG8_SA(1, 0), cA + kstep, voffA); PG8_STAGE(PG8_SB(1, 1), cB + hstep + kstep, voffB);
        PG8_WAIT_V(6); PG8_BAR;
    } else {
        PG8_STAGE(PG8_SB(0, 0), cB, voffB); PG8_STAGE(PG8_SA(0, 0), cA, voffA); PG8_STAGE(PG8_SB(0, 1), cB + hstep, voffB); PG8_STAGE(PG8_SA(0, 1), cA + hstep, voffA);
        if (wr == 1) PG8_BAR;
        PG8_WAIT_V(4); PG8_BAR;
        PG8_STAGE(PG8_SB(1, 0), cB + kstep, voffB); PG8_STAGE(PG8_SA(1, 0), cA + kstep, voffA); PG8_STAGE(PG8_SB(1, 1), cB + hstep + kstep, voffB);
        PG8_WAIT_V(6); PG8_BAR;
    }
#ifdef KT_PROBE
    unsigned long long pc0 = 0, pc4 = 0; unsigned pall = 0, pss = 0, pn = 0;
#endif
    for (;;) {
        const bool has_next = S.next(ui + 1, nxt);
        const int rslot_n = rslot == 2 ? 0 : rslot + 1;
        if (has_next) PG8_STAGE_RS(nxt, rslot_n);
        const char* nA = has_next ? (const char*)g.A + (size_t)nxt.pm * tstep : cA; const char* nB = has_next ? (const char*)g.Bt + (size_t)nxt.pn * tstep : cB;
#ifdef KT_PROBE
        if constexpr (Epi::PROBE) pc0 = __builtin_amdgcn_s_memtime();
#endif
        for (int t = 0; t < nt; t += 2) {
#ifdef KT_PROBE
            if constexpr (Epi::PROBE) if (t == 4) pc4 = __builtin_amdgcn_s_memtime();
#endif
            const bool last = (t == nt - 2);
            const char* a1 = cA + (size_t)(t + 1) * kstep;
            const char* a2 = last ? nA : cA + (size_t)(t + 2) * kstep; const char* b2 = last ? nB : cB + (size_t)(t + 2) * kstep;
            const char* a3 = a2 + kstep; const char* b3 = b2 + kstep;
            if (last && has_next) S.a_ready(nxt);
            if constexpr (SP2) {
            PG8_LDB(B0, 0, 0); PG8_LDB(B1, 0, 1); PG8_SCHED; PG8_LDA(At, 0, 0); PG8_STAGE(PG8_SA(1, 1), a1 + hstep, voffA);
            PG8_WAIT_V(8); PG8_WAIT_L(0); PG8_BAR; PG8_MMA(0, 0, At, B0); PG8_MMA(0, 1, At, B1); PG8_BAR; PG8_SCHED;
            PG8_LDA(At, 0, 1); PG8_STAGE(PG8_SB(0, 0), b2, voffB); PG8_STAGE(PG8_SB(0, 1), b2 + hstep, voffB); PG8_STAGE(PG8_SA(0, 0), a2, voffA);
            PG8_WAIT_V(8); PG8_WAIT_L(0); PG8_BAR; PG8_MMA(1, 0, At, B0); PG8_MMA(1, 1, At, B1); PG8_BAR; PG8_SCHED;
            PG8_LDB(B0, 1, 0); PG8_LDB(B1, 1, 1); PG8_SCHED; PG8_LDA(At, 1, 0); PG8_STAGE(PG8_SA(0, 1), a2 + hstep, voffA);
            PG8_WAIT_V(8); PG8_WAIT_L(0); PG8_BAR; PG8_MMA(0, 0, At, B0); PG8_MMA(0, 1, At, B1); PG8_BAR; PG8_SCHED;
            PG8_LDA(At, 1, 1); PG8_STAGE(PG8_SB(1, 0), b3, voffB); PG8_STAGE(PG8_SB(1, 1), b3 + hstep, voffB); PG8_STAGE(PG8_SA(1, 0), a3, voffA);
            PG8_WAIT_V(8); PG8_WAIT_L(0); PG8_BAR; PG8_MMA(1, 0, At, B0); PG8_MMA(1, 1, At, B1); PG8_BAR; PG8_SCHED;
            } else {
            PG8_LDB(B0, 0, 0); PG8_SCHED; PG8_LDA(At, 0, 0); PG8_STAGE(PG8_SA(1, 1), a1 + hstep, voffA);
            PG8_WAIT_L(8); PG8_BAR; PG8_WAIT_L(0); PG8_MMA(0, 0, At, B0); PG8_BAR; PG8_SCHED;
            PG8_LDB(B1, 0, 1); PG8_STAGE(PG8_SB(0, 0), b2, voffB);
            PG8_BAR; PG8_WAIT_L(0); PG8_MMA(0, 1, At, B1); PG8_BAR;
            PG8_LDA(At, 0, 1); PG8_STAGE(PG8_SA(0, 0), a2, voffA);
            PG8_BAR; PG8_WAIT_L(0); PG8_MMA(1, 0, At, B0); PG8_BAR; PG8_SCHED;
            PG8_STAGE(PG8_SB(0, 1), b2 + hstep, voffB);
            PG8_WAIT_V(6); PG8_BAR; PG8_MMA(1, 1, At, B1); PG8_BAR;
            PG8_LDB(B0, 1, 0); PG8_SCHED; PG8_LDA(At, 1, 0); PG8_STAGE(PG8_SA(0, 1), a2 + hstep, voffA);
            PG8_WAIT_L(8); PG8_BAR; PG8_WAIT_L(0); PG8_MMA(0, 0, At, B0); PG8_BAR; PG8_SCHED;
            PG8_LDB(B1, 1, 1); PG8_STAGE(PG8_SB(1, 0), b3, voffB);
            PG8_BAR; PG8_WAIT_L(0); PG8_MMA(0, 1, At, B1); PG8_BAR;
            PG8_LDA(At, 1, 1); PG8_STAGE(PG8_SA(1, 0), a3, voffA);
            PG8_BAR; PG8_WAIT_L(0); PG8_MMA(1, 0, At, B0); PG8_BAR; PG8_SCHED;
            PG8_STAGE(PG8_SB(1, 1), b3 + hstep, voffB);
            PG8_WAIT_V(6); PG8_BAR; PG8_MMA(1, 1, At, B1); PG8_BAR;
            }
        }
#ifdef KT_PROBE
        if constexpr (Epi::PROBE) { const unsigned long long pe = __builtin_amdgcn_s_memtime(); pall += (unsigned)(pe - pc0); pss += (unsigned)(pe - pc4); ++pn; }
#endif
        if constexpr (ALIGN_EPI) { if (wr == 0) PG8_BAR; }
        if constexpr (!Epi::AFTER_DRAIN) { float rsv[8]; E.load_rs((const PG8_LAS float*)(lds + RSTAB + rslot * 1024), wr, fr, rsv); E(acc, cur, wr, wc, fr, fq, rsv); S.done(cur); }
        if (!has_next) break;
#pragma unroll
        for (int a = 0; a < 2; ++a)
#pragma unroll
            for (int b = 0; b < 2; ++b)
#pragma unroll
                for (int m = 0; m < 4; ++m)
#pragma unroll
                    for (int n = 0; n < 2; ++n) acc[a][b][m][n] = (f32x4){0.f, 0.f, 0.f, 0.f};
        cur = nxt; cA = nA; cB = nB; ++ui; rslot = rslot_n;
        if constexpr (ALIGN_EPI) { if (wr == 1) PG8_BAR; }
    }
#ifdef KT_PROBE
    if constexpr (Epi::PROBE) if (tid == 0) { PG8_LAS unsigned* pw = (PG8_LAS unsigned*)(lds + 131072 + 384); pw[0] += pall; pw[1] += pss; pw[2] += pn; }
#endif
    PG8_WAIT_V(0);
    if constexpr (!ALIGN_EPI) { if (wr == 0) PG8_BAR; }
    PG8_BAR;
    if constexpr (Epi::AFTER_DRAIN) { E.fused(acc, cur, wr, wc, fr, fq, lds, wid, lane); S.done(cur); }
#undef PG8_SA
#undef PG8_SB
#undef PG8_STAGE
#undef PG8_LDA
#undef PG8_LDB
#undef PG8_MMA
#undef PG8_WAIT_V
#undef PG8_WAIT_L
#undef PG8_BAR
#undef PG8_SCHED
#undef PG8_STAGE_RS
}
}
#ifndef PG8_SP2
#define PG8_SP2 true
#endif
#ifndef PG8_ALIGN
#define PG8_ALIGN true
#endif
#define GAS __attribute__((address_space(1)))
#define LAS __attribute__((address_space(3)))
typedef unsigned short bf16;
typedef unsigned v4u __attribute__((ext_vector_type(4)));
typedef float f32x4 __attribute__((ext_vector_type(4)));
typedef short bf16x8 __attribute__((ext_vector_type(8)));
typedef GAS unsigned gu32;
typedef GAS unsigned long long gu64;
#define RLX_AGENT __ATOMIC_RELAXED, __HIP_MEMORY_SCOPE_AGENT
#define LDS_WAIT() asm volatile("s_waitcnt lgkmcnt(0)" ::: "memory")
#define VM_WAIT() asm volatile("s_waitcnt vmcnt(0)" ::: "memory")
__device__ __forceinline__ unsigned long long rt() { return __builtin_amdgcn_s_memrealtime(); }
__device__ __forceinline__ unsigned f2bf(float f) { unsigned u = __builtin_bit_cast(unsigned, f); return (u + 0x7fffu + ((u >> 16) & 1u)) >> 16; }
__device__ __forceinline__ unsigned pk2(float lo, float hi) { return f2bf(lo) | (f2bf(hi) << 16); }

#define XB_TMO      128
#define XB_XCNT(j)  (256  + 64 * (j))
#define XB_XSUB(j)  (1280 + 64 * (j))
#define XB_XGEN(j)  (2304 + 64 * (j))
#define XB_TOP      3328
#define XB_TOPGEN   3392
#define XCD_BAR_WORDS 3456
#define XB_SPIN_CAP (1u << 18)

__device__ __forceinline__ unsigned xb_ld(unsigned* p)              { return __hip_atomic_load(p, __ATOMIC_RELAXED, __HIP_MEMORY_SCOPE_AGENT); }
__device__ __forceinline__ unsigned xb_add(unsigned* p, unsigned v) { return __hip_atomic_fetch_add(p, v, __ATOMIC_RELAXED, __HIP_MEMORY_SCOPE_AGENT); }
__device__ __forceinline__ unsigned xb_xcc_id() { return (unsigned)__builtin_amdgcn_s_getreg((3 << 11) | 20) & 0xFu; }
#define XB_SPIN(cond, bar) do { unsigned _sp = 0; while (cond) { __builtin_amdgcn_s_sleep(1); \
    if ((++_sp & 255u) == 0u) { if (xb_ld(&(bar)[XB_TMO])) break; if (_sp > XB_SPIN_CAP) { atomicAdd(&(bar)[XB_TMO], 1u); break; } } } } while (0)

struct XcdBarrier {
    unsigned* bar; unsigned x;
    volatile LAS unsigned* st;
};

__device__ __forceinline__ XcdBarrier xcd_barrier_post(unsigned* bar, volatile LAS unsigned* st) {
    XcdBarrier b; b.bar = bar; b.x = xb_xcc_id(); b.st = st;
    if (threadIdx.x == 0) (void)xb_add(&bar[XB_XCNT(b.x)], 1u);
    return b;
}
__device__ __forceinline__ void xcd_barrier_complete(unsigned* bar, unsigned x, unsigned& nloc, unsigned& nx) {
    const unsigned G = gridDim.x * gridDim.y * gridDim.z;
    unsigned sum, cnt, mine, sp = 0u;
    for (;;) {
        sum = 0u; cnt = 0u; mine = 0u;
#pragma unroll
        for (unsigned j = 0; j < 16; ++j) { const unsigned c = xb_ld(&bar[XB_XCNT(j)]); sum += c; cnt += (c > 0u) ? 1u : 0u; mine = (j == x) ? c : mine; }
        if (sum == G) break;
        __builtin_amdgcn_s_sleep(1);
        if ((++sp & 255u) == 0u) { if (xb_ld(&bar[XB_TMO])) break; if (sp > XB_SPIN_CAP) { atomicAdd(&bar[XB_TMO], 1u); break; } }
    }
    nloc = mine > 0u ? mine : 1u; nx = cnt > 0u ? cnt : 1u;
}

__device__ __forceinline__ void xcd_barrier(const XcdBarrier& b) {
    asm volatile("s_waitcnt vmcnt(0)" ::: "memory");
    __syncthreads();
    if (threadIdx.x == 0) {
        unsigned* bar = b.bar;
        __builtin_amdgcn_s_waitcnt(0);
        unsigned nloc = b.st[0], nx = b.st[1];
        if (nloc == 0u) { xcd_barrier_complete(bar, b.x, nloc, nx); b.st[0] = nloc; b.st[1] = nx; }
        const unsigned old = xb_add(&bar[XB_XSUB(b.x)], 1u);
        const unsigned gen = old / nloc;
        if (old + 1u == (gen + 1u) * nloc) {
            __builtin_amdgcn_fence(__ATOMIC_RELEASE, "agent");
            asm volatile("s_waitcnt vmcnt(0)" ::: "memory");
            const unsigned og = xb_add(&bar[XB_TOP], 1u);
            const unsigned tg = og / nx;
            if (og + 1u == (tg + 1u) * nx) xb_add(&bar[XB_TOPGEN], 1u);
            else XB_SPIN(xb_ld(&bar[XB_TOPGEN]) == tg, bar);
            __builtin_amdgcn_fence(__ATOMIC_ACQUIRE, "agent");
            xb_add(&bar[XB_XGEN(b.x)], 1u);
            asm volatile("s_waitcnt vmcnt(0)" ::: "memory");
        } else {
            XB_SPIN(xb_ld(&bar[XB_XGEN(b.x)]) == gen, bar);
            __builtin_amdgcn_fence(__ATOMIC_ACQUIRE, "agent");
            asm volatile("s_waitcnt vmcnt(0)" ::: "memory");
        }
    }
    __syncthreads();
}
constexpr int NWAVES = 8;
constexpr int BATCH = 4, SEQ = 8192, DM = 1024, M = BATCH * SEQ, DEPTH = 4;
constexpr int PP = 2560;
constexpr int QA_OFF = 0, KA_OFF = 512, VA_OFF = 576, QI_OFF = 640, KI_OFF = 896, QB_OFF = 960, KB_OFF = 1472, VB_OFF = 1984, WI_OFF = 2496;
constexpr int EVEN_IN = 2500, DFF = 2816, CWID = 2048, TOPK = 256;
constexpr float EPS = 1e-6f;
constexpr int N_PHASES = 1 + 7 * DEPTH;

constexpr size_t MiB = 1u << 20;
constexpr size_t WS_CTL = 0, CTL_ZERO_BYTES = 64 * 1024;
constexpr size_t WS_WINE = 1 * MiB, WS_WOUTE = 11 * MiB, WS_WINO = 15 * MiB, WS_WOUTO = 31 * MiB, WS_WFFI = 39 * MiB, WS_WFFO = 83 * MiB, WS_WSP = 105 * MiB;
constexpr size_t WS_STATS = 106 * MiB, WS_A = 114 * MiB, WS_R1 = 178 * MiB, WS_Y = WS_R1 + 192 * MiB, WS_KT = 434 * MiB, WS_END = 438 * MiB;
constexpr size_t SZ_WINE = (size_t)PP * DM * 2, SZ_WOUTE = (size_t)DM * DM * 2, SZ_WINO = (size_t)4096 * DM * 2, SZ_WOUTO = (size_t)DM * CWID * 2, SZ_WFFI = (size_t)2 * DFF * DM * 2, SZ_WFFO = (size_t)DM * DFF * 2, SZ_WSP = (size_t)16 * 128 * 128 * 2;
static_assert(WS_WINE + 2 * SZ_WINE <= WS_WOUTE && WS_WOUTE + 2 * SZ_WOUTE <= WS_WINO && WS_WINO + 2 * SZ_WINO <= WS_WOUTO && WS_WOUTO + 2 * SZ_WOUTO <= WS_WFFI && WS_WFFI + 4 * SZ_WFFI <= WS_WFFO && WS_WFFO + 4 * SZ_WFFO <= WS_WSP && WS_WSP + 2 * SZ_WSP <= WS_STATS, "weights map");
static_assert(WS_STATS + (size_t)M * 32 * 8 <= WS_A && WS_A + (size_t)M * DM * 2 <= WS_R1 && WS_R1 + (size_t)M * PP * 2 <= WS_Y && WS_R1 + (size_t)M * DFF * 2 <= WS_Y && WS_Y + (size_t)M * DM * 2 <= WS_KT && WS_KT + (size_t)M * 64 * 2 <= WS_END, "activation map");
constexpr int CW_BAR = 4096;

constexpr int RING_OFF = 0, RING_BYTES = 131072;
constexpr int LDSCTL_OFF = RING_BYTES, MISC_OFF = LDSCTL_OFF + 320;
constexpr int LDS_BYTES = 147456;
constexpr int LIST_OFF = RING_BYTES + 1024;
constexpr int LB_OFF = RING_BYTES + 512;
constexpr int HIST_OFF = LIST_OFF + 4096;
static_assert(HIST_OFF + 8192 <= LDS_BYTES, "LDS map");

typedef float f32x16 __attribute__((ext_vector_type(16)));
typedef __bf16 bf16x2_t __attribute__((ext_vector_type(2)));
typedef unsigned u32x2 __attribute__((ext_vector_type(2)));
typedef float f32x2 __attribute__((ext_vector_type(2)));

__device__ __forceinline__ f32x16 zero16() { f32x16 z;
#pragma unroll
    for (int i = 0; i < 16; ++i) z[i] = 0.f;
    asm volatile("" : "+v"(z)); return z; }
__device__ __forceinline__ float bflo(unsigned u) { return __uint_as_float(u << 16); }
__device__ __forceinline__ float bfhi(unsigned u) { return __uint_as_float(u & 0xffff0000u); }
__device__ __forceinline__ unsigned cvtpk(float lo, float hi) { const f32x2 v = {lo, hi}; const bf16x2_t b = __builtin_convertvector(v, bf16x2_t); return __builtin_bit_cast(unsigned, b); }
#define DPP_ADD(V, CTRL, RMASK) V += __builtin_bit_cast(float, __builtin_amdgcn_update_dpp(0, __builtin_bit_cast(int, V), CTRL, RMASK, 0xf, false))
__device__ __forceinline__ float wave_sum(float v) {
    DPP_ADD(v, 0x111, 0xf); DPP_ADD(v, 0x112, 0xf); DPP_ADD(v, 0x114, 0xf); DPP_ADD(v, 0x118, 0xf); DPP_ADD(v, 0x142, 0xa); DPP_ADD(v, 0x143, 0xc);
    return __builtin_bit_cast(float, __builtin_amdgcn_readlane(__builtin_bit_cast(int, v), 63));
}
__device__ __forceinline__ float xsum32(float v) { const auto rr = __builtin_amdgcn_permlane32_swap(__float_as_uint(v), __float_as_uint(v), false, false); return __uint_as_float(rr[0]) + __uint_as_float(rr[1]); }
__device__ __forceinline__ float xsum16(float v) { const auto rr = __builtin_amdgcn_permlane16_swap(__float_as_uint(v), __float_as_uint(v), false, false); return __uint_as_float(rr[0]) + __uint_as_float(rr[1]); }
__device__ __forceinline__ float xmax32(float v) { const auto rr = __builtin_amdgcn_permlane32_swap(__float_as_uint(v), __float_as_uint(v), false, false); return fmaxf(__uint_as_float(rr[0]), __uint_as_float(rr[1])); }
__device__ __forceinline__ float xmax16(float v) { const auto rr = __builtin_amdgcn_permlane16_swap(__float_as_uint(v), __float_as_uint(v), false, false); return fmaxf(__uint_as_float(rr[0]), __uint_as_float(rr[1])); }
__device__ __forceinline__ float wave_max(float v) {
#pragma unroll
    for (int o = 1; o < 64; o <<= 1) v = fmaxf(v, __shfl_xor(v, o));
    return v;
}
__device__ __forceinline__ unsigned wave_sum_u(unsigned v) {
#pragma unroll
    for (int o = 1; o < 64; o <<= 1) v += (unsigned)__shfl_xor((int)v, o);
    return v;
}

struct Frame {
    LAS unsigned char* lds;
    volatile LAS unsigned* MISC;
    gu32* ctl;
    int tid, lane, wave, G, c;
    const float *x, *gains, *w_in_even, *w_out_even, *w_in_odd, *spatial_w, *spatial_b, *vgain, *vbias, *w_out_odd, *w_ffn_in, *w_ffn_out;
    float* out;
    bf16 *WinE, *WoutE, *WinO, *WoutO, *Wffi, *Wffo, *Wsp;
    float* stats;
    bf16 *A, *R1, *Y, *MIX, *KT;
    float* RS;
    float* WSUM;
};

__device__ __forceinline__ int src_col(int mode, int d) {
    if (mode == 0) return d;
    if (mode == 1) { if (d < 960) return d; if (d < 2496) return d + 4; if (d < 2500) return d - 2496 + 960; return -1; }
    const int pn = d >> 8, xx = d & 255; return (xx >> 7) * DFF + 128 * pn + (xx & 127);
}
__device__ __forceinline__ void transpose_item(const float* W, int K, int Nsrc, int ND, int mode, bf16* WT, LAS float* scr, int item, int lane, const float* gain = nullptr) {
    const int nblk = ND / 32, kb = item / nblk, nb = item % nblk, k0 = 64 * kb, n0 = 32 * nb;
    const int n4 = 4 * (lane & 7), sc = src_col(mode, n0 + n4);
#pragma unroll
    for (int i = 0; i < 8; ++i) { const int kk = (lane >> 3) + 8 * i; f32x4 v = {0.f, 0.f, 0.f, 0.f};
        if (sc >= 0) v = *(const f32x4*)(W + (size_t)(k0 + kk) * Nsrc + sc) * (gain ? gain[k0 + kk] : 1.0f);
        LAS float* sp = scr + kk * 33 + n4; sp[0] = v.x; sp[1] = v.y; sp[2] = v.z; sp[3] = v.w; }
    LDS_WAIT(); asm volatile("" ::: "memory");
    const int c = lane & 7;
#pragma unroll
    for (int j = 0; j < 4; ++j) { const int n = (lane >> 3) + 8 * j; const LAS float* s = scr + (8 * c) * 33 + n;
        v4u o; o.x = cvtpk(s[0 * 33], s[1 * 33]); o.y = cvtpk(s[2 * 33], s[3 * 33]); o.z = cvtpk(s[4 * 33], s[5 * 33]); o.w = cvtpk(s[6 * 33], s[7 * 33]);
        *(GAS v4u*)(WT + (size_t)(n0 + n) * K + k0 + 8 * c) = o; }
    LDS_WAIT(); asm volatile("" ::: "memory");
}
__device__ __forceinline__ void x_row_to_bf16(const float* xrow, bf16* orow, float* rs, int lane) {
    const f32x4* xr = (const f32x4*)xrow + lane; f32x4 v[4]; float s = 0.f;
#pragma unroll
    for (int j = 0; j < 4; ++j) { v[j] = xr[64 * j]; s += (v[j].x * v[j].x + v[j].y * v[j].y) + (v[j].z * v[j].z + v[j].w * v[j].w); }
    const float r = 1.0f / sqrtf(wave_sum(s) * (1.f / DM) + EPS);
#pragma unroll
    for (int j = 0; j < 4; ++j) { u32x2 o; o.x = cvtpk(v[j].x, v[j].y); o.y = cvtpk(v[j].z, v[j].w); ((u32x2*)orow)[lane + 64 * j] = o; }
    if (lane == 0) *rs = r;
}
template <bool HF32, bool LAST, int R> __device__ __forceinline__ void res_rows(const void* hin, const bf16* yin, const float* gpost, void* hout, float* rs, size_t m0, size_t mstep, int lane) {
    float h[R][2][8], y[R][2][8], s[R];
#pragma unroll
    for (int q = 0; q < R; ++q) { const size_t m = m0 + q * mstep; s[q] = 0.f;
#pragma unroll
        for (int j = 0; j < 2; ++j) {
            if (HF32) { const f32x4* hp = (const f32x4*)((const float*)hin + m * DM); const f32x4 a = hp[2 * lane + 128 * j], c = hp[2 * lane + 128 * j + 1];
                h[q][j][0] = a.x; h[q][j][1] = a.y; h[q][j][2] = a.z; h[q][j][3] = a.w; h[q][j][4] = c.x; h[q][j][5] = c.y; h[q][j][6] = c.z; h[q][j][7] = c.w; }
            else { const v4u hh = ((const v4u*)((const bf16*)hin + m * DM))[lane + 64 * j];
                h[q][j][0] = bflo(hh.x); h[q][j][1] = bfhi(hh.x); h[q][j][2] = bflo(hh.y); h[q][j][3] = bfhi(hh.y); h[q][j][4] = bflo(hh.z); h[q][j][5] = bfhi(hh.z); h[q][j][6] = bflo(hh.w); h[q][j][7] = bfhi(hh.w); }
            const v4u yy = ((const v4u*)(yin + m * DM))[lane + 64 * j];
            y[q][j][0] = bflo(yy.x); y[q][j][1] = bfhi(yy.x); y[q][j][2] = bflo(yy.y); y[q][j][3] = bfhi(yy.y); y[q][j][4] = bflo(yy.z); y[q][j][5] = bfhi(yy.z); y[q][j][6] = bflo(yy.w); y[q][j][7] = bfhi(yy.w);
#pragma unroll
            for (int e = 0; e < 8; ++e) s[q] += y[q][j][e] * y[q][j][e]; } }
    float gp[2][8];
#pragma unroll
    for (int j = 0; j < 2; ++j) { const f32x4 g0 = ((const f32x4*)gpost)[2 * lane + 128 * j], g1 = ((const f32x4*)gpost)[2 * lane + 128 * j + 1];
        gp[j][0] = g0.x; gp[j][1] = g0.y; gp[j][2] = g0.z; gp[j][3] = g0.w; gp[j][4] = g1.x; gp[j][5] = g1.y; gp[j][6] = g1.z; gp[j][7] = g1.w; }
#pragma unroll
    for (int q = 0; q < R; ++q) s[q] = wave_sum(s[q]);
    float s2[R];
#pragma unroll
    for (int q = 0; q < R; ++q) { const size_t m = m0 + q * mstep; const float r = 1.0f / sqrtf(s[q] * (1.f / DM) + EPS); s2[q] = 0.f;
#pragma unroll
        for (int j = 0; j < 2; ++j) {
#pragma unroll
            for (int e = 0; e < 8; ++e) { h[q][j][e] = h[q][j][e] + (y[q][j][e] * r) * gp[j][e]; s2[q] += h[q][j][e] * h[q][j][e]; }
            if (LAST) { f32x4* op = (f32x4*)((float*)hout + m * DM); op[2 * lane + 128 * j] = (f32x4){h[q][j][0], h[q][j][1], h[q][j][2], h[q][j][3]}; op[2 * lane + 128 * j + 1] = (f32x4){h[q][j][4], h[q][j][5], h[q][j][6], h[q][j][7]}; }
            else { v4u o; o.x = cvtpk(h[q][j][0], h[q][j][1]); o.y = cvtpk(h[q][j][2], h[q][j][3]); o.z = cvtpk(h[q][j][4], h[q][j][5]); o.w = cvtpk(h[q][j][6], h[q][j][7]); ((v4u*)((bf16*)hout + m * DM))[lane + 64 * j] = o; } } }
    if (!LAST) {
#pragma unroll
        for (int q = 0; q < R; ++q) { const float r2 = 1.0f / sqrtf(wave_sum(s2[q]) * (1.f / DM) + EPS); if (lane == 0) rs[m0 + q * mstep] = r2; } }
}
constexpr int I_WINE = 16 * 80, I_WOUTE = 16 * 32, I_WINO = 16 * 128, I_WOUTO = 32 * 32, I_WFFI = 16 * 176, I_WFFO = 44 * 32;
__device__ __forceinline__ void p0_prologue(Frame& F) {
    LAS float* scr = (LAS float*)(F.lds + RING_OFF + F.wave * 16384);
    const int gw = F.c * NWAVES + F.wave, NGW = F.G * NWAVES;
    constexpr int NITEMS = 2 * (I_WINE + I_WOUTE + I_WINO + I_WOUTO) + 4 * (I_WFFI + I_WFFO);
    for (int it = gw; it < NITEMS; it += NGW) {
        int r = it;
        if (r < 2 * I_WINE) { const int i = r / I_WINE; r -= i * I_WINE; transpose_item(F.w_in_even + (size_t)i * DM * EVEN_IN, DM, EVEN_IN, PP, 1, F.WinE + (size_t)i * PP * DM, scr, r, F.lane, F.gains + (size_t)(2 * i) * 4 * DM); continue; } r -= 2 * I_WINE;
        if (r < 2 * I_WOUTE) { const int i = r / I_WOUTE; r -= i * I_WOUTE; transpose_item(F.w_out_even + (size_t)i * DM * DM, DM, DM, DM, 0, F.WoutE + (size_t)i * DM * DM, scr, r, F.lane); continue; } r -= 2 * I_WOUTE;
        if (r < 2 * I_WINO) { const int i = r / I_WINO; r -= i * I_WINO; transpose_item(F.w_in_odd + (size_t)i * DM * 4096, DM, 4096, 4096, 0, F.WinO + (size_t)i * 4096 * DM, scr, r, F.lane, F.gains + (size_t)(2 * i + 1) * 4 * DM); continue; } r -= 2 * I_WINO;
        if (r < 2 * I_WOUTO) { const int i = r / I_WOUTO; r -= i * I_WOUTO; transpose_item(F.w_out_odd + (size_t)i * CWID * DM, CWID, DM, DM, 0, F.WoutO + (size_t)i * DM * CWID, scr, r, F.lane); continue; } r -= 2 * I_WOUTO;
        if (r < 4 * I_WFFI) { const int i = r / I_WFFI; r -= i * I_WFFI; transpose_item(F.w_ffn_in + (size_t)i * DM * 2 * DFF, DM, 2 * DFF, 2 * DFF, 2, F.Wffi + (size_t)i * 2 * DFF * DM, scr, r, F.lane, F.gains + (size_t)i * 4 * DM + 2 * DM); continue; } r -= 4 * I_WFFI;
        { const int i = r / I_WFFO; r -= i * I_WFFO; transpose_item(F.w_ffn_out + (size_t)i * DFF * DM, DFF, DM, DM, 0, F.Wffo + (size_t)i * DM * DFF, scr, r, F.lane); }
    }
    for (int idx = (F.c * NWAVES * 64 + F.tid); idx < 2 * 16 * 128 * 128 / 2; idx += F.G * NWAVES * 64) {
        const int e0 = 2 * idx, t = (e0 >> 7) & 127, s = e0 & 127; const f32x2 wv = *(const f32x2*)(F.spatial_w + e0);
        const unsigned pk = cvtpk(s <= t ? wv.x : 0.f, (s + 1) <= t ? wv.y : 0.f); ((unsigned*)F.Wsp)[idx] = pk;
        const float rsum = wave_sum(bflo(pk) + bfhi(pk)); if (F.lane == 0) F.WSUM[idx >> 6] = rsum; }
    for (int m = gw; m < M; m += 2 * NGW) {
        const f32x4* x0 = (const f32x4*)(F.x + (size_t)m * DM) + F.lane; const f32x4* x1 = (const f32x4*)(F.x + (size_t)(m + NGW) * DM) + F.lane;
        f32x4 v0[4], v1[4]; float s0 = 0.f, s1 = 0.f;
#pragma unroll
        for (int j = 0; j < 4; ++j) { v0[j] = x0[64 * j]; v1[j] = x1[64 * j]; }
#pragma unroll
        for (int j = 0; j < 4; ++j) { s0 += (v0[j].x * v0[j].x + v0[j].y * v0[j].y) + (v0[j].z * v0[j].z + v0[j].w * v0[j].w); s1 += (v1[j].x * v1[j].x + v1[j].y * v1[j].y) + (v1[j].z * v1[j].z + v1[j].w * v1[j].w); }
        s0 = wave_sum(s0); s1 = wave_sum(s1);
        u32x2* o0 = (u32x2*)(F.A + (size_t)m * DM) + F.lane; u32x2* o1 = (u32x2*)(F.A + (size_t)(m + NGW) * DM) + F.lane;
#pragma unroll
        for (int j = 0; j < 4; ++j) { u32x2 a; a.x = cvtpk(v0[j].x, v0[j].y); a.y = cvtpk(v0[j].z, v0[j].w); o0[64 * j] = a; u32x2 b; b.x = cvtpk(v1[j].x, v1[j].y); b.y = cvtpk(v1[j].z, v1[j].w); o1[64 * j] = b; }
        if (F.lane == 0) { F.RS[m] = 1.0f / sqrtf(s0 * (1.f / DM) + EPS); F.RS[m + NGW] = 1.0f / sqrtf(s1 * (1.f / DM) + EPS); }
    }
}
template <bool HF32, bool LAST> __device__ __forceinline__ void thin_phase(Frame& F, const float* gpost, bool dry = false) {
    const int gw = F.c * NWAVES + F.wave, NGW = F.G * NWAVES;
    const void* hin = HF32 ? (const void*)F.x : (const void*)F.A;
    void* hout = dry ? (void*)F.R1 : (LAST ? (void*)F.out : (void*)F.A);
    float* rs = dry ? F.stats : F.RS;
    if constexpr (!HF32 && !LAST) { for (int m = gw; m < M; m += NGW) res_rows<HF32, LAST, 1>(hin, F.Y, gpost, hout, rs, (size_t)m, (size_t)NGW, F.lane); }
    else for (int m = gw; m < M; m += 2 * NGW) res_rows<HF32, LAST, 2>(hin, F.Y, gpost, hout, rs, (size_t)m, (size_t)NGW, F.lane);
}

#ifdef DBG_SB_FULL
constexpr float SB_STOP = -1e30f;
#else
constexpr float SB_STOP = -60.0f;
#endif
__device__ __forceinline__ void sb_task(const bf16* P, bf16* mix, int task, int lane) {
    const int b = task >> 10, h = (task >> 7) & 7, t = ((task & 127) << 6) + lane;
    const size_t rowq = (size_t)b * SEQ + t;
    float q[64], o[64];
    { const v4u* qp = (const v4u*)(P + rowq * PP + QB_OFF + h * 64);
#pragma unroll
      for (int i = 0; i < 8; ++i) { const v4u w = qp[i]; q[8 * i + 0] = bflo(w.x) * 0.125f; q[8 * i + 1] = bfhi(w.x) * 0.125f; q[8 * i + 2] = bflo(w.y) * 0.125f; q[8 * i + 3] = bfhi(w.y) * 0.125f;
          q[8 * i + 4] = bflo(w.z) * 0.125f; q[8 * i + 5] = bfhi(w.z) * 0.125f; q[8 * i + 6] = bflo(w.w) * 0.125f; q[8 * i + 7] = bfhi(w.w) * 0.125f; } }
#pragma unroll
    for (int d = 0; d < 64; ++d) o[d] = 0.f;
    float after = 0.f; int s = t - 1; bool act = s >= 0;
    while (__any(act)) {
        if (act) {
            const v4u* kp = (const v4u*)(P + ((size_t)b * SEQ + s) * PP + KB_OFF + h * 64);
            const v4u* vp = (const v4u*)(P + ((size_t)b * SEQ + s) * PP + VB_OFF + h * 64);
            float z = 0.f;
#pragma unroll
            for (int i = 0; i < 8; ++i) { const v4u w = kp[i]; z += q[8 * i + 0] * bflo(w.x) + q[8 * i + 1] * bfhi(w.x) + q[8 * i + 2] * bflo(w.y) + q[8 * i + 3] * bfhi(w.y)
                                                                 + q[8 * i + 4] * bflo(w.z) + q[8 * i + 5] * bfhi(w.z) + q[8 * i + 6] * bflo(w.w) + q[8 * i + 7] * bfhi(w.w); }
            const float l1p = __logf(1.0f + __expf(-fabsf(z)));
            const float ls_pos = fminf(z, 0.f) - l1p, ls_neg = fminf(-z, 0.f) - l1p;
            const float wgt = __expf(ls_pos + after);
#pragma unroll
            for (int i = 0; i < 8; ++i) { const v4u w = vp[i]; o[8 * i + 0] += wgt * bflo(w.x); o[8 * i + 1] += wgt * bfhi(w.x); o[8 * i + 2] += wgt * bflo(w.y); o[8 * i + 3] += wgt * bfhi(w.y);
                                           o[8 * i + 4] += wgt * bflo(w.z); o[8 * i + 5] += wgt * bfhi(w.z); o[8 * i + 6] += wgt * bflo(w.w); o[8 * i + 7] += wgt * bfhi(w.w); }
            after += ls_neg; --s; act = (s >= 0) && (after > SB_STOP);
        }
    }
    v4u* op = (v4u*)(mix + rowq * DM + 512 + h * 64);
#ifdef DBG_ZERO_YB
#pragma unroll
    for (int d = 0; d < 64; ++d) o[d] = 0.f;
#endif
#pragma unroll
    for (int i = 0; i < 8; ++i) { v4u w; w.x = cvtpk(o[8 * i + 0], o[8 * i + 1]); w.y = cvtpk(o[8 * i + 2], o[8 * i + 3]); w.z = cvtpk(o[8 * i + 4], o[8 * i + 5]); w.w = cvtpk(o[8 * i + 6], o[8 * i + 7]); op[i] = w; }
}

typedef short v4i16_t __attribute__((ext_vector_type(4)));
constexpr int SB_ROWB = 192, SB_VBUF = 32 * SB_ROWB;
__device__ __forceinline__ void sb_unit(Frame& F, const bf16* P, bf16* mix, int u) {
    const int lane = F.lane, r = lane & 31, hh = lane >> 5;
    const int b = u >> 11, h = (u >> 3) & 7, qb = ((u >> 6) & 31) * 8 + (u & 7), t0 = qb * 32;
    const size_t rowb = (size_t)b * SEQ;
    LAS unsigned char* vb = F.lds + RING_OFF + F.wave * (2 * SB_VBUF);
    pg8::bf16x8 Bq[4];
    { const bf16* qp = P + (rowb + t0 + r) * PP + QB_OFF + h * 64 + 8 * hh;
#pragma unroll
      for (int s = 0; s < 4; ++s) Bq[s] = *(const pg8::bf16x8*)(qp + 16 * s); }
    pg8::bf16x8 Uf[2];
#pragma unroll
    for (int s = 0; s < 2; ++s)
#pragma unroll
        for (int j = 0; j < 8; ++j) Uf[s][j] = ((16 * s + 8 * (j >> 2) + 4 * hh + (j & 3)) > r) ? (short)0x3F80 : (short)0;
    f32x16 oacc[2];
#pragma unroll
    for (int d = 0; d < 2; ++d)
#pragma unroll
        for (int i = 0; i < 16; ++i) oacc[d][i] = 0.f;
    float carry = 0.f;
    const int q4 = (lane & 15) >> 2, p4 = lane & 3, g1 = (lane >> 4) & 1;
    const int troff = (4 * hh + q4) * SB_ROWB + (16 * g1 + 4 * p4) * 2;
    pg8::bf16x8 Akn[4]; v4u Vn[4];
#define SB_LOAD(KT) do { const bf16* kp_ = P + (rowb + 32 * (KT) + r) * PP + KB_OFF + h * 64 + 8 * hh; \
        _Pragma("unroll") for (int s_ = 0; s_ < 4; ++s_) Akn[s_] = *(const pg8::bf16x8*)(kp_ + 16 * s_); \
        _Pragma("unroll") for (int i_ = 0; i_ < 4; ++i_) { const int c_ = lane + 64 * i_; Vn[i_] = *(const v4u*)(P + (rowb + 32 * (KT) + (c_ >> 3)) * PP + VB_OFF + h * 64 + 8 * (c_ & 7)); } } while (0)
    SB_LOAD(qb);
    for (int kt = qb; kt >= 0; --kt) {
        LAS unsigned char* vt = vb + (kt & 1) * SB_VBUF;
        pg8::bf16x8 Ak[4];
#pragma unroll
        for (int s = 0; s < 4; ++s) Ak[s] = Akn[s];
#pragma unroll
        for (int i = 0; i < 4; ++i) { const int c = lane + 64 * i; *(LAS v4u*)(vt + (c >> 3) * SB_ROWB + (c & 7) * 16) = Vn[i]; }
        if (kt > 0) SB_LOAD(kt - 1);
        f32x16 d1;
#pragma unroll
        for (int i = 0; i < 16; ++i) d1[i] = 0.f;
#pragma unroll
        for (int s = 0; s < 4; ++s) d1 = __builtin_amdgcn_mfma_f32_32x32x16_bf16(Ak[s], Bq[s], d1, 0, 0, 0);
        const bool diag = (kt == qb);
        float tot = 0.f;
        v4u hi[2], lo[2];
#pragma unroll
        for (int s = 0; s < 2; ++s)
#pragma unroll
            for (int mm = 0; mm < 4; ++mm) { float a2[2];
#pragma unroll
                for (int x = 0; x < 2; ++x) { const int i = 8 * s + 2 * mm + x; const float z = d1[i] * 0.125f; const float l1p = __logf(1.0f + __expf(-fabsf(z)));
                    const bool dead = diag && ((8 * (i >> 2) + 4 * hh + (i & 3)) >= r);
                    a2[x] = dead ? 0.f : (fminf(-z, 0.f) - l1p); tot += a2[x]; d1[i] = dead ? -INFINITY : z; }
                const unsigned hp = cvtpk(a2[0], a2[1]); hi[s][mm] = hp; lo[s][mm] = cvtpk(a2[0] - bflo(hp), a2[1] - bfhi(hp)); }
        tot = xsum32(tot);
        f32x16 aft;
#pragma unroll
        for (int i = 0; i < 16; ++i) aft[i] = 0.f;
#pragma unroll
        for (int s = 0; s < 2; ++s) {
            aft = __builtin_amdgcn_mfma_f32_32x32x16_bf16(Uf[s], __builtin_bit_cast(pg8::bf16x8, hi[s]), aft, 0, 0, 0);
            aft = __builtin_amdgcn_mfma_f32_32x32x16_bf16(Uf[s], __builtin_bit_cast(pg8::bf16x8, lo[s]), aft, 0, 0, 0); }
        asm volatile("s_waitcnt lgkmcnt(0)" ::: "memory");
#pragma unroll
        for (int s = 0; s < 2; ++s) { v4u wf;
#pragma unroll
            for (int mm = 0; mm < 4; ++mm) { const int i0 = 8 * s + 2 * mm;
                const float e0 = (bflo(hi[s][mm]) + bflo(lo[s][mm])) + d1[i0] + aft[i0] + carry, e1 = (bfhi(hi[s][mm]) + bfhi(lo[s][mm])) + d1[i0 + 1] + aft[i0 + 1] + carry;
                wf[mm] = cvtpk(__expf(e0), __expf(e1)); }
            const pg8::bf16x8 wfrag = __builtin_bit_cast(pg8::bf16x8, wf);
#pragma unroll
            for (int db = 0; db < 2; ++db) { LAS unsigned char* ta = vt + troff + 16 * s * SB_ROWB + 64 * db;
                const v4i16_t v0 = __builtin_amdgcn_ds_read_tr16_b64_v4i16((LAS v4i16_t*)ta), v1 = __builtin_amdgcn_ds_read_tr16_b64_v4i16((LAS v4i16_t*)(ta + 8 * SB_ROWB));
                pg8::bf16x8 va; va[0] = v0[0]; va[1] = v0[1]; va[2] = v0[2]; va[3] = v0[3]; va[4] = v1[0]; va[5] = v1[1]; va[6] = v1[2]; va[7] = v1[3];
                oacc[db] = __builtin_amdgcn_mfma_f32_32x32x16_bf16(va, wfrag, oacc[db], 0, 0, 0); } }
        carry += tot;
        if (__ballot(carry > SB_STOP) == 0ull) break;
    }
#undef SB_LOAD
    bf16* op = mix + (rowb + t0 + r) * DM + 512 + h * 64 + 4 * hh;
#pragma unroll
    for (int db = 0; db < 2; ++db)
#pragma unroll
        for (int ig = 0; ig < 4; ++ig) { u32x2 o; o.x = cvtpk(oacc[db][4 * ig], oacc[db][4 * ig + 1]); o.y = cvtpk(oacc[db][4 * ig + 2], oacc[db][4 * ig + 3]);
            *(u32x2*)(op + 32 * db + 8 * ig) = o; }
}

__device__ __forceinline__ unsigned f2key16(float x) {
    const unsigned bits = (unsigned)__builtin_bit_cast(unsigned short, (_Float16)x);
    const int m = ((int)(bits << 16)) >> 31;
    return bits ^ (0x8000u | ((unsigned)m & 0x7fffu));
}
__device__ __forceinline__ float relu2_f(float x) { return x + __builtin_fabsf(x); }
__device__ __forceinline__ unsigned wave_prefix_incl(unsigned v) {
    v += (unsigned)__builtin_amdgcn_update_dpp(0, (int)v, 0x111, 0xf, 0xf, false);
    v += (unsigned)__builtin_amdgcn_update_dpp(0, (int)v, 0x112, 0xf, 0xf, false);
    v += (unsigned)__builtin_amdgcn_update_dpp(0, (int)v, 0x114, 0xf, 0xf, false);
    v += (unsigned)__builtin_amdgcn_update_dpp(0, (int)v, 0x118, 0xf, 0xf, false);
    v += (unsigned)__builtin_amdgcn_update_dpp(0, (int)v, 0x142, 0xa, 0xf, false);
    v += (unsigned)__builtin_amdgcn_update_dpp(0, (int)v, 0x143, 0xc, 0xf, false);
    return v;
}
__device__ __forceinline__ unsigned half_min_u(unsigned v) {
#define HM_STEP(CTRL, RM) { const unsigned o_ = (unsigned)__builtin_amdgcn_update_dpp(-1, (int)v, CTRL, RM, 0xf, false); v = o_ < v ? o_ : v; }
    HM_STEP(0x111, 0xf) HM_STEP(0x112, 0xf) HM_STEP(0x114, 0xf) HM_STEP(0x118, 0xf) HM_STEP(0x142, 0xa)
#undef HM_STEP
    return v;
}
__device__ __forceinline__ int opq(int x) { asm volatile("" : "+v"(x)); return x; }
__device__ __forceinline__ void hist_zero(LAS unsigned* H, int lane) { unsigned z = 0u; asm volatile("" : "+v"(z)); *(LAS v4u*)(H + 4 * lane) = (v4u){z, z, z, z}; }
__device__ __forceinline__ void hist_find(const LAS unsigned* H, int lane_in, unsigned want, unsigned& bin, unsigned& n_above, unsigned& n_in) {
    const int lane = opq(lane_in), grp = 63 - lane;
    const v4u h4 = *(const LAS v4u*)(H + 4 * grp);
    const unsigned s = h4[0] + h4[1] + h4[2] + h4[3];
    const unsigned suf = wave_prefix_incl(s);
    const unsigned above = suf - s;
    const bool mine = (suf >= want) && (above < want);
    unsigned bl = 0, na = above, ni = 0;
    { unsigned cum = above; bool found = false;
#pragma unroll
      for (int i = 3; i >= 0; --i) { const unsigned hv = h4[i]; if (!found && cum + hv >= want) { bl = (unsigned)(4 * grp + i); na = cum; ni = hv; found = true; } cum += found ? 0u : hv; } }
    const unsigned long long mk = __ballot(mine);
    const int src = mk ? (int)__builtin_ctzll(mk) : 0;
    bin = (unsigned)__builtin_amdgcn_readlane((int)bl, src); n_above = (unsigned)__builtin_amdgcn_readlane((int)na, src); n_in = (unsigned)__builtin_amdgcn_readlane((int)ni, src);
}
template <int NB> struct BfBatch { pg8::bf16x8 f[NB][4]; };
struct DsaPre { pg8::bf16x8 Af[4]; u32x2 ww[4]; BfBatch<4> Ba; };
__device__ __forceinline__ void dsa_prefetch(Frame& F, const bf16* P, int b, int qg, DsaPre& pre) {
    const int lane = opq(F.lane), w = F.wave, r = lane & 31, hh = lane >> 5;
    const int t0 = qg * 8; const size_t rowb = (size_t)b * SEQ; const int nreal = (t0 + 8 + 31) >> 5;
    { const bf16* ap = P + (rowb + t0 + (r >> 2)) * PP + QI_OFF + (r & 3) * 64 + 8 * hh;
#pragma unroll
      for (int s = 0; s < 4; ++s) pre.Af[s] = *(const pg8::bf16x8*)(ap + 16 * s); }
#pragma unroll
    for (int bq = 0; bq < 4; ++bq) pre.ww[bq] = *(const u32x2*)(P + (rowb + t0 + 2 * bq + hh) * PP + WI_OFF);
    const bf16* kbase = F.KT + (size_t)b * 256 * 2048 + lane * 8;
#pragma unroll
    for (int i = 0; i < 4; ++i) { const int tq = w + 8 * i, tl = tq < nreal ? tq : nreal - 1; const bf16* kp = kbase + (size_t)tl * 2048;
#pragma unroll
        for (int s = 0; s < 4; ++s) pre.Ba.f[i][s] = *(const pg8::bf16x8*)(kp + 512 * s); }
}
__device__ __forceinline__ void dsa_unit(Frame& F, const bf16* P, bf16* mix, int b, int qg, DsaPre& pre, bool has_next, int qg_next) {
    int lane = opq(F.lane); const int w = F.wave, r = lane & 31, hh = lane >> 5;
    const int t0 = qg * 8; const size_t rowb = (size_t)b * SEQ;
    LAS unsigned short* S = (LAS unsigned short*)(F.lds + RING_OFF);
    const int N = t0 + 8, nreal = (N + 31) >> 5, ntiles = ((N + 511) >> 9) << 4;
    pg8::bf16x8 Af[4];
#pragma unroll
    for (int s = 0; s < 4; ++s) Af[s] = pre.Af[s];
    unsigned mxk[4] = {0u, 0u, 0u, 0u};
    float wg[4][4];
#pragma unroll
    for (int bq = 0; bq < 4; ++bq) { const u32x2 ww = pre.ww[bq];
        wg[bq][0] = bflo(ww.x) * 0.03125f; wg[bq][1] = bfhi(ww.x) * 0.03125f; wg[bq][2] = bflo(ww.y) * 0.03125f; wg[bq][3] = bfhi(ww.y) * 0.03125f; }
    const bf16* kbase = F.KT + (size_t)b * 256 * 2048 + lane * 8;
#define DSA_LOAD1(B, I, TL) do { const int tl_ = (TL); if (tl_ < nreal) { const bf16* kp_ = kbase + (size_t)tl_ * 2048; \
        _Pragma("unroll") for (int s_ = 0; s_ < 4; ++s_) (B).f[I][s_] = *(const pg8::bf16x8*)(kp_ + 512 * s_); } } while (0)
    {   BfBatch<4>& Ba = pre.Ba;
        for (int tb = w; tb < nreal; tb += 32) {
#pragma unroll
            for (int i = 0; i < 4; ++i) { const int tl = tb + 8 * i; if (tl < nreal) { const int key = tl * 32 + r; f32x16 acc;
#pragma unroll
                for (int z = 0; z < 16; ++z) acc[z] = 0.f;
#pragma unroll
                for (int s = 0; s < 4; ++s) acc = __builtin_amdgcn_mfma_f32_32x32x16_bf16(Af[s], Ba.f[i][s], acc, 0, 0, 0);
                DSA_LOAD1(Ba, i, tl + 32);
                const int pos = (key & ~511) + (key & 63) * 8 + ((key & 511) >> 6);
#pragma unroll
                for (int bq = 0; bq < 4; ++bq) {
                    const float sc = __builtin_fmaf(wg[bq][3], relu2_f(acc[4 * bq + 3]), __builtin_fmaf(wg[bq][2], relu2_f(acc[4 * bq + 2]), __builtin_fmaf(wg[bq][1], relu2_f(acc[4 * bq + 1]), wg[bq][0] * relu2_f(acc[4 * bq + 0]))));
                    const unsigned vmask = (key <= t0 + 2 * bq + hh) ? 0xffffu : 0u;
                    const unsigned kk = f2key16(sc) & vmask; mxk[bq] = kk > mxk[bq] ? kk : mxk[bq];
                    S[(2 * bq + hh) * 8192 + pos] = (unsigned short)kk; } } }
        }
    }
#undef DSA_LOAD1
    for (int tile = nreal + w; tile < ntiles; tile += 8) { const int key = tile * 32 + r; const int pos = (key & ~511) + (key & 63) * 8 + ((key & 511) >> 6);
#pragma unroll
        for (int bq = 0; bq < 4; ++bq) S[(2 * bq + hh) * 8192 + pos] = (unsigned short)0; }
    { LAS unsigned short* LB = (LAS unsigned short*)(F.lds + LB_OFF);
#pragma unroll
      for (int bq = 0; bq < 4; ++bq) { const unsigned v = half_min_u(mxk[bq]); if ((lane & 31) == 31) LB[(2 * bq + hh) * 8 + w] = (unsigned short)v; } }
    __syncthreads();
    lane = opq(lane);
    const int t = t0 + w, nch = (t >> 9) + 1;
    LAS unsigned short* Sw = S + w * 8192;
    LAS unsigned short* Lw = (LAS unsigned short*)(F.lds + LIST_OFF) + w * 256;
    LAS unsigned* H = (LAS unsigned*)(F.lds + HIST_OFF) + w * 256;
    int count = 0;
#ifndef DSA_REP_SEL
#define DSA_REP_SEL 1
#endif
#pragma unroll 1
    for (int rep_ = 0; rep_ < DSA_REP_SEL; ++rep_)
    if (t + 1 <= TOPK) {
        count = t + 1;
#pragma unroll
        for (int j = 0; j < 4; ++j) if (lane + 64 * j < count) Lw[lane + 64 * j] = (unsigned short)(lane + 64 * j);
    } else {
        count = TOPK;
        unsigned Lq;
        { const v4u lb4 = *(const LAS v4u*)((LAS unsigned short*)(F.lds + LB_OFF) + w * 8); unsigned mn = 0xffffu;
#pragma unroll
          for (int d = 0; d < 4; ++d) { const unsigned lo = lb4[d] & 0xffffu, hi = lb4[d] >> 16; mn = lo < mn ? lo : mn; mn = hi < mn ? hi : mn; }
          Lq = (unsigned)__builtin_amdgcn_readfirstlane((int)(mn ? mn : 1u)); }
        hist_zero(H, lane);
        for (int c = 0; c < nch; ++c) { const v4u x4 = *(const LAS v4u*)(Sw + c * 512 + 8 * lane);
#pragma unroll
            for (int d = 0; d < 4; ++d) { const unsigned x = x4[d], xl = x & 0xffffu, xh = x >> 16;
                if (xl >= Lq) __hip_atomic_fetch_add(H + (xl >> 8), 1u, __ATOMIC_RELAXED, __HIP_MEMORY_SCOPE_WAVEFRONT);
                if (xh >= Lq) __hip_atomic_fetch_add(H + (xh >> 8), 1u, __ATOMIC_RELAXED, __HIP_MEMORY_SCOPE_WAVEFRONT); } }
        asm volatile("s_waitcnt lgkmcnt(0)" ::: "memory");
        unsigned b1, above1, in1; hist_find(H, lane, (unsigned)TOPK, b1, above1, in1);
        asm volatile("s_waitcnt lgkmcnt(0)" ::: "memory");
        hist_zero(H, lane);
        for (int c = 0; c < nch; ++c) { const v4u x4 = *(const LAS v4u*)(Sw + c * 512 + 8 * lane);
#pragma unroll
            for (int d = 0; d < 4; ++d) { const unsigned x = x4[d], xl = x & 0xffffu, xh = x >> 16;
                if ((xl >> 8) == b1) __hip_atomic_fetch_add(H + (xl & 0xffu), 1u, __ATOMIC_RELAXED, __HIP_MEMORY_SCOPE_WAVEFRONT);
                if ((xh >> 8) == b1) __hip_atomic_fetch_add(H + (xh & 0xffu), 1u, __ATOMIC_RELAXED, __HIP_MEMORY_SCOPE_WAVEFRONT); } }
        asm volatile("s_waitcnt lgkmcnt(0)" ::: "memory");
        unsigned b2, above2, in2; hist_find(H, lane, (unsigned)TOPK - above1, b2, above2, in2);
        const unsigned T = (b1 << 8) | b2, need = (unsigned)TOPK - above1 - above2;
        const unsigned n_gt = above1 + above2;
        const bool ordered = in2 > need;
        const unsigned Tsel = ordered ? T + 1u : T;
        unsigned cntl = 0u;
        for (int c = 0; c < nch; ++c) { const v4u x4 = *(const LAS v4u*)(Sw + c * 512 + 8 * lane);
#pragma unroll
            for (int d = 0; d < 4; ++d) { const unsigned x = x4[d]; cntl += ((x & 0xffffu) >= Tsel ? 1u : 0u) + ((x >> 16) >= Tsel ? 1u : 0u); } }
        const unsigned pre = wave_prefix_incl(cntl);
        unsigned pos = pre - cntl;
        for (int c = 0; c < nch; ++c) { const v4u x4 = *(const LAS v4u*)(Sw + c * 512 + 8 * lane);
#pragma unroll
            for (int e = 0; e < 8; ++e) { const unsigned x = (e & 1) ? (x4[e >> 1] >> 16) : (x4[e >> 1] & 0xffffu);
                if (x >= Tsel) { Lw[pos] = (unsigned short)(c * 512 + e * 64 + lane); ++pos; } } }
        if (ordered) { unsigned eqc = 0u;
            for (int c = 0; c < nch && eqc < need; ++c) { const v4u x4 = *(const LAS v4u*)(Sw + c * 512 + 8 * lane);
#pragma unroll
                for (int e = 0; e < 8; ++e) { const unsigned x = (e & 1) ? (x4[e >> 1] >> 16) : (x4[e >> 1] & 0xffffu);
                    const bool eq = (x == T); const unsigned long long meq = __ballot(eq);
                    if (meq) { const unsigned rk = eqc + __builtin_amdgcn_mbcnt_hi((unsigned)(meq >> 32), __builtin_amdgcn_mbcnt_lo((unsigned)meq, 0u));
                        if (eq && rk < need) Lw[n_gt + rk] = (unsigned short)(c * 512 + e * 64 + lane);
                        eqc += (unsigned)__builtin_popcountll(meq); } } } }
    }
    asm volatile("s_waitcnt lgkmcnt(0)" ::: "memory");
    {
        lane = opq(lane);
        const int hcol = lane & 15, g = lane >> 4, q4 = (lane & 15) >> 2, p4 = lane & 3;
        LAS unsigned char* vimg = (LAS unsigned char*)Sw;
        pg8::bf16x8 Qf[2];
        { const bf16* qp = P + (rowb + t) * PP + QA_OFF + (hcol & 7) * 64 + 8 * g; Qf[0] = *(const pg8::bf16x8*)qp; Qf[1] = *(const pg8::bf16x8*)(qp + 32); }
        f32x4 lg[16]; v4u vr[8];
#pragma unroll
        for (int qt = 0; qt < 4; ++qt) {
            pg8::bf16x8 Kf[4][2];
#pragma unroll
            for (int aa = 0; aa < 4; ++aa) { const int jp = (4 * qt + aa) * 16 + hcol; const int idx = jp < count ? (int)Lw[jp] : 0;
                const bf16* kp = P + (rowb + idx) * PP + KA_OFF + 8 * g; Kf[aa][0] = *(const pg8::bf16x8*)kp; Kf[aa][1] = *(const pg8::bf16x8*)(kp + 32); }
            if (qt == 3) {
#pragma unroll
                for (int i = 0; i < 8; ++i) { const int c8 = lane + 64 * i, row = c8 >> 3, ch = c8 & 7; const int idx = row < count ? (int)Lw[row] : 0;
                    vr[i] = *(const v4u*)(P + (rowb + idx) * PP + VA_OFF + 8 * ch); } }
#pragma unroll
            for (int aa = 0; aa < 4; ++aa) { f32x4 acc = {0.f, 0.f, 0.f, 0.f};
                acc = __builtin_amdgcn_mfma_f32_16x16x32_bf16(Kf[aa][0], Qf[0], acc, 0, 0, 0);
                acc = __builtin_amdgcn_mfma_f32_16x16x32_bf16(Kf[aa][1], Qf[1], acc, 0, 0, 0);
                lg[4 * qt + aa] = acc; }
        }
        float mx = -INFINITY;
#pragma unroll
        for (int aa = 0; aa < 16; ++aa)
#pragma unroll
            for (int i = 0; i < 4; ++i) { float v = lg[aa][i] * 0.125f; if (count < TOPK && (16 * aa + 4 * g + i) >= count) v = -INFINITY; lg[aa][i] = v; mx = fmaxf(mx, v); }
        mx = xmax16(mx); mx = xmax32(mx);
        float sm = 0.f;
#pragma unroll
        for (int aa = 0; aa < 16; ++aa)
#pragma unroll
            for (int i = 0; i < 4; ++i) { const float pv = __expf(lg[aa][i] - mx); lg[aa][i] = pv; sm += pv; }
        sm = xsum16(sm); sm = xsum32(sm);
        const float inv = 1.0f / sm;
        f32x4 oacc[4];
#pragma unroll
        for (int db = 0; db < 4; ++db) oacc[db] = (f32x4){0.f, 0.f, 0.f, 0.f};
        const int troff = (4 * g + q4) * 160 + 8 * p4;
#pragma unroll
        for (int ck = 0; ck < 4; ++ck) {
#pragma unroll
            for (int i = 0; i < 8; ++i) { const int c8 = lane + 64 * i, row = c8 >> 3, ch = c8 & 7; *(LAS v4u*)(vimg + row * 160 + ch * 16) = vr[i]; }
            if (ck < 3) {
#pragma unroll
                for (int i = 0; i < 8; ++i) { const int c8 = lane + 64 * i, row = c8 >> 3, ch = c8 & 7; const int jp = 64 * (ck + 1) + row; const int idx = jp < count ? (int)Lw[jp] : 0;
                    vr[i] = *(const v4u*)(P + (rowb + idx) * PP + VA_OFF + 8 * ch); } }
            asm volatile("s_waitcnt lgkmcnt(0)" ::: "memory");
#pragma unroll
            for (int ks = 0; ks < 2; ++ks) {
                v4u pw;
                { float e0[4], e1[4];
#pragma unroll
                  for (int i = 0; i < 4; ++i) { e0[i] = 0.f; e1[i] = 0.f; }
#pragma unroll
                  for (int aa = 0; aa < 16; aa += 2) if (aa == 4 * ck + 2 * ks) {
#pragma unroll
                      for (int i = 0; i < 4; ++i) { e0[i] = lg[aa][i]; e1[i] = lg[aa + 1][i]; } }
                  pw[0] = cvtpk(e0[0], e0[1]); pw[1] = cvtpk(e0[2], e0[3]); pw[2] = cvtpk(e1[0], e1[1]); pw[3] = cvtpk(e1[2], e1[3]); }
                const pg8::bf16x8 pfrag = __builtin_bit_cast(pg8::bf16x8, pw);
#pragma unroll
                for (int db = 0; db < 4; ++db) { LAS unsigned char* ta = vimg + troff + (32 * ks) * 160 + 32 * db;
                    const v4i16_t v0 = __builtin_amdgcn_ds_read_tr16_b64_v4i16((LAS v4i16_t*)ta), v1 = __builtin_amdgcn_ds_read_tr16_b64_v4i16((LAS v4i16_t*)(ta + 16 * 160));
                    pg8::bf16x8 va; va[0] = v0[0]; va[1] = v0[1]; va[2] = v0[2]; va[3] = v0[3]; va[4] = v1[0]; va[5] = v1[1]; va[6] = v1[2]; va[7] = v1[3];
                    oacc[db] = __builtin_amdgcn_mfma_f32_16x16x32_bf16(va, pfrag, oacc[db], 0, 0, 0); } }
            asm volatile("s_waitcnt lgkmcnt(0)" ::: "memory");
        }
        if (hcol < 8) { bf16* op = mix + (rowb + t) * DM + hcol * 64 + 4 * g;
#pragma unroll
            for (int db = 0; db < 4; ++db) { u32x2 o; o.x = cvtpk(oacc[db][0] * inv, oacc[db][1] * inv); o.y = cvtpk(oacc[db][2] * inv, oacc[db][3] * inv); *(u32x2*)(op + 16 * db) = o; } }
    }
    dsa_prefetch(F, P, b, qg_next, pre);
    asm volatile("s_waitcnt lgkmcnt(0)" ::: "memory"); __builtin_amdgcn_s_barrier(); asm volatile("" ::: "memory");
}

constexpr int SP_PITCH = 320, SP_IMG = 128 * SP_PITCH;
constexpr int SP_SPITCH = 272, SP_STAGE = 128 * SP_SPITCH;
__device__ __forceinline__ void spatial_chunk(Frame& F, int li, int ch, const bf16* U, const bf16* V, bf16* UO) {
    LAS unsigned char* img = F.lds + RING_OFF;
    LAS unsigned char* stg = F.lds + RING_OFF + 2 * SP_IMG;
    LAS float* NB = (LAS float*)(F.lds + RING_OFF + 2 * SP_IMG + SP_STAGE); LAS float* RS = NB + 128;
    const size_t r0 = (size_t)ch * 128; const int lane = F.lane;
    { const int row = F.tid >> 2, part = F.tid & 3; const f32x2* sp = (const f32x2*)F.stats + (r0 + row) * 32 + part * 8; float s = 0.f, q = 0.f;
#pragma unroll
      for (int k = 0; k < 8; ++k) { const f32x2 a = sp[k]; s += a.x; q += a.y; }
      s += __shfl_xor(s, 1); s += __shfl_xor(s, 2); q += __shfl_xor(q, 1); q += __shfl_xor(q, 2);
      if (part == 0) { const float mu = s * (1.f / CWID); const float var = fmaxf(q * (1.f / CWID) - mu * mu, 0.f); const float rs = 1.0f / sqrtf(var + EPS); RS[row] = rs; NB[row] = -mu * rs; } }
    const int cb = F.wave >> 1, tk0 = F.wave & 1, tk1 = 3 - tk0, r = lane & 31, hh = lane >> 5, q4 = (lane & 15) >> 2, p4 = lane & 3, g1 = (lane >> 4) & 1;
    const int troff = (8 * hh + q4) * SP_PITCH + (32 * cb + 16 * g1 + 4 * p4) * 2;
    const int prow = F.tid >> 4, pcol = 8 * (F.tid & 15);
    const bf16* vp = V + (r0 + prow) * CWID + pcol; const bf16* up = U + (r0 + prow) * CWID + pcol; bf16* uop = UO + (r0 + prow) * CWID + pcol;
    const float* gvp = F.vgain + li * CWID + 32 * cb + 4 * hh; const float* bvp = F.vbias + li * CWID + 32 * cb + 4 * hh;
    const float* bsp = F.spatial_b + li * 16 * 128; const float* wsp = F.WSUM + li * 16 * 128;
    const bf16* wb0 = F.Wsp + (size_t)li * 16 * 128 * 128 + (32 * tk0 + r) * 128 + 8 * hh; const bf16* wb1 = F.Wsp + (size_t)li * 16 * 128 * 128 + (32 * tk1 + r) * 128 + 8 * hh;
    v4u vreg[4], ureg[4]; pg8::bf16x8 bf0[4], bf1[8]; float bs[2], ws[2];
#pragma unroll
    for (int it = 0; it < 4; ++it) vreg[it] = *(const v4u*)(vp + (size_t)it * 32 * CWID);
#pragma unroll
    for (int ks = 0; ks < 4; ++ks) bf0[ks] = *(const pg8::bf16x8*)(wb0 + 16 * ks);
#pragma unroll
    for (int ks = 0; ks < 8; ++ks) bf1[ks] = *(const pg8::bf16x8*)(wb1 + 16 * ks);
    bs[0] = bsp[32 * tk0 + r]; bs[1] = bsp[32 * tk1 + r]; ws[0] = wsp[32 * tk0 + r]; ws[1] = wsp[32 * tk1 + r];
#pragma unroll
    for (int it = 0; it < 4; ++it) ureg[it] = *(const v4u*)(up + (size_t)it * 32 * CWID);
    __syncthreads();
#pragma unroll 1
    for (int g = 0; g < 16; ++g) {
        const int c0 = g * 128, gn = g < 15 ? g + 1 : 15; LAS unsigned char* buf = img + (g & 1) * SP_IMG;
        f32x4 gv[4], bv[4];
#pragma unroll
        for (int ig = 0; ig < 4; ++ig) { gv[ig] = *(const f32x4*)(gvp + c0 + 8 * ig); bv[ig] = *(const f32x4*)(bvp + c0 + 8 * ig); }
#pragma unroll
        for (int it = 0; it < 4; ++it) { const int s = prow + 32 * it; const v4u raw = vreg[it]; const float rs = RS[s], nb = NB[s];
            v4u o;
            o.x = cvtpk(__builtin_fmaf(bflo(raw.x), rs, nb), __builtin_fmaf(bfhi(raw.x), rs, nb)); o.y = cvtpk(__builtin_fmaf(bflo(raw.y), rs, nb), __builtin_fmaf(bfhi(raw.y), rs, nb));
            o.z = cvtpk(__builtin_fmaf(bflo(raw.z), rs, nb), __builtin_fmaf(bfhi(raw.z), rs, nb)); o.w = cvtpk(__builtin_fmaf(bflo(raw.w), rs, nb), __builtin_fmaf(bfhi(raw.w), rs, nb));
            *(LAS v4u*)(buf + s * SP_PITCH + pcol * 2) = o; }
#pragma unroll
        for (int it = 0; it < 4; ++it) vreg[it] = *(const v4u*)(vp + (size_t)it * 32 * CWID + gn * 128);
        __syncthreads();
        f32x16 acc[2];
#pragma unroll
        for (int x = 0; x < 2; ++x)
#pragma unroll
            for (int i = 0; i < 16; ++i) acc[x][i] = 0.f;
#pragma unroll
        for (int ks = 0; ks < 8; ++ks) { LAS unsigned char* ta = buf + troff + 16 * ks * SP_PITCH;
            const v4i16_t v0 = __builtin_amdgcn_ds_read_tr16_b64_v4i16((LAS v4i16_t*)ta), v1 = __builtin_amdgcn_ds_read_tr16_b64_v4i16((LAS v4i16_t*)(ta + 4 * SP_PITCH));
            pg8::bf16x8 va; va[0] = v0[0]; va[1] = v0[1]; va[2] = v0[2]; va[3] = v0[3]; va[4] = v1[0]; va[5] = v1[1]; va[6] = v1[2]; va[7] = v1[3];
            if (ks < 4) acc[0] = __builtin_amdgcn_mfma_f32_32x32x16_bf16(va, bf0[ks], acc[0], 0, 0, 0);
            acc[1] = __builtin_amdgcn_mfma_f32_32x32x16_bf16(va, bf1[ks], acc[1], 0, 0, 0); }
        { const size_t wo = (size_t)gn * 128 * 128;
#pragma unroll
          for (int ks = 0; ks < 4; ++ks) bf0[ks] = *(const pg8::bf16x8*)(wb0 + wo + 16 * ks);
#pragma unroll
          for (int ks = 0; ks < 8; ++ks) bf1[ks] = *(const pg8::bf16x8*)(wb1 + wo + 16 * ks); }
#pragma unroll
        for (int x = 0; x < 2; ++x) { const int t = 32 * (x ? tk1 : tk0) + r; const float wsx = ws[x], bsx = bs[x];
#pragma unroll
            for (int ig = 0; ig < 4; ++ig) { const f32x4 a = {acc[x][4 * ig + 0], acc[x][4 * ig + 1], acc[x][4 * ig + 2], acc[x][4 * ig + 3]}; const f32x4 e = gv[ig] * a + (bv[ig] * wsx + bsx);
                u32x2 o; o.x = cvtpk(e[0], e[1]); o.y = cvtpk(e[2], e[3]);
                *(LAS u32x2*)(stg + t * SP_SPITCH + (32 * cb + 8 * ig + 4 * hh) * 2) = o; } }
        bs[0] = bsp[gn * 128 + 32 * tk0 + r]; bs[1] = bsp[gn * 128 + 32 * tk1 + r]; ws[0] = wsp[gn * 128 + 32 * tk0 + r]; ws[1] = wsp[gn * 128 + 32 * tk1 + r];
        __syncthreads();
#pragma unroll
        for (int it = 0; it < 4; ++it) { const int t = prow + 32 * it; const v4u sv = *(const LAS v4u*)(stg + t * SP_SPITCH + pcol * 2); const v4u uv = ureg[it];
            v4u o; o.x = cvtpk(bflo(uv.x) * bflo(sv.x), bfhi(uv.x) * bfhi(sv.x)); o.y = cvtpk(bflo(uv.y) * bflo(sv.y), bfhi(uv.y) * bfhi(sv.y));
            o.z = cvtpk(bflo(uv.z) * bflo(sv.z), bfhi(uv.z) * bfhi(sv.z)); o.w = cvtpk(bflo(uv.w) * bflo(sv.w), bfhi(uv.w) * bfhi(sv.w));
            *(v4u*)(uop + (size_t)it * 32 * CWID + c0) = o; }
#pragma unroll
        for (int it = 0; it < 4; ++it) ureg[it] = *(const v4u*)(up + (size_t)it * 32 * CWID + gn * 128);
    }
    __syncthreads();
}

#ifdef DBG_DUMB_SP
__device__ __forceinline__ void dumb_stats(Frame& F, const bf16* V) {
    const int gw = F.c * NWAVES + F.wave, NGW = F.G * NWAVES;
    for (int m = gw; m < M; m += NGW) { float s = 0.f, q = 0.f;
        for (int c = F.lane; c < CWID; c += 64) { const float x = bflo((unsigned)V[(size_t)m * CWID + c]); s += x; q += x * x; }
        s = wave_sum(s); q = wave_sum(q); const float mu = s / CWID, var = fmaxf(q / CWID - mu * mu, 0.f);
        if (F.lane == 0) { F.stats[(size_t)m * 2] = mu; F.stats[(size_t)m * 2 + 1] = 1.0f / sqrtf(var + EPS); } }
}
__device__ __forceinline__ void dumb_spatial(Frame& F, int li, bf16* U, const bf16* V) {
    const size_t total = (size_t)M * CWID;
    for (size_t e = (size_t)F.c * 512 + F.tid; e < total; e += (size_t)F.G * 512) {
        const size_t row = e / CWID; const int c = (int)(e % CWID), g = c >> 7, t = (int)(row & 127); const size_t rb = row - t;
        float acc = 0.f;
        for (int s = 0; s <= t; ++s) { const float x = bflo((unsigned)V[(rb + s) * CWID + c]); const float mu = F.stats[(rb + s) * 2], rs = F.stats[(rb + s) * 2 + 1];
            const float vn = (x - mu) * rs * F.vgain[li * CWID + c] + F.vbias[li * CWID + c];
            acc += F.spatial_w[(((size_t)li * 16 + g) * 128 + t) * 128 + s] * vn; }
        const float sv = acc + F.spatial_b[(li * 16 + g) * 128 + t];
        const float u = bflo((unsigned)U[e]);
        U[e] = (bf16)(cvtpk(u * sv, 0.f) & 0xffffu);
    }
}
#endif

#ifdef DBG_DUMB_GEMM
template <int MODE> __device__ __forceinline__ void dumb_gemm(Frame& F, const bf16* A, int lda, const float* W, int ldw, int K, int N, bf16* O, int ldo) {
    const size_t total = (size_t)(M / 4) * N;
    for (size_t idx = (size_t)F.c * 512 + F.tid; idx < total; idx += (size_t)F.G * 512) {
        const int mb = (int)(idx / N), n = (int)(idx % N);
        float acc[4] = {0.f, 0.f, 0.f, 0.f}, acu[4] = {0.f, 0.f, 0.f, 0.f};
        for (int k = 0; k < K; ++k) { const float w = W[(size_t)k * ldw + n]; const float w2 = MODE == 2 ? W[(size_t)k * ldw + N + n] : 0.f;
#pragma unroll
            for (int i = 0; i < 4; ++i) { const float a = bflo((unsigned)A[(size_t)(4 * mb + i) * lda + k]); acc[i] += a * w; if (MODE == 2) acu[i] += a * w2; } }
#pragma unroll
        for (int i = 0; i < 4; ++i) { const size_t row = (size_t)(4 * mb + i); float v = acc[i]; size_t off;
            if (MODE == 0) off = row * ldo + n;
            else if (MODE == 1) off = row * ldo + (n < 960 ? n : (n < 964 ? 2496 + (n - 960) : n - 4));
            else if (MODE == 2) { v = v / (1.0f + expf(-v)) * acu[i]; off = row * ldo + n; }
            else { const float y = 0.7978845608028654f * (v + 0.044715f * v * v * v); v = 0.5f * v * (1.0f + tanhf(y)); off = (n < 2048 ? 0 : (size_t)M * 2048) + row * 2048 + (n & 2047); }
            O[off] = (bf16)(cvtpk(v, 0.f) & 0xffffu); }
    }
}
#endif
struct Args { const float* in[12]; float* out; unsigned char* ws; int ph_lo, ph_hi; };
__global__ void __launch_bounds__(NWAVES * 64, 2) fwd_kernel(Args args) {
    extern __shared__ __attribute__((aligned(16))) unsigned char lds[];
    Frame F;
    F.lds = (LAS unsigned char*)lds;
    F.MISC = (volatile LAS unsigned*)(F.lds + MISC_OFF);
    F.tid = threadIdx.x; F.lane = F.tid & 63; F.wave = __builtin_amdgcn_readfirstlane(F.tid >> 6);
    F.G = gridDim.x; F.c = blockIdx.x;
    unsigned char* ws = args.ws;
    F.ctl = (gu32*)(ws + WS_CTL);
    F.x = args.in[0]; F.gains = args.in[1]; F.w_in_even = args.in[2]; F.w_out_even = args.in[3]; F.w_in_odd = args.in[4]; F.spatial_w = args.in[5]; F.spatial_b = args.in[6];
    F.vgain = args.in[7]; F.vbias = args.in[8]; F.w_out_odd = args.in[9]; F.w_ffn_in = args.in[10]; F.w_ffn_out = args.in[11]; F.out = args.out;
    F.WinE = (bf16*)(ws + WS_WINE); F.WoutE = (bf16*)(ws + WS_WOUTE); F.WinO = (bf16*)(ws + WS_WINO); F.WoutO = (bf16*)(ws + WS_WOUTO); F.Wffi = (bf16*)(ws + WS_WFFI); F.Wffo = (bf16*)(ws + WS_WFFO); F.Wsp = (bf16*)(ws + WS_WSP);
    F.stats = (float*)(ws + WS_STATS); F.A = (bf16*)(ws + WS_A); F.R1 = (bf16*)(ws + WS_R1); F.Y = (bf16*)(ws + WS_Y); F.MIX = (bf16*)args.out; F.KT = (bf16*)(ws + WS_KT); F.RS = (float*)(ws + WS_CTL + 512 * 1024); F.WSUM = (float*)(ws + WS_CTL + 768 * 1024);
    for (int u = F.tid; u < (LDS_BYTES - LDSCTL_OFF) / 4; u += NWAVES * 64) ((LAS unsigned*)(F.lds + LDSCTL_OFF))[u] = 0u;
    __syncthreads();
    const bool dry = args.ph_lo >= 1000;
    const int lo = dry ? args.ph_lo - 1000 : args.ph_lo, hi = dry ? args.ph_hi - 1000 : args.ph_hi;
    XcdBarrier bar; bar.bar = (unsigned*)(F.ctl + CW_BAR); bar.x = 0; bar.st = nullptr;
    if (hi - lo > 1) bar = xcd_barrier_post((unsigned*)(F.ctl + CW_BAR), F.MISC + 8);
#define IN(k) (lo <= (k) && (k) < hi)
#define REFRESH() do { int l_; asm volatile("v_mbcnt_lo_u32_b32 %0, -1, 0\n\tv_mbcnt_hi_u32_b32 %0, -1, %0" : "=v"(l_)); F.lane = l_; F.tid = (F.wave << 6) | l_; } while (0)
#define SEAM(k) do { if (IN(k) && IN((k) + 1)) xcd_barrier(bar); } while (0)

    #ifndef NO_P0
#ifdef DBG_DUMB_SP
    if (lo >= 100) { dumb_stats(F, F.R1 + (size_t)M * CWID); return; }
#endif
    if (IN(0)) { REFRESH(); p0_prologue(F); SEAM(0); }
#endif
    for (int L = 0; L < DEPTH; ++L) {
        const int pb = 1 + 7 * L, li = L >> 1;
        const float* gl = F.gains + (size_t)L * 4 * DM;
        if ((L & 1) == 0) {
            if (IN(pb + 0)) {
                pg8::Gemm g{F.A, F.WinE + (size_t)li * PP * DM, M, PP, DM}; pg8::StaticOrder S; S.init(M, PP, F.G, F.c);
                pg8::EpiBf16R E{F.R1, PP, F.RS, F.KT};
#if defined(DBG_DUMB_GEMM) && (DBG_DUMB_GEMM & (1 << 1))
                dumb_gemm<1>(F, F.A, DM, F.w_in_even + (size_t)li * DM * EVEN_IN, EVEN_IN, DM, EVEN_IN, F.R1, PP);
#else
                pg8::gemm_phase<pg8::EpiBf16R, pg8::StaticOrder, PG8_ALIGN, PG8_SP2>(F.lds + RING_OFF, g, S, E, F.wave);
#endif
                SEAM(pb + 0);
            }
            if (IN(pb + 1)) {
                REFRESH();
                if (F.G == 256) {
                    const int b = (F.c & 7) >> 1, j = ((F.c & 1) << 5) | (F.c >> 3);
                    #ifndef NO_DSA
                    { DsaPre pre; dsa_prefetch(F, F.R1, b, j, pre);
#pragma unroll 1
                      for (int k = 0; k < 16; ++k) { const int kn = k + 1; const int kq = kn < 16 ? kn : 15; dsa_unit(F, F.R1, F.MIX, b, (k & 1) ? (64 * k + 63 - j) : (64 * k + j), pre, kn < 16, (kq & 1) ? (64 * kq + 63 - j) : (64 * kq + j)); } }
#ifdef DUP_DSA
                    for (int k = 0; k < 16; ++k) dsa_unit(F, F.R1, F.MIX, b, (k & 1) ? (64 * k + 63 - j) : (64 * k + j));
#endif
#endif
                    #ifndef NO_SB
                    REFRESH();
#ifdef SB_NAIVE
                    for (int task = F.c * NWAVES + F.wave; task < 4096; task += 256 * NWAVES) sb_task(F.R1, F.MIX, task, F.lane);
#else
                    for (int u = F.c * NWAVES + F.wave; u < 8192; u += 256 * NWAVES) sb_unit(F, F.R1, F.MIX, u);
#ifdef DUP_SB
                    for (int u = F.c * NWAVES + F.wave; u < 8192; u += 256 * NWAVES) sb_unit(F, F.R1, F.MIX, u);
#endif
#endif
#endif
                }
                SEAM(pb + 1);
            }
            if (IN(pb + 2)) {
                pg8::Gemm g{F.MIX, F.WoutE + (size_t)li * DM * DM, M, DM, DM}; pg8::StaticOrder S; S.init(M, DM, F.G, F.c);
                pg8::EpiBf16<0> E{F.Y, DM, nullptr, 0, 0, 1.f};
#if defined(DBG_DUMB_GEMM) && (DBG_DUMB_GEMM & (1 << 2))
                dumb_gemm<0>(F, F.A, DM, F.w_out_even + (size_t)li * DM * DM, DM, DM, DM, F.Y, DM);
#else
                pg8::gemm_phase<pg8::EpiBf16<0>, pg8::StaticOrder, PG8_ALIGN, PG8_SP2>(F.lds + RING_OFF, g, S, E, F.wave);
#endif
                SEAM(pb + 2);
            }
        } else {
            bf16* U = F.R1; bf16* V = F.R1 + (size_t)M * CWID;
            if (IN(pb + 0)) {
                pg8::Gemm g{F.A, F.WinO + (size_t)li * 4096 * DM, M, 4096, DM}; pg8::StaticOrder S; S.init(M, 4096, F.G, F.c);
                pg8::EpiGeluStats E{U, V, F.stats, F.RS};
#if defined(DBG_DUMB_GEMM) && (DBG_DUMB_GEMM & (1 << 3))
                dumb_gemm<3>(F, F.A, DM, F.w_in_odd + (size_t)li * DM * 4096, 4096, DM, 4096, F.R1, 0);
#else
                pg8::gemm_phase<pg8::EpiGeluStats, pg8::StaticOrder, PG8_ALIGN, PG8_SP2>(F.lds + RING_OFF, g, S, E, F.wave);
#endif
                SEAM(pb + 0);
            }
            if (IN(pb + 1)) {
                REFRESH();
#ifndef NO_SP
#ifdef DBG_DUMB_SP
                dumb_spatial(F, li, U, V);
#else
                for (int ch = F.c; ch < 256; ch += F.G) spatial_chunk(F, li, ch, U, V, dry ? (bf16*)F.out : U);
#endif
#endif
                SEAM(pb + 1);
            }
            if (IN(pb + 2)) {
                pg8::Gemm g{U, F.WoutO + (size_t)li * DM * CWID, M, DM, CWID}; pg8::StaticOrder S; S.init(M, DM, F.G, F.c);
                pg8::EpiBf16<0> E{F.Y, DM, nullptr, 0, 0, 1.f};
#if defined(DBG_DUMB_GEMM) && (DBG_DUMB_GEMM & (1 << 4))
                dumb_gemm<0>(F, U, CWID, F.w_out_odd + (size_t)li * CWID * DM, DM, CWID, DM, F.Y, DM);
#else
                pg8::gemm_phase<pg8::EpiBf16<0>, pg8::StaticOrder, PG8_ALIGN, PG8_SP2>(F.lds + RING_OFF, g, S, E, F.wave);
#endif
                SEAM(pb + 2);
            }
        }
#ifndef NO_THIN
        if (IN(pb + 3)) { REFRESH(); if (L == 0) thin_phase<true, false>(F, gl + DM, dry); else thin_phase<false, false>(F, gl + DM, dry); SEAM(pb + 3); }
#endif
        if (IN(pb + 4)) {
            pg8::Gemm g{F.A, F.Wffi + (size_t)L * 2 * DFF * DM, M, 2 * DFF, DM}; pg8::StaticOrder S; S.init(M, 2 * DFF, F.G, F.c);
            pg8::EpiSwiglu E{F.R1, DFF, F.RS};
#if defined(DBG_DUMB_GEMM) && (DBG_DUMB_GEMM & (1 << 5))
                dumb_gemm<2>(F, F.A, DM, F.w_ffn_in + (size_t)L * DM * 2 * DFF, 2 * DFF, DM, DFF, F.R1, DFF);
#else
#ifdef FFI_CHUNKS
            {
                const bf16* Bt = F.Wffi + (size_t)L * 2 * DFF * DM;
                { pg8::Gemm g1{F.A, Bt, M, 8 * 256, DM}; pg8::StaticOrder S1; S1.init(M, 8 * 256, F.G, F.c); pg8::EpiSwiglu E1{F.R1, DFF, F.RS};
                  pg8::gemm_phase<pg8::EpiSwiglu, pg8::StaticOrder, PG8_ALIGN, PG8_SP2>(F.lds + RING_OFF, g1, S1, E1, F.wave); }
                { pg8::Gemm g2{F.A, Bt + (size_t)8 * 256 * DM, M, 8 * 256, DM}; pg8::StaticOrder S2; S2.init(M, 8 * 256, F.G, F.c); pg8::EpiSwiglu E2{F.R1 + 8 * 128, DFF, F.RS};
                  pg8::gemm_phase<pg8::EpiSwiglu, pg8::StaticOrder, PG8_ALIGN, PG8_SP2>(F.lds + RING_OFF, g2, S2, E2, F.wave); }
                { pg8::Gemm g3{F.A, Bt + (size_t)16 * 256 * DM, M, 6 * 256, DM}; pg8::StaticOrder S3; S3.init(M, 6 * 256, F.G, F.c); pg8::EpiSwiglu E3{F.R1 + 16 * 128, DFF, F.RS};
                  pg8::gemm_phase<pg8::EpiSwiglu, pg8::StaticOrder, PG8_ALIGN, PG8_SP2>(F.lds + RING_OFF, g3, S3, E3, F.wave); }
            }
#else
            pg8::gemm_phase<pg8::EpiSwiglu, pg8::StaticOrder, PG8_ALIGN, PG8_SP2>(F.lds + RING_OFF, g, S, E, F.wave);
#endif
#endif
            SEAM(pb + 4);
        }
        if (IN(pb + 5)) {
            pg8::Gemm g{F.R1, F.Wffo + (size_t)L * DM * DFF, M, DM, DFF}; pg8::StaticOrder S; S.init(M, DM, F.G, F.c);
            pg8::EpiBf16<0> E{F.Y, DM, nullptr, 0, 0, 1.f};
#if defined(DBG_DUMB_GEMM) && (DBG_DUMB_GEMM & (1 << 6))
                dumb_gemm<0>(F, F.R1, DFF, F.w_ffn_out + (size_t)L * DFF * DM, DM, DFF, DM, F.Y, DM);
#else
            pg8::gemm_phase<pg8::EpiBf16<0>, pg8::StaticOrder, PG8_ALIGN, PG8_SP2>(F.lds + RING_OFF, g, S, E, F.wave);
#endif
            SEAM(pb + 5);
        }
#ifndef NO_THIN
        if (IN(pb + 6)) { REFRESH(); if (L + 1 < DEPTH) { thin_phase<false, false>(F, gl + 3 * DM, dry); SEAM(pb + 6); } else thin_phase<false, true>(F, gl + 3 * DM, dry); }
#endif
    }
#ifdef KT_PROBE
    if (blockIdx.x == 0 && F.wave == 0) {
        LAS unsigned* pw = (LAS unsigned*)(F.lds + 131072 + 384);
        const unsigned pall = pw[0], pss = pw[1], pn = pw[2];
        const unsigned c_all = pall / (pn * 16u), c_ss = pss / (pn * 12u);
        const unsigned spin_us = ((c_ss + 25u) / 50u) * 2000u + ((c_all + 5u) / 10u) * 5u;
        const unsigned long long w0 = __builtin_amdgcn_s_memrealtime();
        while (__builtin_amdgcn_s_memrealtime() - w0 < (unsigned long long)spin_us * 100ull) __builtin_amdgcn_s_sleep(10);
    }
#endif
#undef IN
#undef SEAM
}

#ifndef MK_ONE_LAUNCH
#define MK_ONE_LAUNCH 1
#endif
extern "C" void kernel_launch(void* const* d_in, const int* in_sizes, int n_in, void* d_out, int out_size, void* d_ws, size_t ws_size, hipStream_t stream) {
    static int ready = 0;
    if (ready == 0) {
        if (n_in != 12 || in_sizes[0] != M * DM || out_size != M * DM || ws_size < WS_END) { fprintf(stderr, "kernel_launch: unexpected shapes (n_in %d, in0 %d, out %d, ws %zu)\n", n_in, n_in > 0 ? in_sizes[0] : -1, out_size, ws_size); ready = -1; return; }
        if (hipFuncSetAttribute((const void*)fwd_kernel, hipFuncAttributeMaxDynamicSharedMemorySize, LDS_BYTES) != hipSuccess) { fprintf(stderr, "kernel_launch: hipFuncSetAttribute failed\n"); ready = -1; return; }
        int per_cu = 0;
        if (hipOccupancyMaxActiveBlocksPerMultiprocessor(&per_cu, (const void*)fwd_kernel, NWAVES * 64, LDS_BYTES) != hipSuccess || per_cu < 1) fprintf(stderr, "kernel_launch: note: occupancy query reports %d blocks per CU\n", per_cu);
        (void)hipGetLastError();
        ready = 1;
    }
    if (ready < 0) return;
    if (hipMemsetAsync((char*)d_ws + WS_CTL, 0, CTL_ZERO_BYTES, stream) != hipSuccess) { fprintf(stderr, "kernel_launch: memset failed\n"); return; }
    Args a{};
    for (int i = 0; i < 12; ++i) a.in[i] = (const float*)d_in[i];
    a.out = (float*)d_out; a.ws = (unsigned char*)d_ws;
#if MK_ONE_LAUNCH
    a.ph_lo = 0; a.ph_hi = N_PHASES;
    hipLaunchKernelGGL(fwd_kernel, dim3(256), dim3(NWAVES * 64), LDS_BYTES, stream, a);
#else
    for (int k = 0; k < N_PHASES; ++k) {
#ifdef DBG_DUMB_SP
        if (k == 9 || k == 23) { a.ph_lo = 100; a.ph_hi = 101; hipLaunchKernelGGL(fwd_kernel, dim3(256), dim3(NWAVES * 64), LDS_BYTES, stream, a); }
#endif
#ifdef DUP_MASK
        { const int j = k == 0 ? 7 : (k - 1) % 7, L = k == 0 ? 0 : (k - 1) / 7; const bool idem = (j == 0 || j == 2 || j == 4 || j == 5 || (j == 1 && (L & 1) == 0) || j == 7);
          if ((DUP_MASK >> j) & 1) { if ((DUP_MASK >> 8) & 1) { if (j == 1 && (L & 1) == 0) goto nodup; } else if (j == 1 && (L & 1) == 1) goto nodup;
              a.ph_lo = idem ? k : k + 1000; a.ph_hi = a.ph_lo + 1; hipLaunchKernelGGL(fwd_kernel, dim3(256), dim3(NWAVES * 64), LDS_BYTES, stream, a); }
          nodup:; }
#endif
        a.ph_lo = k; a.ph_hi = k + 1; hipLaunchKernelGGL(fwd_kernel, dim3(256), dim3(NWAVES * 64), LDS_BYTES, stream, a); }
#endif
}
```

```cpp
#include <hip/hip_runtime.h>
#include <cstdio>
#include <cstdint>
#include <cmath>
namespace pg8 {
#define PG8_LAS __attribute__((address_space(3)))
typedef unsigned short bf16_t;
typedef short bf16x8 __attribute__((ext_vector_type(8)));
typedef float f32x4 __attribute__((ext_vector_type(4)));
typedef unsigned u32x4 __attribute__((ext_vector_type(4)));
constexpr int BM = 256, BK = 64, HALF = 128, HTB = HALF * BK * 2  , STAGE_BYTES = 8 * HTB, NXCD = 8, WGM = 8;

__host__ __device__ __forceinline__ int lds_byte(int r, int c) { const int st = (r >> 4) * 2 + (c >> 5), rr = r & 15, cc = c & 31, ob = rr * 64 + cc * 2; return st * 1024 + (ob ^ (((ob >> 9) & 1) << 5)); }
__host__ __device__ __forceinline__ void stage_rc(int b, int& R, int& C) { const int st = b / 1024, sb = b % 1024, swz = sb ^ (((sb >> 9) & 1) << 5); R = (st >> 1) * 16 + swz / 64; C = (st & 1) * 32 + (swz % 64) / 2; }
__host__ __device__ __forceinline__ int perm32(int rho) { const int n = rho >> 4, i = rho & 15; return 8 * (i >> 2) + 4 * n + (i & 3); }

struct Unit { int pm, pn; };
struct Gemm { const bf16_t* A; const bf16_t* Bt; int M, N, K; };

struct StaticOrder {
    int nM, nN, nwg, G, c;
    __host__ __device__ void init(int M, int N, int G_, int c_) { nM = M / BM; nN = N / BM; nwg = nM * nN; G = G_; c = c_; }
    __host__ __device__ bool next(int i, Unit& u) const {
        const long L = (long)i * G + c; if (L >= nwg) return false;
        int wgid = (int)L; { const int q = nwg / NXCD, r = nwg % NXCD, xcd = wgid % NXCD, off = wgid / NXCD; wgid = (xcd < r ? xcd * (q + 1) : r * (q + 1) + (xcd - r) * q) + off; }
        const int nig = WGM * nN, gid = wgid / nig, fm = gid * WGM, gsz = (nM - fm) < WGM ? (nM - fm) : WGM;
        u.pm = fm + ((wgid % nig) % gsz); u.pn = (wgid % nig) / gsz; return true;
    }
    __device__ __forceinline__ void a_ready(const Unit&) const {}
    __device__ __forceinline__ void done(const Unit&) const {}
};

__device__ __forceinline__ unsigned cvt_pk_bf16(float lo, float hi) { unsigned r; asm volatile("v_cvt_pk_bf16_f32 %0, %1, %2" : "=v"(r) : "v"(lo), "v"(hi)); return r; }
typedef float f32x2 __attribute__((ext_vector_type(2)));
__device__ __forceinline__ f32x2 gelu_pk(f32x2 v) {
    const f32x2 av = __builtin_elementwise_abs(v), d = av * 0.2316418882f + 1.0f;
    f32x2 t; t.x = __builtin_amdgcn_rcpf(d.x); t.y = __builtin_amdgcn_rcpf(d.y);
    f32x2 q = t * 0.5307027145f + (-0.7265760135f); q = q * t + 0.7107068705f; q = q * t + (-0.142248368f); q = q * t + 0.127414796f; q = q * t;
    const f32x2 s = (v * v) * (-0.72134752044f);
    f32x2 e; e.x = __builtin_amdgcn_exp2f(s.x); e.y = __builtin_amdgcn_exp2f(s.y);
    const f32x2 m = v * (q * e), r = v - m;
    f32x2 o; o.x = v.x < 0.f ? m.x : r.x; o.y = v.y < 0.f ? m.y : r.y; return o;
}

template <int ACT  > struct EpiBf16 {
    static constexpr bool PERM = true, AFTER_DRAIN = false, PROBE = false; static_assert(ACT == 0 || ACT == 1, "EpiBf16: ACT is 0 (none) or 1 (gelu_pk)");
    bf16_t* O; int ldc; const float* bias; int split_cols; size_t split_stride; float scale0;
    static constexpr bool HAS_RS = false; const float* rs_rows(const Unit&) const { return nullptr; }
    __device__ __forceinline__ void load_rs(const PG8_LAS float*, int, int, float (&)[8]) const {}
    __device__ __forceinline__ void operator()(const f32x4 (&acc)[2][2][4][2], const Unit& u, int wr, int wc, int fr, int fq, const float (&)[8]) const {
        const int row0 = u.pm * BM + wr * 64 + fr; int colt = u.pn * BM; bf16_t* base = O;
        float sc = 1.f; if (split_cols) { const int t = colt / split_cols; base += (size_t)t * split_stride; colt -= t * split_cols; if (t == 0) sc = scale0; }
        const int col0 = colt + wc * 32 + 8 * fq, bcol0 = u.pn * BM + wc * 32 + 8 * fq;
        f32x4 bv[2][2];
#pragma unroll
        for (int bj = 0; bj < 2; ++bj)
#pragma unroll
            for (int n = 0; n < 2; ++n) bv[bj][n] = bias ? *(const f32x4*)(bias + bcol0 + bj * HALF + 4 * n) : (f32x4){0.f, 0.f, 0.f, 0.f};
#pragma unroll
        for (int ai = 0; ai < 2; ++ai)
#pragma unroll
            for (int m = 0; m < 4; ++m) { bf16_t* rowp = base + (size_t)(row0 + ai * HALF + m * 16) * ldc + col0;
#pragma unroll
                for (int bj = 0; bj < 2; ++bj) { f32x4 v0 = acc[ai][bj][m][0] + bv[bj][0], v1 = acc[ai][bj][m][1] + bv[bj][1];
                    if (ACT == 1) { f32x2 a = gelu_pk((f32x2){v0[0], v0[1]}), b = gelu_pk((f32x2){v0[2], v0[3]}), c = gelu_pk((f32x2){v1[0], v1[1]}), d = gelu_pk((f32x2){v1[2], v1[3]});
                        v0 = (f32x4){a.x, a.y, b.x, b.y}; v1 = (f32x4){c.x, c.y, d.x, d.y}; }
                    v0 = v0 * sc; v1 = v1 * sc; u32x4 w; w.x = cvt_pk_bf16(v0[0], v0[1]); w.y = cvt_pk_bf16(v0[2], v0[3]); w.z = cvt_pk_bf16(v1[0], v1[1]); w.w = cvt_pk_bf16(v1[2], v1[3]);
                    *(u32x4*)(rowp + bj * HALF) = w; } }
    }
};
__device__ __forceinline__ float sigmoid_f(float x) { return __builtin_amdgcn_rcpf(1.0f + __builtin_amdgcn_exp2f(-1.4426950408889634f * x)); }
__device__ __forceinline__ float gelu_tanh_f(float x) { const float t = x * __builtin_fmaf(-0.10294324f, x * x, -2.3022082f); return x * __builtin_amdgcn_rcpf(1.0f + __builtin_amdgcn_exp2f(t)); }
struct EpiSwiglu {
    static constexpr bool PERM = true, AFTER_DRAIN = false, PROBE = true;
    bf16_t* O; int ldc; const float* rs;
    static constexpr bool HAS_RS = true;
    __device__ __forceinline__ const float* rs_rows(const Unit& u) const { return rs + u.pm * BM; }
    __device__ __forceinline__ void load_rs(const PG8_LAS float* tbl, int wr, int fr, float (&rsv)[8]) const {
#pragma unroll
        for (int ai = 0; ai < 2; ++ai)
#pragma unroll
            for (int m = 0; m < 4; ++m) rsv[ai * 4 + m] = tbl[wr * 64 + fr + ai * HALF + m * 16]; }
    __device__ __forceinline__ void operator()(const f32x4 (&acc)[2][2][4][2], const Unit& u, int wr, int wc, int fr, int fq, const float (&rsv)[8]) const {
        const int row0 = u.pm * BM + wr * 64 + fr, col0 = u.pn * HALF + wc * 32 + 8 * fq;
#pragma unroll
        for (int ai = 0; ai < 2; ++ai)
#pragma unroll
            for (int m = 0; m < 4; ++m) { bf16_t* rowp = O + (size_t)(row0 + ai * HALF + m * 16) * ldc + col0; const float r = rsv[ai * 4 + m];
                const float c1 = -1.4426950408889634f * r, r2 = r * r; unsigned ow[4];
#pragma unroll
                for (int n = 0; n < 2; ++n)
#pragma unroll
                    for (int h = 0; h < 2; ++h) { const f32x2 g = {acc[ai][0][m][n][2 * h], acc[ai][0][m][n][2 * h + 1]}, up = {acc[ai][1][m][n][2 * h], acc[ai][1][m][n][2 * h + 1]};
                        f32x2 t = g * c1; t.x = __builtin_amdgcn_exp2f(t.x); t.y = __builtin_amdgcn_exp2f(t.y);
                        const f32x2 d = t + 1.0f; f32x2 rc; rc.x = __builtin_amdgcn_rcpf(d.x); rc.y = __builtin_amdgcn_rcpf(d.y);
                        const f32x2 p = ((g * up) * r2) * rc;
                        ow[2 * n + h] = cvt_pk_bf16(p.x, p.y); }
                u32x4 w; w.x = ow[0]; w.y = ow[1]; w.z = ow[2]; w.w = ow[3];
                *(u32x4*)rowp = w; }
    }
};
struct EpiGeluStats {
    static constexpr bool PERM = true, AFTER_DRAIN = false, PROBE = false;
    bf16_t* U; bf16_t* V; float* stats; const float* rs;
    static constexpr bool HAS_RS = true;
    __device__ __forceinline__ const float* rs_rows(const Unit& u) const { return rs + u.pm * BM; }
    __device__ __forceinline__ void load_rs(const PG8_LAS float* tbl, int wr, int fr, float (&rsv)[8]) const {
#pragma unroll
        for (int ai = 0; ai < 2; ++ai)
#pragma unroll
            for (int m = 0; m < 4; ++m) rsv[ai * 4 + m] = tbl[wr * 64 + fr + ai * HALF + m * 16]; }
    __device__ __forceinline__ void operator()(const f32x4 (&acc)[2][2][4][2], const Unit& u, int wr, int wc, int fr, int fq, const float (&rsv)[8]) const {
        const bool isv = u.pn >= 8; bf16_t* base = isv ? V : U;
        const int row0 = u.pm * BM + wr * 64 + fr, col0 = (u.pn & 7) * BM + wc * 32 + 8 * fq;
#pragma unroll
        for (int ai = 0; ai < 2; ++ai)
#pragma unroll
            for (int m = 0; m < 4; ++m) { const int row = row0 + ai * HALF + m * 16; bf16_t* rowp = base + (size_t)row * 2048 + col0; f32x2 s2 = {0.f, 0.f}, q2 = {0.f, 0.f}; const float r = rsv[ai * 4 + m];
#pragma unroll
                for (int bj = 0; bj < 2; ++bj) { unsigned ow[4];
#pragma unroll
                    for (int n = 0; n < 2; ++n)
#pragma unroll
                        for (int h = 0; h < 2; ++h) { const f32x2 a = {acc[ai][bj][m][n][2 * h], acc[ai][bj][m][n][2 * h + 1]};
                            const f32x2 x = a * r, x2 = x * x;
                            f32x2 t = x * (x2 * (-0.10294324f) + (-2.3022082f)); t.x = __builtin_amdgcn_exp2f(t.x); t.y = __builtin_amdgcn_exp2f(t.y);
                            const f32x2 d = t + 1.0f; f32x2 rc; rc.x = __builtin_amdgcn_rcpf(d.x); rc.y = __builtin_amdgcn_rcpf(d.y);
                            const f32x2 v = x * rc;
                            s2 += v; q2 += v * v;
                            ow[2 * n + h] = cvt_pk_bf16(v.x, v.y); }
                    u32x4 w; w.x = ow[0]; w.y = ow[1]; w.z = ow[2]; w.w = ow[3];
                    *(u32x4*)(rowp + bj * HALF) = w; }
                if (isv) { float s = s2.x + s2.y, q = q2.x + q2.y; s += __shfl_xor(s, 16); s += __shfl_xor(s, 32); q += __shfl_xor(q, 16); q += __shfl_xor(q, 32);
                    if (fq == 0) { f32x2 sq; sq.x = s; sq.y = q; *(f32x2*)(stats + ((size_t)row * 32 + (u.pn - 8) * 4 + wc) * 2) = sq; } } }
    }
};
struct EpiBf16R {
    static constexpr bool PERM = true, AFTER_DRAIN = false, PROBE = false;
    bf16_t* O; int ldc; const float* rs; bf16_t* KT;
    static constexpr bool HAS_RS = true;
    __device__ __forceinline__ const float* rs_rows(const Unit& u) const { return rs + u.pm * BM; }
    __device__ __forceinline__ void load_rs(const PG8_LAS float* tbl, int wr, int fr, float (&rsv)[8]) const {
#pragma unroll
        for (int ai = 0; ai < 2; ++ai)
#pragma unroll
            for (int m = 0; m < 4; ++m) rsv[ai * 4 + m] = tbl[wr * 64 + fr + ai * HALF + m * 16]; }
    __device__ __forceinline__ void operator()(const f32x4 (&acc)[2][2][4][2], const Unit& u, int wr, int wc, int fr, int fq, const float (&rsv)[8]) const {
        const int row0 = u.pm * BM + wr * 64 + fr, col0 = u.pn * BM + wc * 32 + 8 * fq;
        const bool kt = (u.pn == 3) && (wc < 2);
#pragma unroll
        for (int ai = 0; ai < 2; ++ai)
#pragma unroll
            for (int m = 0; m < 4; ++m) { const int row = row0 + ai * HALF + m * 16; bf16_t* rowp = O + (size_t)row * ldc + col0; const float r = rsv[ai * 4 + m];
#pragma unroll
                for (int bj = 0; bj < 2; ++bj) { const f32x4 v0 = acc[ai][bj][m][0] * r, v1 = acc[ai][bj][m][1] * r;
                    u32x4 w; w.x = cvt_pk_bf16(v0[0], v0[1]); w.y = cvt_pk_bf16(v0[2], v0[3]); w.z = cvt_pk_bf16(v1[0], v1[1]); w.w = cvt_pk_bf16(v1[2], v1[3]);
                    *(u32x4*)(rowp + bj * HALF) = w;
                    if (kt && bj == 1) { const int dimc = 32 * wc + 8 * fq, bb = row >> 13, tt = row & 8191;
                        *(u32x4*)(KT + ((((size_t)(bb * 256 + (tt >> 5)) * 4 + (dimc >> 4)) * 2 + ((dimc >> 3) & 1)) * 32 + (tt & 31)) * 8) = w; } } }
    }
};
template <class Epi, class Sched, bool ALIGN_EPI = false, bool SP2 = false>
__device__ __forceinline__ void gemm_phase(PG8_LAS unsigned char* lds, const Gemm g, const Sched& S, const Epi& E, const int wave_id) {
    int lane_; asm volatile("v_mbcnt_lo_u32_b32 %0, -1, 0\n\tv_mbcnt_hi_u32_b32 %0, -1, %0" : "=v"(lane_)); int tid_ = (wave_id << 6) | lane_;
    const int tid = tid_, wid = __builtin_amdgcn_readfirstlane(tid >> 6), lane = tid & 63, wr = wid >> 2, wc = wid & 3, fr = lane & 15, fq = lane >> 4;
    const int K = g.K, nt = K / BK;
    unsigned voffA[2], voffB[2];
#pragma unroll
    for (int i = 0; i < 2; ++i) { int R, C; stage_rc(tid * 16 + i * 8192, R, C); const int Rb = Epi::PERM ? ((R & ~31) + perm32(R & 31)) : R;
        voffA[i] = (unsigned)(R * K + C) * 2u; voffB[i] = (unsigned)(Rb * K + C) * 2u; }
    const size_t kstep = (size_t)(BK * 2);
    const size_t hstep = (size_t)HALF * K * 2;
    const size_t tstep = 2 * hstep;
    const unsigned ldsw = (unsigned)wid * 1024u;
    const int aoff = lds_byte(wr * 64 + fr, fq * 8), boff = lds_byte(wc * 32 + fr, fq * 8);
#define PG8_SA(b, h) (((b) * 2 + (h)) * HTB)
#define PG8_SB(b, h) ((4 + (b) * 2 + (h)) * HTB)
#define PG8_STAGE(bufoff, gbase, voff) do { _Pragma("unroll") for (int _i = 0; _i < 2; ++_i) \
        __builtin_amdgcn_global_load_lds((const unsigned*)((const char*)(gbase) + (voff)[_i]), (PG8_LAS unsigned*)(lds + (bufoff) + ldsw + _i * 8192), 16, 0, 0); } while (0)
#define PG8_LDA(dst, b, h) do { _Pragma("unroll") for (int m = 0; m < 4; ++m) _Pragma("unroll") for (int k = 0; k < 2; ++k) dst[m][k] = *(const PG8_LAS bf16x8*)(lds + PG8_SA(b, h) + aoff + m * 2048 + k * 1024); } while (0)
#define PG8_LDB(dst, b, h) do { _Pragma("unroll") for (int n = 0; n < 2; ++n) _Pragma("unroll") for (int k = 0; k < 2; ++k) dst[n][k] = *(const PG8_LAS bf16x8*)(lds + PG8_SB(b, h) + boff + n * 2048 + k * 1024); } while (0)
#define PG8_MMA(ai, bj, At, Bt) do { __builtin_amdgcn_s_setprio(1); _Pragma("unroll") for (int m = 0; m < 4; ++m) _Pragma("unroll") for (int n = 0; n < 2; ++n) _Pragma("unroll") for (int k = 0; k < 2; ++k) \
        acc[ai][bj][m][n] = __builtin_amdgcn_mfma_f32_16x16x32_bf16(Bt[n][k], At[m][k], acc[ai][bj][m][n], 0, 0, 0); __builtin_amdgcn_s_setprio(0); } while (0)
#define PG8_WAIT_V(n) asm volatile("s_waitcnt vmcnt(" #n ")" ::: "memory")
#define PG8_WAIT_L(n) asm volatile("s_waitcnt lgkmcnt(" #n ")" ::: "memory")
#define PG8_BAR __builtin_amdgcn_s_barrier()
#define PG8_SCHED __builtin_amdgcn_sched_barrier(0)
    Unit cur, nxt; int ui = 0;
    if (!S.next(0, cur)) return;
    f32x4 acc[2][2][4][2];
#pragma unroll
    for (int a = 0; a < 2; ++a)
#pragma unroll
        for (int b = 0; b < 2; ++b)
#pragma unroll
            for (int m = 0; m < 4; ++m)
#pragma unroll
                for (int n = 0; n < 2; ++n) acc[a][b][m][n] = (f32x4){0.f, 0.f, 0.f, 0.f};
    bf16x8 At[4][2], B0[2][2], B1[2][2];
    const char* cA = (const char*)g.A + (size_t)cur.pm * tstep; const char* cB = (const char*)g.Bt + (size_t)cur.pn * tstep;
    S.a_ready(cur);
    constexpr int RSTAB = 132096;
    int rslot = 0;
#define PG8_STAGE_RS(u, slot) do { if constexpr (Epi::HAS_RS) __builtin_amdgcn_global_load_lds((const unsigned*)(E.rs_rows(u) + (wid & 3) * 64 + lane), (PG8_LAS unsigned*)(lds + RSTAB + (slot) * 1024 + (wid & 3) * 256), 4, 0, 0); } while (0)
    PG8_STAGE_RS(cur, 0);
    if constexpr (SP2) {
        PG8_STAGE(PG8_SB(0, 0), cB, voffB); PG8_STAGE(PG8_SB(0, 1), cB + hstep, voffB); PG8_STAGE(PG8_SA(0, 0), cA, voffA); PG8_STAGE(PG8_SA(0, 1), cA + hstep, voffA);
        if (wr == 1) PG8_BAR;
        PG8_WAIT_V(2); PG8_BAR;
        PG8_STAGE(PG8_SB(1, 0), cB + kstep, voffB); PG8_STAGE(PG8_SA(1, 0), cA + kstep, voffA); PG8_STAGE(PG8_SB(1, 1), cB + hstep + kstep, voffB);
        PG8_WAIT_V(6); PG8_BAR;
    } else {
        PG8_STAGE(PG8_SB(0, 0), cB, voffB); PG8_STAGE(PG8_SA(0, 0), cA, voffA); PG8_STAGE(PG8_SB(0, 1), cB + hstep, voffB); PG8_STAGE(PG8_SA(0, 1), cA + hstep, voffA);
        if (wr == 1) PG8_BAR;
        PG8_WAIT_V(4); PG8_BAR;
        PG8_STAGE(PG8_SB(1, 0), cB + kstep, voffB); PG8_STAGE(PG8_SA(1, 0), cA + kstep, voffA); PG8_STAGE(PG8_SB(1, 1), cB + hstep + kstep, voffB);
        PG8_WAIT_V(6); PG8_BAR;
    }
#ifdef KT_PROBE
    unsigned long long pc0 = 0, pc4 = 0, pce = 0; unsigned pall = 0, pss = 0, pn = 0, pepi = 0;
#endif
    for (;;) {
        const bool has_next = S.next(ui + 1, nxt);
        const int rslot_n = rslot == 2 ? 0 : rslot + 1;
        if (has_next) PG8_STAGE_RS(nxt, rslot_n);
        const char* nA = has_next ? (const char*)g.A + (size_t)nxt.pm * tstep : cA; const char* nB = has_next ? (const char*)g.Bt + (size_t)nxt.pn * tstep : cB;
#ifdef KT_PROBE
        if constexpr (Epi::PROBE) pc0 = __builtin_amdgcn_s_memtime();
#endif
        for (int t = 0; t < nt; t += 2) {
#ifdef KT_PROBE
            if constexpr (Epi::PROBE) if (t == 4) pc4 = __builtin_amdgcn_s_memtime();
#endif
            const bool last = (t == nt - 2);
            const char* a1 = cA + (size_t)(t + 1) * kstep;
            const char* a2 = last ? nA : cA + (size_t)(t + 2) * kstep; const char* b2 = last ? nB : cB + (size_t)(t + 2) * kstep;
            const char* a3 = a2 + kstep; const char* b3 = b2 + kstep;
            if (last && has_next) S.a_ready(nxt);
            if constexpr (SP2) {
            PG8_LDB(B0, 0, 0); PG8_LDB(B1, 0, 1); PG8_SCHED; PG8_LDA(At, 0, 0); PG8_STAGE(PG8_SA(1, 1), a1 + hstep, voffA);
            PG8_WAIT_V(8); PG8_WAIT_L(0); PG8_BAR; PG8_MMA(0, 0, At, B0); PG8_MMA(0, 1, At, B1); PG8_BAR; PG8_SCHED;
            PG8_LDA(At, 0, 1); PG8_STAGE(PG8_SB(0, 0), b2, voffB); PG8_STAGE(PG8_SB(0, 1), b2 + hstep, voffB); PG8_STAGE(PG8_SA(0, 0), a2, voffA);
            PG8_WAIT_V(8); PG8_WAIT_L(0); PG8_BAR; PG8_MMA(1, 0, At, B0); PG8_MMA(1, 1, At, B1); PG8_BAR; PG8_SCHED;
            PG8_LDB(B0, 1, 0); PG8_LDB(B1, 1, 1); PG8_SCHED; PG8_LDA(At, 1, 0); PG8_STAGE(PG8_SA(0, 1), a2 + hstep, voffA);
            PG8_WAIT_V(8); PG8_WAIT_L(0); PG8_BAR; PG8_MMA(0, 0, At, B0); PG8_MMA(0, 1, At, B1); PG8_BAR; PG8_SCHED;
            PG8_LDA(At, 1, 1); PG8_STAGE(PG8_SB(1, 0), b3, voffB); PG8_STAGE(PG8_SB(1, 1), b3 + hstep, voffB); PG8_STAGE(PG8_SA(1, 0), a3, voffA);
            PG8_WAIT_V(8); PG8_WAIT_L(0); PG8_BAR; PG8_MMA(1, 0, At, B0); PG8_MMA(1, 1, At, B1); PG8_BAR; PG8_SCHED;
            } else {
            PG8_LDB(B0, 0, 0); PG8_SCHED; PG8_LDA(At, 0, 0); PG8_STAGE(PG8_SA(1, 1), a1 + hstep, voffA);
            PG8_WAIT_L(8); PG8_BAR; PG8_WAIT_L(0); PG8_MMA(0, 0, At, B0); PG8_BAR; PG8_SCHED;
            PG8_LDB(B1, 0, 1); PG8_STAGE(PG8_SB(0, 0), b2, voffB);
            PG8_BAR; PG8_WAIT_L(0); PG8_MMA(0, 1, At, B1); PG8_BAR;
            PG8_LDA(At, 0, 1); PG8_STAGE(PG8_SA(0, 0), a2, voffA);
            PG8_BAR; PG8_WAIT_L(0); PG8_MMA(1, 0, At, B0); PG8_BAR; PG8_SCHED;
            PG8_STAGE(PG8_SB(0, 1), b2 + hstep, voffB);
            PG8_WAIT_V(6); PG8_BAR; PG8_MMA(1, 1, At, B1); PG8_BAR;
            PG8_LDB(B0, 1, 0); PG8_SCHED; PG8_LDA(At, 1, 0); PG8_STAGE(PG8_SA(0, 1), a2 + hstep, voffA);
            PG8_WAIT_L(8); PG8_BAR; PG8_WAIT_L(0); PG8_MMA(0, 0, At, B0); PG8_BAR; PG8_SCHED;
            PG8_LDB(B1, 1, 1); PG8_STAGE(PG8_SB(1, 0), b3, voffB);
            PG8_BAR; PG8_WAIT_L(0); PG8_MMA(0, 1, At, B1); PG8_BAR;
            PG8_LDA(At, 1, 1); PG8_STAGE(PG8_SA(1, 0), a3, voffA);
            PG8_BAR; PG8_WAIT_L(0); PG8_MMA(1, 0, At, B0); PG8_BAR; PG8_SCHED;
            PG8_STAGE(PG8_SB(1, 1), b3 + hstep, voffB);
            PG8_WAIT_V(6); PG8_BAR; PG8_MMA(1, 1, At, B1); PG8_BAR;
            }
        }
#ifdef KT_PROBE
        if constexpr (Epi::PROBE) { const unsigned long long pe = __builtin_amdgcn_s_memtime(); pall += (unsigned)(pe - pc0); pss += (unsigned)(pe - pc4); ++pn; pce = pe; }
#endif
        if constexpr (ALIGN_EPI) { if (wr == 0) PG8_BAR; }
        if constexpr (!Epi::AFTER_DRAIN) { float rsv[8]; E.load_rs((const PG8_LAS float*)(lds + RSTAB + rslot * 1024), wr, fr, rsv); E(acc, cur, wr, wc, fr, fq, rsv); S.done(cur); }
#ifdef KT_PROBE
        if constexpr (Epi::PROBE) { const unsigned long long px = __builtin_amdgcn_s_memtime(); pepi += (unsigned)(px - pce); }
#endif
        if (!has_next) break;
#pragma unroll
        for (int a = 0; a < 2; ++a)
#pragma unroll
            for (int b = 0; b < 2; ++b)
#pragma unroll
                for (int m = 0; m < 4; ++m)
#pragma unroll
                    for (int n = 0; n < 2; ++n) acc[a][b][m][n] = (f32x4){0.f, 0.f, 0.f, 0.f};
        cur = nxt; cA = nA; cB = nB; ++ui; rslot = rslot_n;
        if constexpr (ALIGN_EPI) { if (wr == 1) PG8_BAR; }
    }
#ifdef KT_PROBE
    if constexpr (Epi::PROBE) if (tid == 0) { PG8_LAS unsigned* pw = (PG8_LAS unsigned*)(lds + 131072 + 640); pw[0] += pall; pw[1] += pss; pw[2] += pn; pw[3] += pepi; }
#endif
    PG8_WAIT_V(0);
    if constexpr (!ALIGN_EPI) { if (wr == 0) PG8_BAR; }
    PG8_BAR;
    if constexpr (Epi::AFTER_DRAIN) { E.fused(acc, cur, wr, wc, fr, fq, lds, wid, lane); S.done(cur); }
#undef PG8_SA
#undef PG8_SB
#undef PG8_STAGE
#undef PG8_LDA
#undef PG8_LDB
#undef PG8_MMA
#undef PG8_WAIT_V
#undef PG8_WAIT_L
#undef PG8_BAR
#undef PG8_SCHED
#undef PG8_STAGE_RS
}
}
#ifndef PG8_SP2
#define PG8_SP2 true
#endif
#ifndef PG8_ALIGN
#define PG8_ALIGN true
#endif
#define GAS __attribute__((address_space(1)))
#define LAS __attribute__((address_space(3)))
typedef unsigned short bf16;
typedef unsigned v4u __attribute__((ext_vector_type(4)));
typedef float f32x4 __attribute__((ext_vector_type(4)));
typedef short bf16x8 __attribute__((ext_vector_type(8)));
typedef GAS unsigned gu32;
typedef GAS unsigned long long gu64;
#define RLX_AGENT __ATOMIC_RELAXED, __HIP_MEMORY_SCOPE_AGENT
#define LDS_WAIT() asm volatile("s_waitcnt lgkmcnt(0)" ::: "memory")
#define VM_WAIT() asm volatile("s_waitcnt vmcnt(0)" ::: "memory")
__device__ __forceinline__ unsigned long long rt() { return __builtin_amdgcn_s_memrealtime(); }
__device__ __forceinline__ unsigned f2bf(float f) { unsigned u = __builtin_bit_cast(unsigned, f); return (u + 0x7fffu + ((u >> 16) & 1u)) >> 16; }
__device__ __forceinline__ unsigned pk2(float lo, float hi) { return f2bf(lo) | (f2bf(hi) << 16); }

#define XB_TMO      128
#define XB_XCNT(j)  (256  + 64 * (j))
#define XB_XSUB(j)  (1280 + 64 * (j))
#define XB_XGEN(j)  (2304 + 64 * (j))
#define XB_TOP      3328
#define XB_TOPGEN   3392
#define XCD_BAR_WORDS 3456
#define XB_SPIN_CAP (1u << 18)

__device__ __forceinline__ unsigned xb_ld(unsigned* p)              { return __hip_atomic_load(p, __ATOMIC_RELAXED, __HIP_MEMORY_SCOPE_AGENT); }
__device__ __forceinline__ unsigned xb_add(unsigned* p, unsigned v) { return __hip_atomic_fetch_add(p, v, __ATOMIC_RELAXED, __HIP_MEMORY_SCOPE_AGENT); }
__device__ __forceinline__ unsigned xb_xcc_id() { return (unsigned)__builtin_amdgcn_s_getreg((3 << 11) | 20) & 0xFu; }
#define XB_SPIN(cond, bar) do { unsigned _sp = 0; while (cond) { __builtin_amdgcn_s_sleep(1); \
    if ((++_sp & 255u) == 0u) { if (xb_ld(&(bar)[XB_TMO])) break; if (_sp > XB_SPIN_CAP) { atomicAdd(&(bar)[XB_TMO], 1u); break; } } } } while (0)

struct XcdBarrier {
    unsigned* bar; unsigned x;
    volatile LAS unsigned* st;
};

__device__ __forceinline__ XcdBarrier xcd_barrier_post(unsigned* bar, volatile LAS unsigned* st) {
    XcdBarrier b; b.bar = bar; b.x = xb_xcc_id(); b.st = st;
    if (threadIdx.x == 0) (void)xb_add(&bar[XB_XCNT(b.x)], 1u);
    return b;
}
__device__ __forceinline__ void xcd_barrier_complete(unsigned* bar, unsigned x, unsigned& nloc, unsigned& nx) {
    const unsigned G = gridDim.x * gridDim.y * gridDim.z;
    unsigned sum, cnt, mine, sp = 0u;
    for (;;) {
        sum = 0u; cnt = 0u; mine = 0u;
#pragma unroll
        for (unsigned j = 0; j < 16; ++j) { const unsigned c = xb_ld(&bar[XB_XCNT(j)]); sum += c; cnt += (c > 0u) ? 1u : 0u; mine = (j == x) ? c : mine; }
        if (sum == G) break;
        __builtin_amdgcn_s_sleep(1);
        if ((++sp & 255u) == 0u) { if (xb_ld(&bar[XB_TMO])) break; if (sp > XB_SPIN_CAP) { atomicAdd(&bar[XB_TMO], 1u); break; } }
    }
    nloc = mine > 0u ? mine : 1u; nx = cnt > 0u ? cnt : 1u;
}

__device__ __forceinline__ void xcd_barrier(const XcdBarrier& b) {
    asm volatile("s_waitcnt vmcnt(0)" ::: "memory");
    __syncthreads();
    if (threadIdx.x == 0) {
        unsigned* bar = b.bar;
        __builtin_amdgcn_s_waitcnt(0);
        unsigned nloc = b.st[0], nx = b.st[1];
        if (nloc == 0u) { xcd_barrier_complete(bar, b.x, nloc, nx); b.st[0] = nloc; b.st[1] = nx; }
        const unsigned old = xb_add(&bar[XB_XSUB(b.x)], 1u);
        const unsigned gen = old / nloc;
        if (old + 1u == (gen + 1u) * nloc) {
            __builtin_amdgcn_fence(__ATOMIC_RELEASE, "agent");
            asm volatile("s_waitcnt vmcnt(0)" ::: "memory");
            const unsigned og = xb_add(&bar[XB_TOP], 1u);
            const unsigned tg = og / nx;
            if (og + 1u == (tg + 1u) * nx) xb_add(&bar[XB_TOPGEN], 1u);
            else XB_SPIN(xb_ld(&bar[XB_TOPGEN]) == tg, bar);
            __builtin_amdgcn_fence(__ATOMIC_ACQUIRE, "agent");
            xb_add(&bar[XB_XGEN(b.x)], 1u);
            asm volatile("s_waitcnt vmcnt(0)" ::: "memory");
        } else {
            XB_SPIN(xb_ld(&bar[XB_XGEN(b.x)]) == gen, bar);
            __builtin_amdgcn_fence(__ATOMIC_ACQUIRE, "agent");
            asm volatile("s_waitcnt vmcnt(0)" ::: "memory");
        }
    }
    __syncthreads();
}
constexpr int NWAVES = 8;
constexpr int BATCH = 4, SEQ = 8192, DM = 1024, M = BATCH * SEQ, DEPTH = 4;
constexpr int PP = 2560;
constexpr int QA_OFF = 0, KA_OFF = 512, VA_OFF = 576, QI_OFF = 640, KI_OFF = 896, QB_OFF = 960, KB_OFF = 1472, VB_OFF = 1984, WI_OFF = 2496;
constexpr int EVEN_IN = 2500, DFF = 2816, CWID = 2048, TOPK = 256;
constexpr float EPS = 1e-6f;
constexpr int N_PHASES = 1 + 7 * DEPTH;

constexpr size_t MiB = 1u << 20;
constexpr size_t WS_CTL = 0, CTL_ZERO_BYTES = 64 * 1024;
constexpr size_t WS_WINE = 1 * MiB, WS_WOUTE = 11 * MiB, WS_WINO = 15 * MiB, WS_WOUTO = 31 * MiB, WS_WFFI = 39 * MiB, WS_WFFO = 83 * MiB, WS_WSP = 105 * MiB;
constexpr size_t WS_STATS = 106 * MiB, WS_A = 114 * MiB, WS_R1 = 178 * MiB, WS_Y = WS_R1 + 192 * MiB, WS_KT = 434 * MiB, WS_END = 438 * MiB;
constexpr size_t SZ_WINE = (size_t)PP * DM * 2, SZ_WOUTE = (size_t)DM * DM * 2, SZ_WINO = (size_t)4096 * DM * 2, SZ_WOUTO = (size_t)DM * CWID * 2, SZ_WFFI = (size_t)2 * DFF * DM * 2, SZ_WFFO = (size_t)DM * DFF * 2, SZ_WSP = (size_t)16 * 128 * 128 * 2;
static_assert(WS_WINE + 2 * SZ_WINE <= WS_WOUTE && WS_WOUTE + 2 * SZ_WOUTE <= WS_WINO && WS_WINO + 2 * SZ_WINO <= WS_WOUTO && WS_WOUTO + 2 * SZ_WOUTO <= WS_WFFI && WS_WFFI + 4 * SZ_WFFI <= WS_WFFO && WS_WFFO + 4 * SZ_WFFO <= WS_WSP && WS_WSP + 2 * SZ_WSP <= WS_STATS, "weights map");
static_assert(WS_STATS + (size_t)M * 32 * 8 <= WS_A && WS_A + (size_t)M * DM * 2 <= WS_R1 && WS_R1 + (size_t)M * PP * 2 <= WS_Y && WS_R1 + (size_t)M * DFF * 2 <= WS_Y && WS_Y + (size_t)M * DM * 2 <= WS_KT && WS_KT + (size_t)M * 64 * 2 <= WS_END, "activation map");
constexpr int CW_BAR = 4096;
constexpr int SBQ_OFF = 10240;

constexpr int RING_OFF = 0, RING_BYTES = 131072;
constexpr int LDSCTL_OFF = RING_BYTES, MISC_OFF = LDSCTL_OFF + 320;
constexpr int LDS_BYTES = 147456;
constexpr int LIST_OFF = RING_BYTES + 1024;
constexpr int LB_OFF = RING_BYTES + 512;
constexpr int HIST_OFF = LIST_OFF + 4096;
static_assert(HIST_OFF + 8192 <= LDS_BYTES, "LDS map");

typedef float f32x16 __attribute__((ext_vector_type(16)));
typedef __bf16 bf16x2_t __attribute__((ext_vector_type(2)));
typedef unsigned u32x2 __attribute__((ext_vector_type(2)));
typedef float f32x2 __attribute__((ext_vector_type(2)));

__device__ __forceinline__ f32x16 zero16() { f32x16 z;
#pragma unroll
    for (int i = 0; i < 16; ++i) z[i] = 0.f;
    asm volatile("" : "+v"(z)); return z; }
__device__ __forceinline__ float bflo(unsigned u) { return __uint_as_float(u << 16); }
__device__ __forceinline__ float bfhi(unsigned u) { return __uint_as_float(u & 0xffff0000u); }
__device__ __forceinline__ unsigned cvtpk(float lo, float hi) { const f32x2 v = {lo, hi}; const bf16x2_t b = __builtin_convertvector(v, bf16x2_t); return __builtin_bit_cast(unsigned, b); }
#define DPP_ADD(V, CTRL, RMASK) V += __builtin_bit_cast(float, __builtin_amdgcn_update_dpp(0, __builtin_bit_cast(int, V), CTRL, RMASK, 0xf, false))
__device__ __forceinline__ float wave_sum(float v) {
    DPP_ADD(v, 0x111, 0xf); DPP_ADD(v, 0x112, 0xf); DPP_ADD(v, 0x114, 0xf); DPP_ADD(v, 0x118, 0xf); DPP_ADD(v, 0x142, 0xa); DPP_ADD(v, 0x143, 0xc);
    return __builtin_bit_cast(float, __builtin_amdgcn_readlane(__builtin_bit_cast(int, v), 63));
}
__device__ __forceinline__ float xsum32(float v) { const auto rr = __builtin_amdgcn_permlane32_swap(__float_as_uint(v), __float_as_uint(v), false, false); return __uint_as_float(rr[0]) + __uint_as_float(rr[1]); }
__device__ __forceinline__ float xsum16(float v) { const auto rr = __builtin_amdgcn_permlane16_swap(__float_as_uint(v), __float_as_uint(v), false, false); return __uint_as_float(rr[0]) + __uint_as_float(rr[1]); }
__device__ __forceinline__ float xmax32(float v) { const auto rr = __builtin_amdgcn_permlane32_swap(__float_as_uint(v), __float_as_uint(v), false, false); return fmaxf(__uint_as_float(rr[0]), __uint_as_float(rr[1])); }
__device__ __forceinline__ float xmax16(float v) { const auto rr = __builtin_amdgcn_permlane16_swap(__float_as_uint(v), __float_as_uint(v), false, false); return fmaxf(__uint_as_float(rr[0]), __uint_as_float(rr[1])); }
__device__ __forceinline__ float wave_max(float v) {
#pragma unroll
    for (int o = 1; o < 64; o <<= 1) v = fmaxf(v, __shfl_xor(v, o));
    return v;
}
__device__ __forceinline__ unsigned wave_sum_u(unsigned v) {
#pragma unroll
    for (int o = 1; o < 64; o <<= 1) v += (unsigned)__shfl_xor((int)v, o);
    return v;
}

struct Frame {
    LAS unsigned char* lds;
    volatile LAS unsigned* MISC;
    gu32* ctl;
    int tid, lane, wave, G, c;
    const float *x, *gains, *w_in_even, *w_out_even, *w_in_odd, *spatial_w, *spatial_b, *vgain, *vbias, *w_out_odd, *w_ffn_in, *w_ffn_out;
    float* out;
    bf16 *WinE, *WoutE, *WinO, *WoutO, *Wffi, *Wffo, *Wsp;
    float* stats;
    bf16 *A, *R1, *Y, *MIX, *KT;
    float* RS;
    float* WSUM;
};

__device__ __forceinline__ int src_col(int mode, int d) {
    if (mode == 0) return d;
    if (mode == 1) { if (d < 960) return d; if (d < 2496) return d + 4; if (d < 2500) return d - 2496 + 960; return -1; }
    const int pn = d >> 8, xx = d & 255; return (xx >> 7) * DFF + 128 * pn + (xx & 127);
}
__device__ __forceinline__ void transpose_item(const float* W, int K, int Nsrc, int ND, int mode, bf16* WT, LAS float* scr, int item, int lane, const float* gain = nullptr) {
    const int nblk = ND / 32, kb = item / nblk, nb = item % nblk, k0 = 64 * kb, n0 = 32 * nb;
    const int n4 = 4 * (lane & 7), sc = src_col(mode, n0 + n4);
#pragma unroll
    for (int i = 0; i < 8; ++i) { const int kk = (lane >> 3) + 8 * i; f32x4 v = {0.f, 0.f, 0.f, 0.f};
        if (sc >= 0) v = *(const f32x4*)(W + (size_t)(k0 + kk) * Nsrc + sc) * (gain ? gain[k0 + kk] : 1.0f);
        LAS float* sp = scr + kk * 33 + n4; sp[0] = v.x; sp[1] = v.y; sp[2] = v.z; sp[3] = v.w; }
    LDS_WAIT(); asm volatile("" ::: "memory");
    const int c = lane & 7;
#pragma unroll
    for (int j = 0; j < 4; ++j) { const int n = (lane >> 3) + 8 * j; const LAS float* s = scr + (8 * c) * 33 + n;
        v4u o; o.x = cvtpk(s[0 * 33], s[1 * 33]); o.y = cvtpk(s[2 * 33], s[3 * 33]); o.z = cvtpk(s[4 * 33], s[5 * 33]); o.w = cvtpk(s[6 * 33], s[7 * 33]);
        *(GAS v4u*)(WT + (size_t)(n0 + n) * K + k0 + 8 * c) = o; }
    LDS_WAIT(); asm volatile("" ::: "memory");
}
__device__ __forceinline__ void x_row_to_bf16(const float* xrow, bf16* orow, float* rs, int lane) {
    const f32x4* xr = (const f32x4*)xrow + lane; f32x4 v[4]; float s = 0.f;
#pragma unroll
    for (int j = 0; j < 4; ++j) { v[j] = xr[64 * j]; s += (v[j].x * v[j].x + v[j].y * v[j].y) + (v[j].z * v[j].z + v[j].w * v[j].w); }
    const float r = 1.0f / sqrtf(wave_sum(s) * (1.f / DM) + EPS);
#pragma unroll
    for (int j = 0; j < 4; ++j) { u32x2 o; o.x = cvtpk(v[j].x, v[j].y); o.y = cvtpk(v[j].z, v[j].w); ((u32x2*)orow)[lane + 64 * j] = o; }
    if (lane == 0) *rs = r;
}
template <bool HF32, bool LAST, int R> __device__ __forceinline__ void res_rows(const void* hin, const bf16* yin, const float* gpost, void* hout, float* rs, size_t m0, size_t mstep, int lane) {
    float h[R][2][8], y[R][2][8], s[R];
#pragma unroll
    for (int q = 0; q < R; ++q) { const size_t m = m0 + q * mstep; s[q] = 0.f;
#pragma unroll
        for (int j = 0; j < 2; ++j) {
            if (HF32) { const f32x4* hp = (const f32x4*)((const float*)hin + m * DM); const f32x4 a = hp[2 * lane + 128 * j], c = hp[2 * lane + 128 * j + 1];
                h[q][j][0] = a.x; h[q][j][1] = a.y; h[q][j][2] = a.z; h[q][j][3] = a.w; h[q][j][4] = c.x; h[q][j][5] = c.y; h[q][j][6] = c.z; h[q][j][7] = c.w; }
            else { const v4u hh = ((const v4u*)((const bf16*)hin + m * DM))[lane + 64 * j];
                h[q][j][0] = bflo(hh.x); h[q][j][1] = bfhi(hh.x); h[q][j][2] = bflo(hh.y); h[q][j][3] = bfhi(hh.y); h[q][j][4] = bflo(hh.z); h[q][j][5] = bfhi(hh.z); h[q][j][6] = bflo(hh.w); h[q][j][7] = bfhi(hh.w); }
            const v4u yy = ((const v4u*)(yin + m * DM))[lane + 64 * j];
            y[q][j][0] = bflo(yy.x); y[q][j][1] = bfhi(yy.x); y[q][j][2] = bflo(yy.y); y[q][j][3] = bfhi(yy.y); y[q][j][4] = bflo(yy.z); y[q][j][5] = bfhi(yy.z); y[q][j][6] = bflo(yy.w); y[q][j][7] = bfhi(yy.w);
#pragma unroll
            for (int e = 0; e < 8; ++e) s[q] += y[q][j][e] * y[q][j][e]; } }
    float gp[2][8];
#pragma unroll
    for (int j = 0; j < 2; ++j) { const f32x4 g0 = ((const f32x4*)gpost)[2 * lane + 128 * j], g1 = ((const f32x4*)gpost)[2 * lane + 128 * j + 1];
        gp[j][0] = g0.x; gp[j][1] = g0.y; gp[j][2] = g0.z; gp[j][3] = g0.w; gp[j][4] = g1.x; gp[j][5] = g1.y; gp[j][6] = g1.z; gp[j][7] = g1.w; }
#pragma unroll
    for (int q = 0; q < R; ++q) s[q] = wave_sum(s[q]);
    float s2[R];
#pragma unroll
    for (int q = 0; q < R; ++q) { const size_t m = m0 + q * mstep; const float r = 1.0f / sqrtf(s[q] * (1.f / DM) + EPS); s2[q] = 0.f;
#pragma unroll
        for (int j = 0; j < 2; ++j) {
#pragma unroll
            for (int e = 0; e < 8; ++e) { h[q][j][e] = h[q][j][e] + (y[q][j][e] * r) * gp[j][e]; s2[q] += h[q][j][e] * h[q][j][e]; }
            if (LAST) { f32x4* op = (f32x4*)((float*)hout + m * DM); op[2 * lane + 128 * j] = (f32x4){h[q][j][0], h[q][j][1], h[q][j][2], h[q][j][3]}; op[2 * lane + 128 * j + 1] = (f32x4){h[q][j][4], h[q][j][5], h[q][j][6], h[q][j][7]}; }
            else { v4u o; o.x = cvtpk(h[q][j][0], h[q][j][1]); o.y = cvtpk(h[q][j][2], h[q][j][3]); o.z = cvtpk(h[q][j][4], h[q][j][5]); o.w = cvtpk(h[q][j][6], h[q][j][7]); ((v4u*)((bf16*)hout + m * DM))[lane + 64 * j] = o; } } }
    if (!LAST) {
#pragma unroll
        for (int q = 0; q < R; ++q) { const float r2 = 1.0f / sqrtf(wave_sum(s2[q]) * (1.f / DM) + EPS); if (lane == 0) rs[m0 + q * mstep] = r2; } }
}
constexpr int I_WINE = 16 * 80, I_WOUTE = 16 * 32, I_WINO = 16 * 128, I_WOUTO = 32 * 32, I_WFFI = 16 * 176, I_WFFO = 44 * 32;
__device__ __forceinline__ void p0_prologue(Frame& F) {
    LAS float* scr = (LAS float*)(F.lds + RING_OFF + F.wave * 16384);
    const int gw = F.c * NWAVES + F.wave, NGW = F.G * NWAVES;
    constexpr int NITEMS = 2 * (I_WINE + I_WOUTE + I_WINO + I_WOUTO) + 4 * (I_WFFI + I_WFFO);
    for (int it = gw; it < NITEMS; it += NGW) {
        int r = it;
        if (r < 2 * I_WINE) { const int i = r / I_WINE; r -= i * I_WINE; transpose_item(F.w_in_even + (size_t)i * DM * EVEN_IN, DM, EVEN_IN, PP, 1, F.WinE + (size_t)i * PP * DM, scr, r, F.lane, F.gains + (size_t)(2 * i) * 4 * DM); continue; } r -= 2 * I_WINE;
        if (r < 2 * I_WOUTE) { const int i = r / I_WOUTE; r -= i * I_WOUTE; transpose_item(F.w_out_even + (size_t)i * DM * DM, DM, DM, DM, 0, F.WoutE + (size_t)i * DM * DM, scr, r, F.lane); continue; } r -= 2 * I_WOUTE;
        if (r < 2 * I_WINO) { const int i = r / I_WINO; r -= i * I_WINO; transpose_item(F.w_in_odd + (size_t)i * DM * 4096, DM, 4096, 4096, 0, F.WinO + (size_t)i * 4096 * DM, scr, r, F.lane, F.gains + (size_t)(2 * i + 1) * 4 * DM); continue; } r -= 2 * I_WINO;
        if (r < 2 * I_WOUTO) { const int i = r / I_WOUTO; r -= i * I_WOUTO; transpose_item(F.w_out_odd + (size_t)i * CWID * DM, CWID, DM, DM, 0, F.WoutO + (size_t)i * DM * CWID, scr, r, F.lane); continue; } r -= 2 * I_WOUTO;
        if (r < 4 * I_WFFI) { const int i = r / I_WFFI; r -= i * I_WFFI; transpose_item(F.w_ffn_in + (size_t)i * DM * 2 * DFF, DM, 2 * DFF, 2 * DFF, 2, F.Wffi + (size_t)i * 2 * DFF * DM, scr, r, F.lane, F.gains + (size_t)i * 4 * DM + 2 * DM); continue; } r -= 4 * I_WFFI;
        { const int i = r / I_WFFO; r -= i * I_WFFO; transpose_item(F.w_ffn_out + (size_t)i * DFF * DM, DFF, DM, DM, 0, F.Wffo + (size_t)i * DM * DFF, scr, r, F.lane); }
    }
    for (int idx = (F.c * NWAVES * 64 + F.tid); idx < 2 * 16 * 128 * 128 / 2; idx += F.G * NWAVES * 64) {
        const int e0 = 2 * idx, t = (e0 >> 7) & 127, s = e0 & 127; const f32x2 wv = *(const f32x2*)(F.spatial_w + e0);
        const unsigned pk = cvtpk(s <= t ? wv.x : 0.f, (s + 1) <= t ? wv.y : 0.f); ((unsigned*)F.Wsp)[idx] = pk;
        const float rsum = wave_sum(bflo(pk) + bfhi(pk)); if (F.lane == 0) F.WSUM[idx >> 6] = rsum; }
    for (int m = gw; m < M; m += 2 * NGW) {
        const f32x4* x0 = (const f32x4*)(F.x + (size_t)m * DM) + F.lane; const f32x4* x1 = (const f32x4*)(F.x + (size_t)(m + NGW) * DM) + F.lane;
        f32x4 v0[4], v1[4]; float s0 = 0.f, s1 = 0.f;
#pragma unroll
        for (int j = 0; j < 4; ++j) { v0[j] = x0[64 * j]; v1[j] = x1[64 * j]; }
#pragma unroll
        for (int j = 0; j < 4; ++j) { s0 += (v0[j].x * v0[j].x + v0[j].y * v0[j].y) + (v0[j].z * v0[j].z + v0[j].w * v0[j].w); s1 += (v1[j].x * v1[j].x + v1[j].y * v1[j].y) + (v1[j].z * v1[j].z + v1[j].w * v1[j].w); }
        s0 = wave_sum(s0); s1 = wave_sum(s1);
        u32x2* o0 = (u32x2*)(F.A + (size_t)m * DM) + F.lane; u32x2* o1 = (u32x2*)(F.A + (size_t)(m + NGW) * DM) + F.lane;
#pragma unroll
        for (int j = 0; j < 4; ++j) { u32x2 a; a.x = cvtpk(v0[j].x, v0[j].y); a.y = cvtpk(v0[j].z, v0[j].w); o0[64 * j] = a; u32x2 b; b.x = cvtpk(v1[j].x, v1[j].y); b.y = cvtpk(v1[j].z, v1[j].w); o1[64 * j] = b; }
        if (F.lane == 0) { F.RS[m] = 1.0f / sqrtf(s0 * (1.f / DM) + EPS); F.RS[m + NGW] = 1.0f / sqrtf(s1 * (1.f / DM) + EPS); }
    }
}
template <bool HF32, bool LAST> __device__ __forceinline__ void thin_phase(Frame& F, const float* gpost, bool dry = false) {
    const int gw = F.c * NWAVES + F.wave, NGW = F.G * NWAVES;
    const void* hin = HF32 ? (const void*)F.x : (const void*)F.A;
    void* hout = dry ? (void*)F.R1 : (LAST ? (void*)F.out : (void*)F.A);
    float* rs = dry ? F.stats : F.RS;
    for (int m = gw; m < M; m += 2 * NGW) res_rows<HF32, LAST, 2>(hin, F.Y, gpost, hout, rs, (size_t)m, (size_t)NGW, F.lane);
}

#ifdef DBG_SB_FULL
constexpr float SB_STOP = -1e30f;
#else
constexpr float SB_STOP = -60.0f;
#endif
__device__ __forceinline__ void sb_task(const bf16* P, bf16* mix, int task, int lane) {
    const int b = task >> 10, h = (task >> 7) & 7, t = ((task & 127) << 6) + lane;
    const size_t rowq = (size_t)b * SEQ + t;
    float q[64], o[64];
    { const v4u* qp = (const v4u*)(P + rowq * PP + QB_OFF + h * 64);
#pragma unroll
      for (int i = 0; i < 8; ++i) { const v4u w = qp[i]; q[8 * i + 0] = bflo(w.x) * 0.125f; q[8 * i + 1] = bfhi(w.x) * 0.125f; q[8 * i + 2] = bflo(w.y) * 0.125f; q[8 * i + 3] = bfhi(w.y) * 0.125f;
          q[8 * i + 4] = bflo(w.z) * 0.125f; q[8 * i + 5] = bfhi(w.z) * 0.125f; q[8 * i + 6] = bflo(w.w) * 0.125f; q[8 * i + 7] = bfhi(w.w) * 0.125f; } }
#pragma unroll
    for (int d = 0; d < 64; ++d) o[d] = 0.f;
    float after = 0.f; int s = t - 1; bool act = s >= 0;
    while (__any(act)) {
        if (act) {
            const v4u* kp = (const v4u*)(P + ((size_t)b * SEQ + s) * PP + KB_OFF + h * 64);
            const v4u* vp = (const v4u*)(P + ((size_t)b * SEQ + s) * PP + VB_OFF + h * 64);
            float z = 0.f;
#pragma unroll
            for (int i = 0; i < 8; ++i) { const v4u w = kp[i]; z += q[8 * i + 0] * bflo(w.x) + q[8 * i + 1] * bfhi(w.x) + q[8 * i + 2] * bflo(w.y) + q[8 * i + 3] * bfhi(w.y)
                                                                 + q[8 * i + 4] * bflo(w.z) + q[8 * i + 5] * bfhi(w.z) + q[8 * i + 6] * bflo(w.w) + q[8 * i + 7] * bfhi(w.w); }
            const float l1p = __logf(1.0f + __expf(-fabsf(z)));
            const float ls_pos = fminf(z, 0.f) - l1p, ls_neg = fminf(-z, 0.f) - l1p;
            const float wgt = __expf(ls_pos + after);
#pragma unroll
            for (int i = 0; i < 8; ++i) { const v4u w = vp[i]; o[8 * i + 0] += wgt * bflo(w.x); o[8 * i + 1] += wgt * bfhi(w.x); o[8 * i + 2] += wgt * bflo(w.y); o[8 * i + 3] += wgt * bfhi(w.y);
                                           o[8 * i + 4] += wgt * bflo(w.z); o[8 * i + 5] += wgt * bfhi(w.z); o[8 * i + 6] += wgt * bflo(w.w); o[8 * i + 7] += wgt * bfhi(w.w); }
            after += ls_neg; --s; act = (s >= 0) && (after > SB_STOP);
        }
    }
    v4u* op = (v4u*)(mix + rowq * DM + 512 + h * 64);
#ifdef DBG_ZERO_YB
#pragma unroll
    for (int d = 0; d < 64; ++d) o[d] = 0.f;
#endif
#pragma unroll
    for (int i = 0; i < 8; ++i) { v4u w; w.x = cvtpk(o[8 * i + 0], o[8 * i + 1]); w.y = cvtpk(o[8 * i + 2], o[8 * i + 3]); w.z = cvtpk(o[8 * i + 4], o[8 * i + 5]); w.w = cvtpk(o[8 * i + 6], o[8 * i + 7]); op[i] = w; }
}

typedef short v4i16_t __attribute__((ext_vector_type(4)));
constexpr int SB_ROWB = 192, SB_VBUF = 32 * SB_ROWB;
__device__ __forceinline__ void sb_unit(Frame& F, const bf16* P, bf16* mix, int u) {
    const int lane = F.lane, r = lane & 31, hh = lane >> 5;
    const int b = u >> 11, h = (u >> 3) & 7, qb = ((u >> 6) & 31) * 8 + (u & 7), t0 = qb * 32;
    const size_t rowb = (size_t)b * SEQ;
    LAS unsigned char* vb = F.lds + RING_OFF + F.wave * (2 * SB_VBUF);
    pg8::bf16x8 Bq[4];
    { const bf16* qp = P + (rowb + t0 + r) * PP + QB_OFF + h * 64 + 8 * hh;
#pragma unroll
      for (int s = 0; s < 4; ++s) Bq[s] = *(const pg8::bf16x8*)(qp + 16 * s); }
    pg8::bf16x8 Uf[2];
#pragma unroll
    for (int s = 0; s < 2; ++s)
#pragma unroll
        for (int j = 0; j < 8; ++j) Uf[s][j] = ((16 * s + 8 * (j >> 2) + 4 * hh + (j & 3)) > r) ? (short)0x3F80 : (short)0;
    f32x16 oacc[2];
#pragma unroll
    for (int d = 0; d < 2; ++d)
#pragma unroll
        for (int i = 0; i < 16; ++i) oacc[d][i] = 0.f;
    float carry = 0.f;
    const int q4 = (lane & 15) >> 2, p4 = lane & 3, g1 = (lane >> 4) & 1;
    const int troff = (4 * hh + q4) * SB_ROWB + (16 * g1 + 4 * p4) * 2;
    pg8::bf16x8 Akn[4]; v4u Vn[4];
#define SB_LOAD(KT) do { const bf16* kp_ = P + (rowb + 32 * (KT) + r) * PP + KB_OFF + h * 64 + 8 * hh; \
        _Pragma("unroll") for (int s_ = 0; s_ < 4; ++s_) Akn[s_] = *(const pg8::bf16x8*)(kp_ + 16 * s_); \
        _Pragma("unroll") for (int i_ = 0; i_ < 4; ++i_) { const int c_ = lane + 64 * i_; Vn[i_] = *(const v4u*)(P + (rowb + 32 * (KT) + (c_ >> 3)) * PP + VB_OFF + h * 64 + 8 * (c_ & 7)); } } while (0)
    SB_LOAD(qb);
    for (int kt = qb; kt >= 0; --kt) {
        LAS unsigned char* vt = vb + (kt & 1) * SB_VBUF;
        pg8::bf16x8 Ak[4];
#pragma unroll
        for (int s = 0; s < 4; ++s) Ak[s] = Akn[s];
#pragma unroll
        for (int i = 0; i < 4; ++i) { const int c = lane + 64 * i; *(LAS v4u*)(vt + (c >> 3) * SB_ROWB + (c & 7) * 16) = Vn[i]; }
        if (kt > 0) SB_LOAD(kt - 1);
        f32x16 d1;
#pragma unroll
        for (int i = 0; i < 16; ++i) d1[i] = 0.f;
#pragma unroll
        for (int s = 0; s < 4; ++s) d1 = __builtin_amdgcn_mfma_f32_32x32x16_bf16(Ak[s], Bq[s], d1, 0, 0, 0);
        const bool diag = (kt == qb);
        float tot = 0.f;
        v4u hi[2], lo[2];
#pragma unroll
        for (int s = 0; s < 2; ++s)
#pragma unroll
            for (int mm = 0; mm < 4; ++mm) { float a2[2];
#pragma unroll
                for (int x = 0; x < 2; ++x) { const int i = 8 * s + 2 * mm + x; const float z = d1[i] * 0.125f; const float l1p = __logf(1.0f + __expf(-fabsf(z)));
                    const bool dead = diag && ((8 * (i >> 2) + 4 * hh + (i & 3)) >= r);
                    a2[x] = dead ? 0.f : (fminf(-z, 0.f) - l1p); tot += a2[x]; d1[i] = dead ? -INFINITY : z; }
                const unsigned hp = cvtpk(a2[0], a2[1]); hi[s][mm] = hp; lo[s][mm] = cvtpk(a2[0] - bflo(hp), a2[1] - bfhi(hp)); }
        tot = xsum32(tot);
        f32x16 aft;
#pragma unroll
        for (int i = 0; i < 16; ++i) aft[i] = 0.f;
#pragma unroll
        for (int s = 0; s < 2; ++s) {
            aft = __builtin_amdgcn_mfma_f32_32x32x16_bf16(Uf[s], __builtin_bit_cast(pg8::bf16x8, hi[s]), aft, 0, 0, 0);
            aft = __builtin_amdgcn_mfma_f32_32x32x16_bf16(Uf[s], __builtin_bit_cast(pg8::bf16x8, lo[s]), aft, 0, 0, 0); }
        asm volatile("s_waitcnt lgkmcnt(0)" ::: "memory");
#pragma unroll
        for (int s = 0; s < 2; ++s) { v4u wf;
#pragma unroll
            for (int mm = 0; mm < 4; ++mm) { const int i0 = 8 * s + 2 * mm;
                const float e0 = (bflo(hi[s][mm]) + bflo(lo[s][mm])) + d1[i0] + aft[i0] + carry, e1 = (bfhi(hi[s][mm]) + bfhi(lo[s][mm])) + d1[i0 + 1] + aft[i0 + 1] + carry;
                wf[mm] = cvtpk(__expf(e0), __expf(e1)); }
            const pg8::bf16x8 wfrag = __builtin_bit_cast(pg8::bf16x8, wf);
#pragma unroll
            for (int db = 0; db < 2; ++db) { LAS unsigned char* ta = vt + troff + 16 * s * SB_ROWB + 64 * db;
                const v4i16_t v0 = __builtin_amdgcn_ds_read_tr16_b64_v4i16((LAS v4i16_t*)ta), v1 = __builtin_amdgcn_ds_read_tr16_b64_v4i16((LAS v4i16_t*)(ta + 8 * SB_ROWB));
                pg8::bf16x8 va; va[0] = v0[0]; va[1] = v0[1]; va[2] = v0[2]; va[3] = v0[3]; va[4] = v1[0]; va[5] = v1[1]; va[6] = v1[2]; va[7] = v1[3];
                oacc[db] = __builtin_amdgcn_mfma_f32_32x32x16_bf16(va, wfrag, oacc[db], 0, 0, 0); } }
        carry += tot;
        if (__ballot(carry > SB_STOP) == 0ull) break;
    }
#undef SB_LOAD
    bf16* op = mix + (rowb + t0 + r) * DM + 512 + h * 64 + 4 * hh;
#pragma unroll
    for (int db = 0; db < 2; ++db)
#pragma unroll
        for (int ig = 0; ig < 4; ++ig) { u32x2 o; o.x = cvtpk(oacc[db][4 * ig], oacc[db][4 * ig + 1]); o.y = cvtpk(oacc[db][4 * ig + 2], oacc[db][4 * ig + 3]);
            *(u32x2*)(op + 32 * db + 8 * ig) = o; }
}

__device__ __forceinline__ unsigned f2key16(float x) {
    const unsigned bits = (unsigned)__builtin_bit_cast(unsigned short, (_Float16)x);
    const int m = ((int)(bits << 16)) >> 31;
    return bits ^ (0x8000u | ((unsigned)m & 0x7fffu));
}
__device__ __forceinline__ float relu2_f(float x) { return x + __builtin_fabsf(x); }
__device__ __forceinline__ unsigned wave_prefix_incl(unsigned v) {
    v += (unsigned)__builtin_amdgcn_update_dpp(0, (int)v, 0x111, 0xf, 0xf, false);
    v += (unsigned)__builtin_amdgcn_update_dpp(0, (int)v, 0x112, 0xf, 0xf, false);
    v += (unsigned)__builtin_amdgcn_update_dpp(0, (int)v, 0x114, 0xf, 0xf, false);
    v += (unsigned)__builtin_amdgcn_update_dpp(0, (int)v, 0x118, 0xf, 0xf, false);
    v += (unsigned)__builtin_amdgcn_update_dpp(0, (int)v, 0x142, 0xa, 0xf, false);
    v += (unsigned)__builtin_amdgcn_update_dpp(0, (int)v, 0x143, 0xc, 0xf, false);
    return v;
}
__device__ __forceinline__ unsigned half_min_u(unsigned v) {
#define HM_STEP(CTRL, RM) { const unsigned o_ = (unsigned)__builtin_amdgcn_update_dpp(-1, (int)v, CTRL, RM, 0xf, false); v = o_ < v ? o_ : v; }
    HM_STEP(0x111, 0xf) HM_STEP(0x112, 0xf) HM_STEP(0x114, 0xf) HM_STEP(0x118, 0xf) HM_STEP(0x142, 0xa)
#undef HM_STEP
    return v;
}
__device__ __forceinline__ int opq(int x) { asm volatile("" : "+v"(x)); return x; }
__device__ __forceinline__ void hist_zero(LAS unsigned* H, int lane) { unsigned z = 0u; asm volatile("" : "+v"(z)); *(LAS v4u*)(H + 4 * lane) = (v4u){z, z, z, z}; }
__device__ __forceinline__ void hist_find(const LAS unsigned* H, int lane_in, unsigned want, unsigned& bin, unsigned& n_above, unsigned& n_in) {
    const int lane = opq(lane_in), grp = 63 - lane;
    const v4u h4 = *(const LAS v4u*)(H + 4 * grp);
    const unsigned s = h4[0] + h4[1] + h4[2] + h4[3];
    const unsigned suf = wave_prefix_incl(s);
    const unsigned above = suf - s;
    const bool mine = (suf >= want) && (above < want);
    unsigned bl = 0, na = above, ni = 0;
    { unsigned cum = above; bool found = false;
#pragma unroll
      for (int i = 3; i >= 0; --i) { const unsigned hv = h4[i]; if (!found && cum + hv >= want) { bl = (unsigned)(4 * grp + i); na = cum; ni = hv; found = true; } cum += found ? 0u : hv; } }
    const unsigned long long mk = __ballot(mine);
    const int src = mk ? (int)__builtin_ctzll(mk) : 0;
    bin = (unsigned)__builtin_amdgcn_readlane((int)bl, src); n_above = (unsigned)__builtin_amdgcn_readlane((int)na, src); n_in = (unsigned)__builtin_amdgcn_readlane((int)ni, src);
}
template <int NB> struct BfBatch { pg8::bf16x8 f[NB][4]; };
struct DsaPre { pg8::bf16x8 Af[4]; u32x2 ww[4]; BfBatch<4> Ba; };
__device__ __forceinline__ void dsa_prefetch(Frame& F, const bf16* P, int b, int qg, DsaPre& pre) {
    const int lane = opq(F.lane), w = F.wave, r = lane & 31, hh = lane >> 5;
    const int t0 = qg * 8; const size_t rowb = (size_t)b * SEQ; const int nreal = (t0 + 8 + 31) >> 5;
    { const bf16* ap = P + (rowb + t0 + (r >> 2)) * PP + QI_OFF + (r & 3) * 64 + 8 * hh;
#pragma unroll
      for (int s = 0; s < 4; ++s) pre.Af[s] = *(const pg8::bf16x8*)(ap + 16 * s); }
#pragma unroll
    for (int bq = 0; bq < 4; ++bq) pre.ww[bq] = *(const u32x2*)(P + (rowb + t0 + 2 * bq + hh) * PP + WI_OFF);
    const bf16* kbase = F.KT + (size_t)b * 256 * 2048 + lane * 8;
#pragma unroll
    for (int i = 0; i < 4; ++i) { const int tq = w + 8 * i, tl = tq < nreal ? tq : nreal - 1; const bf16* kp = kbase + (size_t)tl * 2048;
#pragma unroll
        for (int s = 0; s < 4; ++s) pre.Ba.f[i][s] = *(const pg8::bf16x8*)(kp + 512 * s); }
}
#ifdef PROBE_SEL
#define PSTAMP(id) do { if (F.wave == 0) { const unsigned now_ = (unsigned)__builtin_amdgcn_s_memtime(); if (F.lane == 0) { LAS unsigned* pw_ = (LAS unsigned*)(F.lds + 131072 + 640); pw_[id] += now_ - pw_[15]; pw_[15] = now_; } } } while (0)
#else
#define PSTAMP(id) do { } while (0)
#endif
__device__ __forceinline__ void dsa_unit(Frame& F, const bf16* P, bf16* mix, int b, int qg, DsaPre& pre, bool has_next, int qg_next) {
    PSTAMP(4);
    int lane = opq(F.lane); const int w = F.wave, r = lane & 31, hh = lane >> 5;
    const int t0 = qg * 8; const size_t rowb = (size_t)b * SEQ;
    LAS unsigned short* S = (LAS unsigned short*)(F.lds + RING_OFF);
    const int N = t0 + 8, nreal = (N + 31) >> 5, ntiles = ((N + 511) >> 9) << 4;
    pg8::bf16x8 Af[4];
#pragma unroll
    for (int s = 0; s < 4; ++s) Af[s] = pre.Af[s];
    unsigned mxk[4] = {0u, 0u, 0u, 0u};
    float wg[4][4];
#pragma unroll
    for (int bq = 0; bq < 4; ++bq) { const u32x2 ww = pre.ww[bq];
        wg[bq][0] = bflo(ww.x) * 0.03125f; wg[bq][1] = bfhi(ww.x) * 0.03125f; wg[bq][2] = bflo(ww.y) * 0.03125f; wg[bq][3] = bfhi(ww.y) * 0.03125f; }
    const bf16* kbase = F.KT + (size_t)b * 256 * 2048 + lane * 8;
#define DSA_LOAD1(B, I, TL) do { const int tl_ = (TL); if (tl_ < nreal) { const bf16* kp_ = kbase + (size_t)tl_ * 2048; \
        _Pragma("unroll") for (int s_ = 0; s_ < 4; ++s_) (B).f[I][s_] = *(const pg8::bf16x8*)(kp_ + 512 * s_); } } while (0)
    {   BfBatch<4>& Ba = pre.Ba;
        for (int tb = w; tb < nreal; tb += 32) {
#pragma unroll
            for (int i = 0; i < 4; ++i) { const int tl = tb + 8 * i; if (tl < nreal) { const int key = tl * 32 + r; f32x16 acc;
#pragma unroll
                for (int z = 0; z < 16; ++z) acc[z] = 0.f;
#pragma unroll
                for (int s = 0; s < 4; ++s) acc = __builtin_amdgcn_mfma_f32_32x32x16_bf16(Af[s], Ba.f[i][s], acc, 0, 0, 0);
                DSA_LOAD1(Ba, i, tl + 32);
                const int pos = (key & ~511) + (key & 63) * 8 + ((key & 511) >> 6);
#pragma unroll
                for (int bq = 0; bq < 4; ++bq) {
                    const float sc = __builtin_fmaf(wg[bq][3], relu2_f(acc[4 * bq + 3]), __builtin_fmaf(wg[bq][2], relu2_f(acc[4 * bq + 2]), __builtin_fmaf(wg[bq][1], relu2_f(acc[4 * bq + 1]), wg[bq][0] * relu2_f(acc[4 * bq + 0]))));
                    const unsigned vmask = (key <= t0 + 2 * bq + hh) ? 0xffffu : 0u;
                    const unsigned kk = f2key16(sc) & vmask; mxk[bq] = kk > mxk[bq] ? kk : mxk[bq];
                    S[(2 * bq + hh) * 8192 + pos] = (unsigned short)kk; } } }
        }
    }
#undef DSA_LOAD1
    for (int tile = nreal + w; tile < ntiles; tile += 8) { const int key = tile * 32 + r; const int pos = (key & ~511) + (key & 63) * 8 + ((key & 511) >> 6);
#pragma unroll
        for (int bq = 0; bq < 4; ++bq) S[(2 * bq + hh) * 8192 + pos] = (unsigned short)0; }
    { LAS unsigned short* LB = (LAS unsigned short*)(F.lds + LB_OFF);
#pragma unroll
      for (int bq = 0; bq < 4; ++bq) { const unsigned v = half_min_u(mxk[bq]); if ((lane & 31) == 31) LB[(2 * bq + hh) * 8 + w] = (unsigned short)v; } }
    __syncthreads();
    PSTAMP(5);
    lane = opq(lane);
    const int t = t0 + w, nch = (t >> 9) + 1;
    LAS unsigned short* Sw = S + w * 8192;
    LAS unsigned short* Lw = (LAS unsigned short*)(F.lds + LIST_OFF) + w * 256;
    LAS unsigned* H = (LAS unsigned*)(F.lds + HIST_OFF) + w * 256;
    int count = 0;
#ifndef DSA_REP_SEL
#define DSA_REP_SEL 1
#endif
#pragma unroll 1
    for (int rep_ = 0; rep_ < DSA_REP_SEL; ++rep_)
    if (t + 1 <= TOPK) {
        count = t + 1;
#pragma unroll
        for (int j = 0; j < 4; ++j) if (lane + 64 * j < count) Lw[lane + 64 * j] = (unsigned short)(lane + 64 * j);
    } else {
        count = TOPK;
        unsigned Lq;
        { const v4u lb4 = *(const LAS v4u*)((LAS unsigned short*)(F.lds + LB_OFF) + w * 8); unsigned mn = 0xffffu;
#pragma unroll
          for (int d = 0; d < 4; ++d) { const unsigned lo = lb4[d] & 0xffffu, hi = lb4[d] >> 16; mn = lo < mn ? lo : mn; mn = hi < mn ? hi : mn; }
          Lq = (unsigned)__builtin_amdgcn_readfirstlane((int)(mn ? mn : 1u)); }
        hist_zero(H, lane);
        for (int c = 0; c < nch; ++c) { const v4u x4 = *(const LAS v4u*)(Sw + c * 512 + 8 * lane);
#pragma unroll
            for (int d = 0; d < 4; ++d) { const unsigned x = x4[d], xl = x & 0xffffu, xh = x >> 16;
                if (xl >= Lq) __hip_atomic_fetch_add(H + (xl >> 8), 1u, __ATOMIC_RELAXED, __HIP_MEMORY_SCOPE_WAVEFRONT);
                if (xh >= Lq) __hip_atomic_fetch_add(H + (xh >> 8), 1u, __ATOMIC_RELAXED, __HIP_MEMORY_SCOPE_WAVEFRONT); } }
        asm volatile("s_waitcnt lgkmcnt(0)" ::: "memory");
        unsigned b1, above1, in1; hist_find(H, lane, (unsigned)TOPK, b1, above1, in1);
        asm volatile("s_waitcnt lgkmcnt(0)" ::: "memory");
        hist_zero(H, lane);
        for (int c = 0; c < nch; ++c) { const v4u x4 = *(const LAS v4u*)(Sw + c * 512 + 8 * lane);
#pragma unroll
            for (int d = 0; d < 4; ++d) { const unsigned x = x4[d], xl = x & 0xffffu, xh = x >> 16;
                if ((xl >> 8) == b1) __hip_atomic_fetch_add(H + (xl & 0xffu), 1u, __ATOMIC_RELAXED, __HIP_MEMORY_SCOPE_WAVEFRONT);
                if ((xh >> 8) == b1) __hip_atomic_fetch_add(H + (xh & 0xffu), 1u, __ATOMIC_RELAXED, __HIP_MEMORY_SCOPE_WAVEFRONT); } }
        asm volatile("s_waitcnt lgkmcnt(0)" ::: "memory");
        unsigned b2, above2, in2; hist_find(H, lane, (unsigned)TOPK - above1, b2, above2, in2);
        const unsigned T = (b1 << 8) | b2, need = (unsigned)TOPK - above1 - above2;
        const unsigned n_gt = above1 + above2;
        const bool ordered = in2 > need;
        const unsigned Tsel = ordered ? T + 1u : T;
        unsigned cntl = 0u;
        for (int c = 0; c < nch; ++c) { const v4u x4 = *(const LAS v4u*)(Sw + c * 512 + 8 * lane);
#pragma unroll
            for (int d = 0; d < 4; ++d) { const unsigned x = x4[d]; cntl += ((x & 0xffffu) >= Tsel ? 1u : 0u) + ((x >> 16) >= Tsel ? 1u : 0u); } }
        const unsigned pre = wave_prefix_incl(cntl);
        unsigned pos = pre - cntl;
        for (int c = 0; c < nch; ++c) { const v4u x4 = *(const LAS v4u*)(Sw + c * 512 + 8 * lane);
#pragma unroll
            for (int e = 0; e < 8; ++e) { const unsigned x = (e & 1) ? (x4[e >> 1] >> 16) : (x4[e >> 1] & 0xffffu);
                if (x >= Tsel) { Lw[pos] = (unsigned short)(c * 512 + e * 64 + lane); ++pos; } } }
        if (ordered) { unsigned eqc = 0u;
            for (int c = 0; c < nch && eqc < need; ++c) { const v4u x4 = *(const LAS v4u*)(Sw + c * 512 + 8 * lane);
#pragma unroll
                for (int e = 0; e < 8; ++e) { const unsigned x = (e & 1) ? (x4[e >> 1] >> 16) : (x4[e >> 1] & 0xffffu);
                    const bool eq = (x == T); const unsigned long long meq = __ballot(eq);
                    if (meq) { const unsigned rk = eqc + __builtin_amdgcn_mbcnt_hi((unsigned)(meq >> 32), __builtin_amdgcn_mbcnt_lo((unsigned)meq, 0u));
                        if (eq && rk < need) Lw[n_gt + rk] = (unsigned short)(c * 512 + e * 64 + lane);
                        eqc += (unsigned)__builtin_popcountll(meq); } } } }
    }
    asm volatile("s_waitcnt lgkmcnt(0)" ::: "memory");
    PSTAMP(6);
    {
        lane = opq(lane);
        const int hcol = lane & 15, g = lane >> 4, q4 = (lane & 15) >> 2, p4 = lane & 3;
        LAS unsigned char* vimg = (LAS unsigned char*)Sw;
        pg8::bf16x8 Qf[2];
        { const bf16* qp = P + (rowb + t) * PP + QA_OFF + (hcol & 7) * 64 + 8 * g; Qf[0] = *(const pg8::bf16x8*)qp; Qf[1] = *(const pg8::bf16x8*)(qp + 32); }
        f32x4 lg[16]; v4u vrA[8], vrB[8];
        pg8::bf16x8 KfA[4][2], KfB[4][2];
#define DSA_KLOAD(KF, QT) do { _Pragma("unroll") for (int aa = 0; aa < 4; ++aa) { const int jp = (4 * (QT) + aa) * 16 + hcol; const int idx = jp < count ? (int)Lw[jp] : 0; \
            const bf16* kp = P + (rowb + idx) * PP + KA_OFF + 8 * g; KF[aa][0] = *(const pg8::bf16x8*)kp; KF[aa][1] = *(const pg8::bf16x8*)(kp + 32); } } while (0)
#define DSA_KMMA(KF, QT) do { asm volatile("" : "+v"(KF[0][0]), "+v"(KF[0][1]), "+v"(KF[1][0]), "+v"(KF[1][1]), "+v"(KF[2][0]), "+v"(KF[2][1]), "+v"(KF[3][0]), "+v"(KF[3][1]) :: "memory"); \
            _Pragma("unroll") for (int aa = 0; aa < 4; ++aa) { f32x4 acc = {0.f, 0.f, 0.f, 0.f}; \
                acc = __builtin_amdgcn_mfma_f32_16x16x32_bf16(KF[aa][0], Qf[0], acc, 0, 0, 0); acc = __builtin_amdgcn_mfma_f32_16x16x32_bf16(KF[aa][1], Qf[1], acc, 0, 0, 0); \
                lg[4 * (QT) + aa] = acc; } } while (0)
#define DSA_VLOAD(VR, CK) do { _Pragma("unroll") for (int i = 0; i < 8; ++i) { const int c8 = lane + 64 * i, row = c8 >> 3, ch = c8 & 7; const int jp = 64 * (CK) + row; const int idx = jp < count ? (int)Lw[jp] : 0; \
            VR[i] = *(const v4u*)(P + (rowb + idx) * PP + VA_OFF + 8 * ch); } } while (0)
        DSA_KLOAD(KfA, 0); DSA_KLOAD(KfB, 1);
        DSA_KMMA(KfA, 0); DSA_KLOAD(KfA, 2);
        DSA_KMMA(KfB, 1); DSA_KLOAD(KfB, 3);
        DSA_VLOAD(vrA, 0);
        DSA_KMMA(KfA, 2); DSA_VLOAD(vrB, 1);
        DSA_KMMA(KfB, 3);
#undef DSA_KLOAD
#undef DSA_KMMA
        float mx = -INFINITY;
#pragma unroll
        for (int aa = 0; aa < 16; ++aa)
#pragma unroll
            for (int i = 0; i < 4; ++i) { float v = lg[aa][i] * 0.125f; if (count < TOPK && (16 * aa + 4 * g + i) >= count) v = -INFINITY; lg[aa][i] = v; mx = fmaxf(mx, v); }
        mx = xmax16(mx); mx = xmax32(mx);
        float sm = 0.f;
#pragma unroll
        for (int aa = 0; aa < 16; ++aa)
#pragma unroll
            for (int i = 0; i < 4; ++i) { const float pv = __expf(lg[aa][i] - mx); lg[aa][i] = pv; sm += pv; }
        sm = xsum16(sm); sm = xsum32(sm);
        const float inv = 1.0f / sm;
        f32x4 oacc[4];
#pragma unroll
        for (int db = 0; db < 4; ++db) oacc[db] = (f32x4){0.f, 0.f, 0.f, 0.f};
        const int troff = (4 * g + q4) * 160 + 8 * p4;
#define DSA_VCHUNK(VR, CK) do { constexpr int ck = (CK); \
            asm volatile("" : "+v"(VR[0]), "+v"(VR[1]), "+v"(VR[2]), "+v"(VR[3]), "+v"(VR[4]), "+v"(VR[5]), "+v"(VR[6]), "+v"(VR[7]) :: "memory"); \
            _Pragma("unroll") for (int i = 0; i < 8; ++i) { const int c8 = lane + 64 * i, row = c8 >> 3, ch = c8 & 7; *(LAS v4u*)(vimg + row * 160 + ch * 16) = VR[i]; } \
            if (ck + 2 < 4) DSA_VLOAD(VR, ck + 2); \
            DSA_VMMA(ck); } while (0)
#define DSA_VMMA(ck) do { \
                asm volatile("s_waitcnt lgkmcnt(0)" ::: "memory"); \
    _Pragma("unroll") \
                for (int ks = 0; ks < 2; ++ks) { \
                    v4u pw;                                                         \
                    { float e0[4], e1[4]; \
    _Pragma("unroll") \
                      for (int i = 0; i < 4; ++i) { e0[i] = 0.f; e1[i] = 0.f; } \
    _Pragma("unroll") \
                      for (int aa = 0; aa < 16; aa += 2) if (aa == 4 * ck + 2 * ks) { \
    _Pragma("unroll") \
                          for (int i = 0; i < 4; ++i) { e0[i] = lg[aa][i]; e1[i] = lg[aa + 1][i]; } } \
                      pw[0] = cvtpk(e0[0], e0[1]); pw[1] = cvtpk(e0[2], e0[3]); pw[2] = cvtpk(e1[0], e1[1]); pw[3] = cvtpk(e1[2], e1[3]); } \
                    const pg8::bf16x8 pfrag = __builtin_bit_cast(pg8::bf16x8, pw); \
    _Pragma("unroll") \
                    for (int db = 0; db < 4; ++db) { LAS unsigned char* ta = vimg + troff + (32 * ks) * 160 + 32 * db; \
                        const v4i16_t v0 = __builtin_amdgcn_ds_read_tr16_b64_v4i16((LAS v4i16_t*)ta), v1 = __builtin_amdgcn_ds_read_tr16_b64_v4i16((LAS v4i16_t*)(ta + 16 * 160)); \
                        pg8::bf16x8 va; va[0] = v0[0]; va[1] = v0[1]; va[2] = v0[2]; va[3] = v0[3]; va[4] = v1[0]; va[5] = v1[1]; va[6] = v1[2]; va[7] = v1[3]; \
                        oacc[db] = __builtin_amdgcn_mfma_f32_16x16x32_bf16(va, pfrag, oacc[db], 0, 0, 0); } } \
                asm volatile("s_waitcnt lgkmcnt(0)" ::: "memory"); \
        } while (0)
        DSA_VCHUNK(vrA, 0); DSA_VCHUNK(vrB, 1); DSA_VCHUNK(vrA, 2); DSA_VCHUNK(vrB, 3);
#undef DSA_VCHUNK
#undef DSA_VMMA
#undef DSA_VLOAD
        if (hcol < 8) { bf16* op = mix + (rowb + t) * DM + hcol * 64 + 4 * g;
#pragma unroll
            for (int db = 0; db < 4; ++db) { u32x2 o; o.x = cvtpk(oacc[db][0] * inv, oacc[db][1] * inv); o.y = cvtpk(oacc[db][2] * inv, oacc[db][3] * inv); *(u32x2*)(op + 16 * db) = o; } }
    }
    PSTAMP(7);
    dsa_prefetch(F, P, b, qg_next, pre);
    asm volatile("s_waitcnt lgkmcnt(0)" ::: "memory"); __builtin_amdgcn_s_barrier(); asm volatile("" ::: "memory");
    PSTAMP(8);
}

constexpr int SP_PITCH = 320, SP_IMG = 128 * SP_PITCH;
constexpr int SP_SPITCH = 272, SP_STAGE = 128 * SP_SPITCH;
__device__ __forceinline__ void spatial_chunk(Frame& F, int li, int ch, const bf16* U, const bf16* V, bf16* UO) {
    LAS unsigned char* img = F.lds + RING_OFF;
    LAS unsigned char* stg = F.lds + RING_OFF + 2 * SP_IMG;
    LAS float* NB = (LAS float*)(F.lds + RING_OFF + 2 * SP_IMG + SP_STAGE); LAS float* RS = NB + 128;
    const size_t r0 = (size_t)ch * 128; const int lane = F.lane;
    { const int row = F.tid >> 2, part = F.tid & 3; const f32x2* sp = (const f32x2*)F.stats + (r0 + row) * 32 + part * 8; float s = 0.f, q = 0.f;
#pragma unroll
      for (int k = 0; k < 8; ++k) { const f32x2 a = sp[k]; s += a.x; q += a.y; }
      s += __shfl_xor(s, 1); s += __shfl_xor(s, 2); q += __shfl_xor(q, 1); q += __shfl_xor(q, 2);
      if (part == 0) { const float mu = s * (1.f / CWID); const float var = fmaxf(q * (1.f / CWID) - mu * mu, 0.f); const float rs = 1.0f / sqrtf(var + EPS); RS[row] = rs; NB[row] = -mu * rs; } }
    const int cb = F.wave >> 1, tk0 = F.wave & 1, tk1 = 3 - tk0, r = lane & 31, hh = lane >> 5, q4 = (lane & 15) >> 2, p4 = lane & 3, g1 = (lane >> 4) & 1;
    const int troff = (8 * hh + q4) * SP_PITCH + (32 * cb + 16 * g1 + 4 * p4) * 2;
    const int prow = F.tid >> 4, pcol = 8 * (F.tid & 15);
    const bf16* vp = V + (r0 + prow) * CWID + pcol; const bf16* up = U + (r0 + prow) * CWID + pcol; bf16* uop = UO + (r0 + prow) * CWID + pcol;
    const float* gvp = F.vgain + li * CWID + 32 * cb + 4 * hh; const float* bvp = F.vbias + li * CWID + 32 * cb + 4 * hh;
    const float* bsp = F.spatial_b + li * 16 * 128; const float* wsp = F.WSUM + li * 16 * 128;
    const bf16* wb0 = F.Wsp + (size_t)li * 16 * 128 * 128 + (32 * tk0 + r) * 128 + 8 * hh; const bf16* wb1 = F.Wsp + (size_t)li * 16 * 128 * 128 + (32 * tk1 + r) * 128 + 8 * hh;
    v4u vreg[4], ureg[4]; pg8::bf16x8 bf0[4], bf1[8]; float bs[2], ws[2];
#pragma unroll
    for (int it = 0; it < 4; ++it) vreg[it] = *(const v4u*)(vp + (size_t)it * 32 * CWID);
#pragma unroll
    for (int ks = 0; ks < 4; ++ks) bf0[ks] = *(const pg8::bf16x8*)(wb0 + 16 * ks);
#pragma unroll
    for (int ks = 0; ks < 8; ++ks) bf1[ks] = *(const pg8::bf16x8*)(wb1 + 16 * ks);
    bs[0] = bsp[32 * tk0 + r]; bs[1] = bsp[32 * tk1 + r]; ws[0] = wsp[32 * tk0 + r]; ws[1] = wsp[32 * tk1 + r];
#pragma unroll
    for (int it = 0; it < 4; ++it) ureg[it] = *(const v4u*)(up + (size_t)it * 32 * CWID);
    __syncthreads();
#pragma unroll 1
    for (int g = 0; g < 16; ++g) {
        const int c0 = g * 128, gn = g < 15 ? g + 1 : 15; LAS unsigned char* buf = img + (g & 1) * SP_IMG;
        f32x4 gv[4], bv[4];
#pragma unroll
        for (int ig = 0; ig < 4; ++ig) { gv[ig] = *(const f32x4*)(gvp + c0 + 8 * ig); bv[ig] = *(const f32x4*)(bvp + c0 + 8 * ig); }
#pragma unroll
        for (int it = 0; it < 4; ++it) { const int s = prow + 32 * it; const v4u raw = vreg[it]; const float rs = RS[s], nb = NB[s];
            v4u o;
            o.x = cvtpk(__builtin_fmaf(bflo(raw.x), rs, nb), __builtin_fmaf(bfhi(raw.x), rs, nb)); o.y = cvtpk(__builtin_fmaf(bflo(raw.y), rs, nb), __builtin_fmaf(bfhi(raw.y), rs, nb));
            o.z = cvtpk(__builtin_fmaf(bflo(raw.z), rs, nb), __builtin_fmaf(bfhi(raw.z), rs, nb)); o.w = cvtpk(__builtin_fmaf(bflo(raw.w), rs, nb), __builtin_fmaf(bfhi(raw.w), rs, nb));
            *(LAS v4u*)(buf + s * SP_PITCH + pcol * 2) = o; }
#pragma unroll
        for (int it = 0; it < 4; ++it) vreg[it] = *(const v4u*)(vp + (size_t)it * 32 * CWID + gn * 128);
        __syncthreads();
        f32x16 acc[2];
#pragma unroll
        for (int x = 0; x < 2; ++x)
#pragma unroll
            for (int i = 0; i < 16; ++i) acc[x][i] = 0.f;
#pragma unroll
        for (int ks = 0; ks < 8; ++ks) { LAS unsigned char* ta = buf + troff + 16 * ks * SP_PITCH;
            const v4i16_t v0 = __builtin_amdgcn_ds_read_tr16_b64_v4i16((LAS v4i16_t*)ta), v1 = __builtin_amdgcn_ds_read_tr16_b64_v4i16((LAS v4i16_t*)(ta + 4 * SP_PITCH));
            pg8::bf16x8 va; va[0] = v0[0]; va[1] = v0[1]; va[2] = v0[2]; va[3] = v0[3]; va[4] = v1[0]; va[5] = v1[1]; va[6] = v1[2]; va[7] = v1[3];
            if (ks < 4) acc[0] = __builtin_amdgcn_mfma_f32_32x32x16_bf16(va, bf0[ks], acc[0], 0, 0, 0);
            acc[1] = __builtin_amdgcn_mfma_f32_32x32x16_bf16(va, bf1[ks], acc[1], 0, 0, 0); }
        { const size_t wo = (size_t)gn * 128 * 128;
#pragma unroll
          for (int ks = 0; ks < 4; ++ks) bf0[ks] = *(const pg8::bf16x8*)(wb0 + wo + 16 * ks);
#pragma unroll
          for (int ks = 0; ks < 8; ++ks) bf1[ks] = *(const pg8::bf16x8*)(wb1 + wo + 16 * ks); }
#pragma unroll
        for (int x = 0; x < 2; ++x) { const int t = 32 * (x ? tk1 : tk0) + r; const float wsx = ws[x], bsx = bs[x];
#pragma unroll
            for (int ig = 0; ig < 4; ++ig) { const f32x4 a = {acc[x][4 * ig + 0], acc[x][4 * ig + 1], acc[x][4 * ig + 2], acc[x][4 * ig + 3]}; const f32x4 e = gv[ig] * a + (bv[ig] * wsx + bsx);
                u32x2 o; o.x = cvtpk(e[0], e[1]); o.y = cvtpk(e[2], e[3]);
                *(LAS u32x2*)(stg + t * SP_SPITCH + (32 * cb + 8 * ig + 4 * hh) * 2) = o; } }
        bs[0] = bsp[gn * 128 + 32 * tk0 + r]; bs[1] = bsp[gn * 128 + 32 * tk1 + r]; ws[0] = wsp[gn * 128 + 32 * tk0 + r]; ws[1] = wsp[gn * 128 + 32 * tk1 + r];
        __syncthreads();
#pragma unroll
        for (int it = 0; it < 4; ++it) { const int t = prow + 32 * it; const v4u sv = *(const LAS v4u*)(stg + t * SP_SPITCH + pcol * 2); const v4u uv = ureg[it];
            v4u o; o.x = cvtpk(bflo(uv.x) * bflo(sv.x), bfhi(uv.x) * bfhi(sv.x)); o.y = cvtpk(bflo(uv.y) * bflo(sv.y), bfhi(uv.y) * bfhi(sv.y));
            o.z = cvtpk(bflo(uv.z) * bflo(sv.z), bfhi(uv.z) * bfhi(sv.z)); o.w = cvtpk(bflo(uv.w) * bflo(sv.w), bfhi(uv.w) * bfhi(sv.w));
            *(v4u*)(uop + (size_t)it * 32 * CWID + c0) = o; }
#pragma unroll
        for (int it = 0; it < 4; ++it) ureg[it] = *(const v4u*)(up + (size_t)it * 32 * CWID + gn * 128);
    }
    __syncthreads();
}

#ifdef DBG_DUMB_SP
__device__ __forceinline__ void dumb_stats(Frame& F, const bf16* V) {
    const int gw = F.c * NWAVES + F.wave, NGW = F.G * NWAVES;
    for (int m = gw; m < M; m += NGW) { float s = 0.f, q = 0.f;
        for (int c = F.lane; c < CWID; c += 64) { const float x = bflo((unsigned)V[(size_t)m * CWID + c]); s += x; q += x * x; }
        s = wave_sum(s); q = wave_sum(q); const float mu = s / CWID, var = fmaxf(q / CWID - mu * mu, 0.f);
        if (F.lane == 0) { F.stats[(size_t)m * 2] = mu; F.stats[(size_t)m * 2 + 1] = 1.0f / sqrtf(var + EPS); } }
}
__device__ __forceinline__ void dumb_spatial(Frame& F, int li, bf16* U, const bf16* V) {
    const size_t total = (size_t)M * CWID;
    for (size_t e = (size_t)F.c * 512 + F.tid; e < total; e += (size_t)F.G * 512) {
        const size_t row = e / CWID; const int c = (int)(e % CWID), g = c >> 7, t = (int)(row & 127); const size_t rb = row - t;
        float acc = 0.f;
        for (int s = 0; s <= t; ++s) { const float x = bflo((unsigned)V[(rb + s) * CWID + c]); const float mu = F.stats[(rb + s) * 2], rs = F.stats[(rb + s) * 2 + 1];
            const float vn = (x - mu) * rs * F.vgain[li * CWID + c] + F.vbias[li * CWID + c];
            acc += F.spatial_w[(((size_t)li * 16 + g) * 128 + t) * 128 + s] * vn; }
        const float sv = acc + F.spatial_b[(li * 16 + g) * 128 + t];
        const float u = bflo((unsigned)U[e]);
        U[e] = (bf16)(cvtpk(u * sv, 0.f) & 0xffffu);
    }
}
#endif

#ifdef DBG_DUMB_GEMM
template <int MODE> __device__ __forceinline__ void dumb_gemm(Frame& F, const bf16* A, int lda, const float* W, int ldw, int K, int N, bf16* O, int ldo) {
    const size_t total = (size_t)(M / 4) * N;
    for (size_t idx = (size_t)F.c * 512 + F.tid; idx < total; idx += (size_t)F.G * 512) {
        const int mb = (int)(idx / N), n = (int)(idx % N);
        float acc[4] = {0.f, 0.f, 0.f, 0.f}, acu[4] = {0.f, 0.f, 0.f, 0.f};
        for (int k = 0; k < K; ++k) { const float w = W[(size_t)k * ldw + n]; const float w2 = MODE == 2 ? W[(size_t)k * ldw + N + n] : 0.f;
#pragma unroll
            for (int i = 0; i < 4; ++i) { const float a = bflo((unsigned)A[(size_t)(4 * mb + i) * lda + k]); acc[i] += a * w; if (MODE == 2) acu[i] += a * w2; } }
#pragma unroll
        for (int i = 0; i < 4; ++i) { const size_t row = (size_t)(4 * mb + i); float v = acc[i]; size_t off;
            if (MODE == 0) off = row * ldo + n;
            else if (MODE == 1) off = row * ldo + (n < 960 ? n : (n < 964 ? 2496 + (n - 960) : n - 4));
            else if (MODE == 2) { v = v / (1.0f + expf(-v)) * acu[i]; off = row * ldo + n; }
            else { const float y = 0.7978845608028654f * (v + 0.044715f * v * v * v); v = 0.5f * v * (1.0f + tanhf(y)); off = (n < 2048 ? 0 : (size_t)M * 2048) + row * 2048 + (n & 2047); }
            O[off] = (bf16)(cvtpk(v, 0.f) & 0xffffu); }
    }
}
#endif
struct Args { const float* in[12]; float* out; unsigned char* ws; int ph_lo, ph_hi; };
__global__ void __launch_bounds__(NWAVES * 64, 2) fwd_kernel(Args args) {
    extern __shared__ __attribute__((aligned(16))) unsigned char lds[];
    Frame F;
    F.lds = (LAS unsigned char*)lds;
    F.MISC = (volatile LAS unsigned*)(F.lds + MISC_OFF);
    F.tid = threadIdx.x; F.lane = F.tid & 63; F.wave = __builtin_amdgcn_readfirstlane(F.tid >> 6);
    F.G = gridDim.x; F.c = blockIdx.x;
    unsigned char* ws = args.ws;
    F.ctl = (gu32*)(ws + WS_CTL);
    F.x = args.in[0]; F.gains = args.in[1]; F.w_in_even = args.in[2]; F.w_out_even = args.in[3]; F.w_in_odd = args.in[4]; F.spatial_w = args.in[5]; F.spatial_b = args.in[6];
    F.vgain = args.in[7]; F.vbias = args.in[8]; F.w_out_odd = args.in[9]; F.w_ffn_in = args.in[10]; F.w_ffn_out = args.in[11]; F.out = args.out;
    F.WinE = (bf16*)(ws + WS_WINE); F.WoutE = (bf16*)(ws + WS_WOUTE); F.WinO = (bf16*)(ws + WS_WINO); F.WoutO = (bf16*)(ws + WS_WOUTO); F.Wffi = (bf16*)(ws + WS_WFFI); F.Wffo = (bf16*)(ws + WS_WFFO); F.Wsp = (bf16*)(ws + WS_WSP);
    F.stats = (float*)(ws + WS_STATS); F.A = (bf16*)(ws + WS_A); F.R1 = (bf16*)(ws + WS_R1); F.Y = (bf16*)(ws + WS_Y); F.MIX = (bf16*)args.out; F.KT = (bf16*)(ws + WS_KT); F.RS = (float*)(ws + WS_CTL + 512 * 1024); F.WSUM = (float*)(ws + WS_CTL + 768 * 1024);
    for (int u = F.tid; u < (LDS_BYTES - LDSCTL_OFF) / 4; u += NWAVES * 64) ((LAS unsigned*)(F.lds + LDSCTL_OFF))[u] = 0u;
    __syncthreads();
#ifdef PROBE_SEL
    const unsigned long long probe_c0 = __builtin_amdgcn_s_memtime(), probe_w0 = __builtin_amdgcn_s_memrealtime();
#endif
    const bool dry = args.ph_lo >= 1000;
    const int lo = dry ? args.ph_lo - 1000 : args.ph_lo, hi = dry ? args.ph_hi - 1000 : args.ph_hi;
    XcdBarrier bar; bar.bar = (unsigned*)(F.ctl + CW_BAR); bar.x = 0; bar.st = nullptr;
    if (hi - lo > 1) bar = xcd_barrier_post((unsigned*)(F.ctl + CW_BAR), F.MISC + 8);
#define IN(k) (lo <= (k) && (k) < hi)
#define REFRESH() do { int l_; asm volatile("v_mbcnt_lo_u32_b32 %0, -1, 0\n\tv_mbcnt_hi_u32_b32 %0, -1, %0" : "=v"(l_)); F.lane = l_; F.tid = (F.wave << 6) | l_; } while (0)
#define SEAM_IDX(k) ((k) == 0 ? 14 : (((k) - 1) % 14))
#define SEAM(k) do { if (IN(k) && IN((k) + 1)) { PSTAMP(48 + SEAM_IDX(k)); xcd_barrier(bar); PSTAMP(16 + SEAM_IDX(k)); } } while (0)

    #ifndef NO_P0
#ifdef DBG_DUMB_SP
    if (lo >= 100) { dumb_stats(F, F.R1 + (size_t)M * CWID); return; }
#endif
    if (IN(0)) { REFRESH(); p0_prologue(F); SEAM(0); }
#endif
    for (int L = 0; L < DEPTH; ++L) {
        const int pb = 1 + 7 * L, li = L >> 1;
        const float* gl = F.gains + (size_t)L * 4 * DM;
        if ((L & 1) == 0) {
            if (IN(pb + 0)) {
                pg8::Gemm g{F.A, F.WinE + (size_t)li * PP * DM, M, PP, DM}; pg8::StaticOrder S; S.init(M, PP, F.G, F.c);
                pg8::EpiBf16R E{F.R1, PP, F.RS, F.KT};
#if defined(DBG_DUMB_GEMM) && (DBG_DUMB_GEMM & (1 << 1))
                dumb_gemm<1>(F, F.A, DM, F.w_in_even + (size_t)li * DM * EVEN_IN, EVEN_IN, DM, EVEN_IN, F.R1, PP);
#else
                pg8::gemm_phase<pg8::EpiBf16R, pg8::StaticOrder, PG8_ALIGN, PG8_SP2>(F.lds + RING_OFF, g, S, E, F.wave);
#endif
                SEAM(pb + 0);
            }
            if (IN(pb + 1)) {
                REFRESH();
                if (F.G == 256) {
                    const int b = (F.c & 7) >> 1, j = ((F.c & 1) << 5) | (F.c >> 3);
                    #ifndef NO_DSA
                    { DsaPre pre; PSTAMP(14); dsa_prefetch(F, F.R1, b, j, pre);
#pragma unroll 1
                      for (int k = 0; k < 16; ++k) { const int kn = k + 1; const int kq = kn < 16 ? kn : 15; dsa_unit(F, F.R1, F.MIX, b, (k & 1) ? (64 * k + 63 - j) : (64 * k + j), pre, kn < 16, (kq & 1) ? (64 * kq + 63 - j) : (64 * kq + j)); } }
#ifdef DUP_DSA
                    for (int k = 0; k < 16; ++k) dsa_unit(F, F.R1, F.MIX, b, (k & 1) ? (64 * k + 63 - j) : (64 * k + j));
#endif
#endif
                    #ifndef NO_SB
                    REFRESH();
#ifdef SB_NAIVE
                    for (int task = F.c * NWAVES + F.wave; task < 4096; task += 256 * NWAVES) sb_task(F.R1, F.MIX, task, F.lane);
#else
#ifdef SB_STATIC
                    for (int u = F.c * NWAVES + F.wave; u < 8192; u += 256 * NWAVES) sb_unit(F, F.R1, F.MIX, u);
#else
                    {
                        unsigned* qctr = (unsigned*)(F.ctl + SBQ_OFF + (li * 8 + (F.c & 7)) * 32); const int hq = F.c & 7;
                        unsigned qv = 0u; if (F.lane == 0) qv = __hip_atomic_fetch_add(qctr, 1u, __ATOMIC_RELAXED, __HIP_MEMORY_SCOPE_AGENT);
                        int q = __builtin_amdgcn_readfirstlane((int)qv);
                        while (q < 1024) { unsigned qn = 0u; if (F.lane == 0) qn = __hip_atomic_fetch_add(qctr, 1u, __ATOMIC_RELAXED, __HIP_MEMORY_SCOPE_AGENT);
                            const int qb = 255 - (q >> 2), bb = q & 3; sb_unit(F, F.R1, F.MIX, 2048 * bb + 8 * (8 * (qb >> 3) + hq) + (qb & 7));
                            q = __builtin_amdgcn_readfirstlane((int)qn); } }
#endif
#ifdef DUP_SB
                    for (int u = F.c * NWAVES + F.wave; u < 8192; u += 256 * NWAVES) sb_unit(F, F.R1, F.MIX, u);
#endif
#endif
#endif
                }
                SEAM(pb + 1);
            }
            if (IN(pb + 2)) {
                pg8::Gemm g{F.MIX, F.WoutE + (size_t)li * DM * DM, M, DM, DM}; pg8::StaticOrder S; S.init(M, DM, F.G, F.c);
                pg8::EpiBf16<0> E{F.Y, DM, nullptr, 0, 0, 1.f};
#if defined(DBG_DUMB_GEMM) && (DBG_DUMB_GEMM & (1 << 2))
                dumb_gemm<0>(F, F.A, DM, F.w_out_even + (size_t)li * DM * DM, DM, DM, DM, F.Y, DM);
#else
                pg8::gemm_phase<pg8::EpiBf16<0>, pg8::StaticOrder, PG8_ALIGN, PG8_SP2>(F.lds + RING_OFF, g, S, E, F.wave);
#endif
                SEAM(pb + 2);
            }
        } else {
            bf16* U = F.R1; bf16* V = F.R1 + (size_t)M * CWID;
            if (IN(pb + 0)) {
                pg8::Gemm g{F.A, F.WinO + (size_t)li * 4096 * DM, M, 4096, DM}; pg8::StaticOrder S; S.init(M, 4096, F.G, F.c);
                pg8::EpiGeluStats E{U, V, F.stats, F.RS};
#if defined(DBG_DUMB_GEMM) && (DBG_DUMB_GEMM & (1 << 3))
                dumb_gemm<3>(F, F.A, DM, F.w_in_odd + (size_t)li * DM * 4096, 4096, DM, 4096, F.R1, 0);
#else
                pg8::gemm_phase<pg8::EpiGeluStats, pg8::StaticOrder, PG8_ALIGN, PG8_SP2>(F.lds + RING_OFF, g, S, E, F.wave);
#endif
                SEAM(pb + 0);
            }
            if (IN(pb + 1)) {
                REFRESH();
#ifndef NO_SP
#ifdef DBG_DUMB_SP
                dumb_spatial(F, li, U, V);
#else
                for (int ch = F.c; ch < 256; ch += F.G) spatial_chunk(F, li, ch, U, V, dry ? (bf16*)F.out : U);
#endif
#endif
                SEAM(pb + 1);
            }
            if (IN(pb + 2)) {
                pg8::Gemm g{U, F.WoutO + (size_t)li * DM * CWID, M, DM, CWID}; pg8::StaticOrder S; S.init(M, DM, F.G, F.c);
                pg8::EpiBf16<0> E{F.Y, DM, nullptr, 0, 0, 1.f};
#if defined(DBG_DUMB_GEMM) && (DBG_DUMB_GEMM & (1 << 4))
                dumb_gemm<0>(F, U, CWID, F.w_out_odd + (size_t)li * CWID * DM, DM, CWID, DM, F.Y, DM);
#else
                pg8::gemm_phase<pg8::EpiBf16<0>, pg8::StaticOrder, PG8_ALIGN, PG8_SP2>(F.lds + RING_OFF, g, S, E, F.wave);
#endif
                SEAM(pb + 2);
            }
        }
#ifndef NO_THIN
        if (IN(pb + 3)) { REFRESH(); if (L == 0) thin_phase<true, false>(F, gl + DM, dry); else thin_phase<false, false>(F, gl + DM, dry); SEAM(pb + 3); }
#endif
        if (IN(pb + 4)) {
            pg8::Gemm g{F.A, F.Wffi + (size_t)L * 2 * DFF * DM, M, 2 * DFF, DM}; pg8::StaticOrder S; S.init(M, 2 * DFF, F.G, F.c);
            pg8::EpiSwiglu E{F.R1, DFF, F.RS};
#if defined(DBG_DUMB_GEMM) && (DBG_DUMB_GEMM & (1 << 5))
                dumb_gemm<2>(F, F.A, DM, F.w_ffn_in + (size_t)L * DM * 2 * DFF, 2 * DFF, DM, DFF, F.R1, DFF);
#else
#ifdef FFI_CHUNKS
            {
                const bf16* Bt = F.Wffi + (size_t)L * 2 * DFF * DM;
                { pg8::Gemm g1{F.A, Bt, M, 8 * 256, DM}; pg8::StaticOrder S1; S1.init(M, 8 * 256, F.G, F.c); pg8::EpiSwiglu E1{F.R1, DFF, F.RS};
                  pg8::gemm_phase<pg8::EpiSwiglu, pg8::StaticOrder, PG8_ALIGN, PG8_SP2>(F.lds + RING_OFF, g1, S1, E1, F.wave); }
                { pg8::Gemm g2{F.A, Bt + (size_t)8 * 256 * DM, M, 8 * 256, DM}; pg8::StaticOrder S2; S2.init(M, 8 * 256, F.G, F.c); pg8::EpiSwiglu E2{F.R1 + 8 * 128, DFF, F.RS};
                  pg8::gemm_phase<pg8::EpiSwiglu, pg8::StaticOrder, PG8_ALIGN, PG8_SP2>(F.lds + RING_OFF, g2, S2, E2, F.wave); }
                { pg8::Gemm g3{F.A, Bt + (size_t)16 * 256 * DM, M, 6 * 256, DM}; pg8::StaticOrder S3; S3.init(M, 6 * 256, F.G, F.c); pg8::EpiSwiglu E3{F.R1 + 16 * 128, DFF, F.RS};
                  pg8::gemm_phase<pg8::EpiSwiglu, pg8::StaticOrder, PG8_ALIGN, PG8_SP2>(F.lds + RING_OFF, g3, S3, E3, F.wave); }
            }
#else
            pg8::gemm_phase<pg8::EpiSwiglu, pg8::StaticOrder, PG8_ALIGN, PG8_SP2>(F.lds + RING_OFF, g, S, E, F.wave);
#endif
#endif
            SEAM(pb + 4);
        }
        if (IN(pb + 5)) {
            pg8::Gemm g{F.R1, F.Wffo + (size_t)L * DM * DFF, M, DM, DFF}; pg8::StaticOrder S; S.init(M, DM, F.G, F.c);
            pg8::EpiBf16<0> E{F.Y, DM, nullptr, 0, 0, 1.f};
#if defined(DBG_DUMB_GEMM) && (DBG_DUMB_GEMM & (1 << 6))
                dumb_gemm<0>(F, F.R1, DFF, F.w_ffn_out + (size_t)L * DFF * DM, DM, DFF, DM, F.Y, DM);
#else
            pg8::gemm_phase<pg8::EpiBf16<0>, pg8::StaticOrder, PG8_ALIGN, PG8_SP2>(F.lds + RING_OFF, g, S, E, F.wave);
#endif
            SEAM(pb + 5);
        }
#ifndef NO_THIN
        if (IN(pb + 6)) { REFRESH(); if (L + 1 < DEPTH) { thin_phase<false, false>(F, gl + 3 * DM, dry); SEAM(pb + 6); } else thin_phase<false, true>(F, gl + 3 * DM, dry); }
#endif
    }
#ifdef PROBE_SEL
#ifndef PROBE_WG
#define PROBE_WG 0
#endif
    if (blockIdx.x == PROBE_WG && F.wave == 0) {
        LAS unsigned* pw = (LAS unsigned*)(F.lds + 131072 + 640);
        const unsigned long long c_tot = __builtin_amdgcn_s_memtime() - probe_c0, w_tot = __builtin_amdgcn_s_memrealtime() - probe_w0;
        unsigned long long cyc = 0;
        if (PROBE_SEL == 1) cyc = pw[0] - pw[1]; else if (PROBE_SEL == 2) cyc = pw[1]; else if (PROBE_SEL == 3) cyc = pw[3]; else if (PROBE_SEL >= 4 && PROBE_SEL < 96) cyc = pw[PROBE_SEL];
        else if (PROBE_SEL == 100) { for (int i = 0; i < 15; ++i) cyc += pw[16 + i]; }
        else if (PROBE_SEL == 101) { cyc = (unsigned long long)pw[16 + 0] + pw[16 + 2] + pw[16 + 4] + pw[16 + 5] + pw[16 + 7] + pw[16 + 9] + pw[16 + 11] + pw[16 + 12]; }
        else if (PROBE_SEL == 102) cyc = pw[16 + 1]; else if (PROBE_SEL == 103) cyc = pw[16 + 8];
        else if (PROBE_SEL == 104) { cyc = (unsigned long long)pw[16 + 3] + pw[16 + 6] + pw[16 + 10] + pw[16 + 13]; }
        else if (PROBE_SEL == 105) cyc = pw[16 + 14];
        else if (PROBE_SEL == 110) { for (int i = 0; i < 15; ++i) cyc += pw[48 + i]; }
        unsigned long long spin_ticks;
        if (PROBE_SEL == 0) spin_ticks = (c_tot * 100ull / w_tot) * 400ull;
        else spin_ticks = cyc * w_tot / c_tot * 10ull;
        const unsigned long long w0 = __builtin_amdgcn_s_memrealtime();
        while (__builtin_amdgcn_s_memrealtime() - w0 < spin_ticks) __builtin_amdgcn_s_sleep(10);
    }
#endif
#undef IN
#undef SEAM
}

#ifndef MK_ONE_LAUNCH
#define MK_ONE_LAUNCH 1
#endif
extern "C" void kernel_launch(void* const* d_in, const int* in_sizes, int n_in, void* d_out, int out_size, void* d_ws, size_t ws_size, hipStream_t stream) {
    static int ready = 0;
    if (ready == 0) {
        if (n_in != 12 || in_sizes[0] != M * DM || out_size != M * DM || ws_size < WS_END) { fprintf(stderr, "kernel_launch: unexpected shapes (n_in %d, in0 %d, out %d, ws %zu)\n", n_in, n_in > 0 ? in_sizes[0] : -1, out_size, ws_size); ready = -1; return; }
        if (hipFuncSetAttribute((const void*)fwd_kernel, hipFuncAttributeMaxDynamicSharedMemorySize, LDS_BYTES) != hipSuccess) { fprintf(stderr, "kernel_launch: hipFuncSetAttribute failed\n"); ready = -1; return; }
        int per_cu = 0;
        if (hipOccupancyMaxActiveBlocksPerMultiprocessor(&per_cu, (const void*)fwd_kernel, NWAVES * 64, LDS_BYTES) != hipSuccess || per_cu < 1) fprintf(stderr, "kernel_launch: note: occupancy query reports %d blocks per CU\n", per_cu);
        (void)hipGetLastError();
        ready = 1;
    }
    if (ready < 0) return;
    if (hipMemsetAsync((char*)d_ws + WS_CTL, 0, CTL_ZERO_BYTES, stream) != hipSuccess) { fprintf(stderr, "kernel_launch: memset failed\n"); return; }
    Args a{};
    for (int i = 0; i < 12; ++i) a.in[i] = (const float*)d_in[i];
    a.out = (float*)d_out; a.ws = (unsigned char*)d_ws;
#if MK_ONE_LAUNCH
    a.ph_lo = 0; a.ph_hi = N_PHASES;
    hipLaunchKernelGGL(fwd_kernel, dim3(256), dim3(NWAVES * 64), LDS_BYTES, stream, a);
#else
    for (int k = 0; k < N_PHASES; ++k) {
#ifdef DBG_DUMB_SP
        if (k == 9 || k == 23) { a.ph_lo = 100; a.ph_hi = 101; hipLaunchKernelGGL(fwd_kernel, dim3(256), dim3(NWAVES * 64), LDS_BYTES, stream, a); }
#endif
#ifdef DUP_MASK
        { const int j = k == 0 ? 7 : (k - 1) % 7, L = k == 0 ? 0 : (k - 1) / 7; const bool idem = (j == 0 || j == 2 || j == 4 || j == 5 || (j == 1 && (L & 1) == 0) || j == 7);
          if ((DUP_MASK >> j) & 1) { if ((DUP_MASK >> 8) & 1) { if (j == 1 && (L & 1) == 0) goto nodup; } else if (j == 1 && (L & 1) == 1) goto nodup;
              a.ph_lo = idem ? k : k + 1000; a.ph_hi = a.ph_lo + 1; hipLaunchKernelGGL(fwd_kernel, dim3(256), dim3(NWAVES * 64), LDS_BYTES, stream, a); }
          nodup:; }
#endif
        a.ph_lo = k; a.ph_hi = k + 1; hipLaunchKernelGGL(fwd_kernel, dim3(256), dim3(NWAVES * 64), LDS_BYTES, stream, a); }
#endif
}
```

```cpp
#include <hip/hip_runtime.h>
#include <cstdio>
#include <cstdint>
#include <cmath>
namespace pg8 {
#define PG8_LAS __attribute__((address_space(3)))
typedef unsigned short bf16_t;
typedef short bf16x8 __attribute__((ext_vector_type(8)));
typedef float f32x4 __attribute__((ext_vector_type(4)));
typedef unsigned u32x4 __attribute__((ext_vector_type(4)));
constexpr int BM = 256, BK = 64, HALF = 128, HTB = HALF * BK * 2  , STAGE_BYTES = 8 * HTB, NXCD = 8, WGM = 8;

__host__ __device__ __forceinline__ int lds_byte(int r, int c) { const int st = (r >> 4) * 2 + (c >> 5), rr = r & 15, cc = c & 31, ob = rr * 64 + cc * 2; return st * 1024 + (ob ^ (((ob >> 9) & 1) << 5)); }
__host__ __device__ __forceinline__ void stage_rc(int b, int& R, int& C) { const int st = b / 1024, sb = b % 1024, swz = sb ^ (((sb >> 9) & 1) << 5); R = (st >> 1) * 16 + swz / 64; C = (st & 1) * 32 + (swz % 64) / 2; }
__host__ __device__ __forceinline__ int perm32(int rho) { const int n = rho >> 4, i = rho & 15; return 8 * (i >> 2) + 4 * n + (i & 3); }

struct Unit { int pm, pn; };
struct Gemm { const bf16_t* A; const bf16_t* Bt; int M, N, K; int lda; int kpairA; };

struct StaticOrder {
    int nM, nN, nwg, G, c;
    __host__ __device__ void init(int M, int N, int G_, int c_) { nM = M / BM; nN = N / BM; nwg = nM * nN; G = G_; c = c_; }
    __host__ __device__ bool next(int i, Unit& u) const {
        const long L = (long)i * G + c; if (L >= nwg) return false;
        int wgid = (int)L; { const int q = nwg / NXCD, r = nwg % NXCD, xcd = wgid % NXCD, off = wgid / NXCD; wgid = (xcd < r ? xcd * (q + 1) : r * (q + 1) + (xcd - r) * q) + off; }
        const int nig = WGM * nN, gid = wgid / nig, fm = gid * WGM, gsz = (nM - fm) < WGM ? (nM - fm) : WGM;
        u.pm = fm + ((wgid % nig) % gsz); u.pn = (wgid % nig) / gsz; return true;
    }
    __device__ __forceinline__ void a_ready(const Unit&) const {}
    __device__ __forceinline__ void done(const Unit&) const {}
};

__device__ __forceinline__ unsigned cvt_pk_bf16(float lo, float hi) { unsigned r; asm volatile("v_cvt_pk_bf16_f32 %0, %1, %2" : "=v"(r) : "v"(lo), "v"(hi)); return r; }
typedef float f32x2 __attribute__((ext_vector_type(2)));
__device__ __forceinline__ f32x2 gelu_pk(f32x2 v) {
    const f32x2 av = __builtin_elementwise_abs(v), d = av * 0.2316418882f + 1.0f;
    f32x2 t; t.x = __builtin_amdgcn_rcpf(d.x); t.y = __builtin_amdgcn_rcpf(d.y);
    f32x2 q = t * 0.5307027145f + (-0.7265760135f); q = q * t + 0.7107068705f; q = q * t + (-0.142248368f); q = q * t + 0.127414796f; q = q * t;
    const f32x2 s = (v * v) * (-0.72134752044f);
    f32x2 e; e.x = __builtin_amdgcn_exp2f(s.x); e.y = __builtin_amdgcn_exp2f(s.y);
    const f32x2 m = v * (q * e), r = v - m;
    f32x2 o; o.x = v.x < 0.f ? m.x : r.x; o.y = v.y < 0.f ? m.y : r.y; return o;
}

template <int ACT  > struct EpiBf16 {
    static constexpr bool PERM = true, AFTER_DRAIN = false, PROBE = false; static_assert(ACT == 0 || ACT == 1, "EpiBf16: ACT is 0 (none) or 1 (gelu_pk)");
    bf16_t* O; int ldc; const float* bias; int split_cols; size_t split_stride; float scale0;
    static constexpr bool HAS_RS = false; const float* rs_rows(const Unit&) const { return nullptr; }
    __device__ __forceinline__ void load_rs(const PG8_LAS float*, int, int, float (&)[8]) const {}
    __device__ __forceinline__ void operator()(const f32x4 (&acc)[2][2][4][2], const Unit& u, int wr, int wc, int fr, int fq, const float (&)[8]) const {
        const int row0 = u.pm * BM + wr * 64 + fr; int colt = u.pn * BM; bf16_t* base = O;
        float sc = 1.f; if (split_cols) { const int t = colt / split_cols; base += (size_t)t * split_stride; colt -= t * split_cols; if (t == 0) sc = scale0; }
        const int col0 = colt + wc * 32 + 8 * fq, bcol0 = u.pn * BM + wc * 32 + 8 * fq;
        f32x4 bv[2][2];
#pragma unroll
        for (int bj = 0; bj < 2; ++bj)
#pragma unroll
            for (int n = 0; n < 2; ++n) bv[bj][n] = bias ? *(const f32x4*)(bias + bcol0 + bj * HALF + 4 * n) : (f32x4){0.f, 0.f, 0.f, 0.f};
#pragma unroll
        for (int ai = 0; ai < 2; ++ai)
#pragma unroll
            for (int m = 0; m < 4; ++m) { bf16_t* rowp = base + (size_t)(row0 + ai * HALF + m * 16) * ldc + col0;
#pragma unroll
                for (int bj = 0; bj < 2; ++bj) { f32x4 v0 = acc[ai][bj][m][0] + bv[bj][0], v1 = acc[ai][bj][m][1] + bv[bj][1];
                    if (ACT == 1) { f32x2 a = gelu_pk((f32x2){v0[0], v0[1]}), b = gelu_pk((f32x2){v0[2], v0[3]}), c = gelu_pk((f32x2){v1[0], v1[1]}), d = gelu_pk((f32x2){v1[2], v1[3]});
                        v0 = (f32x4){a.x, a.y, b.x, b.y}; v1 = (f32x4){c.x, c.y, d.x, d.y}; }
                    v0 = v0 * sc; v1 = v1 * sc; u32x4 w; w.x = cvt_pk_bf16(v0[0], v0[1]); w.y = cvt_pk_bf16(v0[2], v0[3]); w.z = cvt_pk_bf16(v1[0], v1[1]); w.w = cvt_pk_bf16(v1[2], v1[3]);
                    *(u32x4*)(rowp + bj * HALF) = w; } }
    }
};
__device__ __forceinline__ float sigmoid_f(float x) { return __builtin_amdgcn_rcpf(1.0f + __builtin_amdgcn_exp2f(-1.4426950408889634f * x)); }
__device__ __forceinline__ float gelu_tanh_f(float x) { const float t = x * __builtin_fmaf(-0.10294324f, x * x, -2.3022082f); return x * __builtin_amdgcn_rcpf(1.0f + __builtin_amdgcn_exp2f(t)); }
struct EpiSwiglu {
    static constexpr bool PERM = true, AFTER_DRAIN = false, PROBE = true;
    bf16_t* O; int ldc; const float* rs;
    static constexpr bool HAS_RS = true;
    __device__ __forceinline__ const float* rs_rows(const Unit& u) const { return rs + u.pm * BM; }
    __device__ __forceinline__ void load_rs(const PG8_LAS float* tbl, int wr, int fr, float (&rsv)[8]) const {
#pragma unroll
        for (int ai = 0; ai < 2; ++ai)
#pragma unroll
            for (int m = 0; m < 4; ++m) rsv[ai * 4 + m] = tbl[wr * 64 + fr + ai * HALF + m * 16]; }
    __device__ __forceinline__ void operator()(const f32x4 (&acc)[2][2][4][2], const Unit& u, int wr, int wc, int fr, int fq, const float (&rsv)[8]) const {
        const int rl0 = wr * 64 + fr, cl0 = wc * 32 + 8 * fq, tpc = ldc >> 7;
#pragma unroll
        for (int ai = 0; ai < 2; ++ai)
#pragma unroll
            for (int m = 0; m < 4; ++m) { bf16_t* rowp = O + ((size_t)((u.pm * 2 + ai) * tpc + u.pn) * 128 + rl0 + m * 16) * 128 + cl0; const float r = rsv[ai * 4 + m];
                const float c1 = -1.4426950408889634f * r, r2 = r * r; unsigned ow[4];
#pragma unroll
                for (int n = 0; n < 2; ++n)
#pragma unroll
                    for (int h = 0; h < 2; ++h) { const f32x2 g = {acc[ai][0][m][n][2 * h], acc[ai][0][m][n][2 * h + 1]}, up = {acc[ai][1][m][n][2 * h], acc[ai][1][m][n][2 * h + 1]};
                        f32x2 t = g * c1; t.x = __builtin_amdgcn_exp2f(t.x); t.y = __builtin_amdgcn_exp2f(t.y);
                        const f32x2 d = t + 1.0f; f32x2 rc; rc.x = __builtin_amdgcn_rcpf(d.x); rc.y = __builtin_amdgcn_rcpf(d.y);
                        const f32x2 p = ((g * up) * r2) * rc;
                        ow[2 * n + h] = cvt_pk_bf16(p.x, p.y); }
                u32x4 w; w.x = ow[0]; w.y = ow[1]; w.z = ow[2]; w.w = ow[3];
                *(u32x4*)rowp = w; }
    }
};
struct EpiGeluStats {
    static constexpr bool PERM = true, AFTER_DRAIN = false, PROBE = false;
    bf16_t* U; bf16_t* V; float* stats; const float* rs;
    static constexpr bool HAS_RS = true;
    __device__ __forceinline__ const float* rs_rows(const Unit& u) const { return rs + u.pm * BM; }
    __device__ __forceinline__ void load_rs(const PG8_LAS float* tbl, int wr, int fr, float (&rsv)[8]) const {
#pragma unroll
        for (int ai = 0; ai < 2; ++ai)
#pragma unroll
            for (int m = 0; m < 4; ++m) rsv[ai * 4 + m] = tbl[wr * 64 + fr + ai * HALF + m * 16]; }
    __device__ __forceinline__ void operator()(const f32x4 (&acc)[2][2][4][2], const Unit& u, int wr, int wc, int fr, int fq, const float (&rsv)[8]) const {
        const bool isv = u.pn >= 8; bf16_t* base = isv ? V : U;
        const int row0 = u.pm * BM + wr * 64 + fr, rl0 = wr * 64 + fr, cl0 = wc * 32 + 8 * fq;
#pragma unroll
        for (int ai = 0; ai < 2; ++ai)
#pragma unroll
            for (int m = 0; m < 4; ++m) { const int row = row0 + ai * HALF + m * 16; bf16_t* rowp = base + ((size_t)((u.pm * 2 + ai) * 16 + (u.pn & 7) * 2) * 128 + rl0 + m * 16) * 128 + cl0; f32x2 s2 = {0.f, 0.f}, q2 = {0.f, 0.f}; const float r = rsv[ai * 4 + m];
#pragma unroll
                for (int bj = 0; bj < 2; ++bj) { unsigned ow[4];
#pragma unroll
                    for (int n = 0; n < 2; ++n)
#pragma unroll
                        for (int h = 0; h < 2; ++h) { const f32x2 a = {acc[ai][bj][m][n][2 * h], acc[ai][bj][m][n][2 * h + 1]};
                            const f32x2 x = a * r, x2 = x * x;
                            f32x2 t = x * (x2 * (-0.10294324f) + (-2.3022082f)); t.x = __builtin_amdgcn_exp2f(t.x); t.y = __builtin_amdgcn_exp2f(t.y);
                            const f32x2 d = t + 1.0f; f32x2 rc; rc.x = __builtin_amdgcn_rcpf(d.x); rc.y = __builtin_amdgcn_rcpf(d.y);
                            const f32x2 v = x * rc;
                            s2 += v; q2 += v * v;
                            ow[2 * n + h] = cvt_pk_bf16(v.x, v.y); }
                    u32x4 w; w.x = ow[0]; w.y = ow[1]; w.z = ow[2]; w.w = ow[3];
                    *(u32x4*)(rowp + bj * (128 * 128)) = w; }
                if (isv) { float s = s2.x + s2.y, q = q2.x + q2.y; s += __shfl_xor(s, 16); s += __shfl_xor(s, 32); q += __shfl_xor(q, 16); q += __shfl_xor(q, 32);
                    if (fq == 0) { f32x2 sq; sq.x = s; sq.y = q; *(f32x2*)(stats + ((size_t)row * 32 + (u.pn - 8) * 4 + wc) * 2) = sq; } } }
    }
};
struct EpiBf16R {
    static constexpr bool PERM = true, AFTER_DRAIN = false, PROBE = false;
    bf16_t* O; int ldc; const float* rs; bf16_t* KT;
    static constexpr bool HAS_RS = true;
    __device__ __forceinline__ const float* rs_rows(const Unit& u) const { return rs + u.pm * BM; }
    __device__ __forceinline__ void load_rs(const PG8_LAS float* tbl, int wr, int fr, float (&rsv)[8]) const {
#pragma unroll
        for (int ai = 0; ai < 2; ++ai)
#pragma unroll
            for (int m = 0; m < 4; ++m) rsv[ai * 4 + m] = tbl[wr * 64 + fr + ai * HALF + m * 16]; }
    __device__ __forceinline__ void operator()(const f32x4 (&acc)[2][2][4][2], const Unit& u, int wr, int wc, int fr, int fq, const float (&rsv)[8]) const {
        const int row0 = u.pm * BM + wr * 64 + fr, col0 = u.pn * BM + wc * 32 + 8 * fq;
        const bool kt = (u.pn == 3) && (wc < 2);
#pragma unroll
        for (int ai = 0; ai < 2; ++ai)
#pragma unroll
            for (int m = 0; m < 4; ++m) { const int row = row0 + ai * HALF + m * 16; bf16_t* rowp = O + (size_t)row * ldc + col0; const float r = rsv[ai * 4 + m];
#pragma unroll
                for (int bj = 0; bj < 2; ++bj) { const f32x4 v0 = acc[ai][bj][m][0] * r, v1 = acc[ai][bj][m][1] * r;
                    u32x4 w; w.x = cvt_pk_bf16(v0[0], v0[1]); w.y = cvt_pk_bf16(v0[2], v0[3]); w.z = cvt_pk_bf16(v1[0], v1[1]); w.w = cvt_pk_bf16(v1[2], v1[3]);
                    *(u32x4*)(rowp + bj * HALF) = w;
                    if (kt && bj == 1) { const int dimc = 32 * wc + 8 * fq, bb = row >> 13, tt = row & 8191;
                        *(u32x4*)(KT + ((((size_t)(bb * 256 + (tt >> 5)) * 4 + (dimc >> 4)) * 2 + ((dimc >> 3) & 1)) * 32 + (tt & 31)) * 8) = w; } } }
    }
};
template <class Epi, class Sched, bool ALIGN_EPI = false, bool SP2 = false>
__device__ __forceinline__ void gemm_phase(PG8_LAS unsigned char* lds, const Gemm g, const Sched& S, const Epi& E, const int wave_id) {
    int lane_; asm volatile("v_mbcnt_lo_u32_b32 %0, -1, 0\n\tv_mbcnt_hi_u32_b32 %0, -1, %0" : "=v"(lane_)); int tid_ = (wave_id << 6) | lane_;
    const int tid = tid_, wid = __builtin_amdgcn_readfirstlane(tid >> 6), lane = tid & 63, wr = wid >> 2, wc = wid & 3, fr = lane & 15, fq = lane >> 4;
    const int K = g.K, nt = K / BK;
    unsigned voffA[2], voffB[2];
#pragma unroll
    for (int i = 0; i < 2; ++i) { int R, C; stage_rc(tid * 16 + i * 8192, R, C); const int Rb = Epi::PERM ? ((R & ~31) + perm32(R & 31)) : R;
        voffA[i] = (unsigned)(R * (g.lda ? g.lda : K) + C) * 2u; voffB[i] = (unsigned)(Rb * K + C) * 2u; }
    const size_t kstep = (size_t)(BK * 2);
    const size_t kpairA = g.kpairA ? (size_t)g.kpairA : 2 * kstep;
    const size_t hstep = (size_t)HALF * K * 2;
    const size_t tstep = 2 * hstep;
    const unsigned ldsw = (unsigned)wid * 1024u;
    const int aoff = lds_byte(wr * 64 + fr, fq * 8), boff = lds_byte(wc * 32 + fr, fq * 8);
#define PG8_SA(b, h) (((b) * 2 + (h)) * HTB)
#define PG8_SB(b, h) ((4 + (b) * 2 + (h)) * HTB)
#define PG8_STAGE(bufoff, gbase, voff) do { _Pragma("unroll") for (int _i = 0; _i < 2; ++_i) \
        __builtin_amdgcn_global_load_lds((const unsigned*)((const char*)(gbase) + (voff)[_i]), (PG8_LAS unsigned*)(lds + (bufoff) + ldsw + _i * 8192), 16, 0, 0); } while (0)
#define PG8_LDA(dst, b, h) do { _Pragma("unroll") for (int m = 0; m < 4; ++m) _Pragma("unroll") for (int k = 0; k < 2; ++k) dst[m][k] = *(const PG8_LAS bf16x8*)(lds + PG8_SA(b, h) + aoff + m * 2048 + k * 1024); } while (0)
#define PG8_LDB(dst, b, h) do { _Pragma("unroll") for (int n = 0; n < 2; ++n) _Pragma("unroll") for (int k = 0; k < 2; ++k) dst[n][k] = *(const PG8_LAS bf16x8*)(lds + PG8_SB(b, h) + boff + n * 2048 + k * 1024); } while (0)
#define PG8_MMA(ai, bj, At, Bt) do { __builtin_amdgcn_s_setprio(1); _Pragma("unroll") for (int m = 0; m < 4; ++m) _Pragma("unroll") for (int n = 0; n < 2; ++n) _Pragma("unroll") for (int k = 0; k < 2; ++k) \
        acc[ai][bj][m][n] = __builtin_amdgcn_mfma_f32_16x16x32_bf16(Bt[n][k], At[m][k], acc[ai][bj][m][n], 0, 0, 0); __builtin_amdgcn_s_setprio(0); } while (0)
#define PG8_WAIT_V(n) asm volatile("s_waitcnt vmcnt(" #n ")" ::: "memory")
#define PG8_WAIT_L(n) asm volatile("s_waitcnt lgkmcnt(" #n ")" ::: "memory")
#define PG8_BAR __builtin_amdgcn_s_barrier()
#define PG8_SCHED __builtin_amdgcn_sched_barrier(0)
    Unit cur, nxt; int ui = 0;
    if (!S.next(0, cur)) return;
    f32x4 acc[2][2][4][2];
#pragma unroll
    for (int a = 0; a < 2; ++a)
#pragma unroll
        for (int b = 0; b < 2; ++b)
#pragma unroll
            for (int m = 0; m < 4; ++m)
#pragma unroll
                for (int n = 0; n < 2; ++n) acc[a][b][m][n] = (f32x4){0.f, 0.f, 0.f, 0.f};
    bf16x8 At[4][2], B0[2][2], B1[2][2];
    const char* cA = (const char*)g.A + (size_t)cur.pm * tstep; const char* cB = (const char*)g.Bt + (size_t)cur.pn * tstep;
    S.a_ready(cur);
    constexpr int RSTAB = 132096;
    int rslot = 0;
#define PG8_STAGE_RS(u, slot) do { if constexpr (Epi::HAS_RS) __builtin_amdgcn_global_load_lds((const unsigned*)(E.rs_rows(u) + (wid & 3) * 64 + lane), (PG8_LAS unsigned*)(lds + RSTAB + (slot) * 1024 + (wid & 3) * 256), 4, 0, 0); } while (0)
    PG8_STAGE_RS(cur, 0);
    if constexpr (SP2) {
        PG8_STAGE(PG8_SB(0, 0), cB, voffB); PG8_STAGE(PG8_SB(0, 1), cB + hstep, voffB); PG8_STAGE(PG8_SA(0, 0), cA, voffA); PG8_STAGE(PG8_SA(0, 1), cA + hstep, voffA);
        if (wr == 1) PG8_BAR;
        PG8_WAIT_V(2); PG8_BAR;
        PG8_STAGE(PG8_SB(1, 0), cB + kstep, voffB); PG8_STAGE(PG8_SA(1, 0), cA + kstep, voffA); PG8_STAGE(PG8_SB(1, 1), cB + hstep + kstep, voffB);
        PG8_WAIT_V(6); PG8_BAR;
    } else {
        PG8_STAGE(PG8_SB(0, 0), cB, voffB); PG8_STAGE(PG8_SA(0, 0), cA, voffA); PG8_STAGE(PG8_SB(0, 1), cB + hstep, voffB); PG8_STAGE(PG8_SA(0, 1), cA + hstep, voffA);
        if (wr == 1) PG8_BAR;
        PG8_WAIT_V(4); PG8_BAR;
        PG8_STAGE(PG8_SB(1, 0), cB + kstep, voffB); PG8_STAGE(PG8_SA(1, 0), cA + kstep, voffA); PG8_STAGE(PG8_SB(1, 1), cB + hstep + kstep, voffB);
        PG8_WAIT_V(6); PG8_BAR;
    }
#ifdef KT_PROBE
    unsigned long long pc0 = 0, pc4 = 0, pce = 0; unsigned pall = 0, pss = 0, pn = 0, pepi = 0;
#endif
    for (;;) {
        const bool has_next = S.next(ui + 1, nxt);
        const int rslot_n = rslot == 2 ? 0 : rslot + 1;
        if (has_next) PG8_STAGE_RS(nxt, rslot_n);
        const char* nA = has_next ? (const char*)g.A + (size_t)nxt.pm * tstep : cA; const char* nB = has_next ? (const char*)g.Bt + (size_t)nxt.pn * tstep : cB;
#ifdef KT_PROBE
        if constexpr (Epi::PROBE) pc0 = __builtin_amdgcn_s_memtime();
#endif
        for (int t = 0; t < nt; t += 2) {
#ifdef KT_PROBE
            if constexpr (Epi::PROBE) if (t == 4) pc4 = __builtin_amdgcn_s_memtime();
#endif
            const bool last = (t == nt - 2);
            const char* a1 = cA + (size_t)(t >> 1) * kpairA + kstep;
            const char* a2 = last ? nA : cA + (size_t)((t >> 1) + 1) * kpairA; const char* b2 = last ? nB : cB + (size_t)(t + 2) * kstep;
            const char* a3 = a2 + kstep; const char* b3 = b2 + kstep;
            if (last && has_next) S.a_ready(nxt);
            if constexpr (SP2) {
            PG8_LDB(B0, 0, 0); PG8_LDB(B1, 0, 1); PG8_SCHED; PG8_LDA(At, 0, 0); PG8_STAGE(PG8_SA(1, 1), a1 + hstep, voffA);
            PG8_WAIT_V(8); PG8_WAIT_L(0); PG8_BAR; PG8_MMA(0, 0, At, B0); PG8_MMA(0, 1, At, B1); PG8_BAR; PG8_SCHED;
            PG8_LDA(At, 0, 1); PG8_STAGE(PG8_SB(0, 0), b2, voffB); PG8_STAGE(PG8_SB(0, 1), b2 + hstep, voffB); PG8_STAGE(PG8_SA(0, 0), a2, voffA);
            PG8_WAIT_V(8); PG8_WAIT_L(0); PG8_BAR; PG8_MMA(1, 0, At, B0); PG8_MMA(1, 1, At, B1); PG8_BAR; PG8_SCHED;
            PG8_LDB(B0, 1, 0); PG8_LDB(B1, 1, 1); PG8_SCHED; PG8_LDA(At, 1, 0); PG8_STAGE(PG8_SA(0, 1), a2 + hstep, voffA);
            PG8_WAIT_V(8); PG8_WAIT_L(0); PG8_BAR; PG8_MMA(0, 0, At, B0); PG8_MMA(0, 1, At, B1); PG8_BAR; PG8_SCHED;
            PG8_LDA(At, 1, 1); PG8_STAGE(PG8_SB(1, 0), b3, voffB); PG8_STAGE(PG8_SB(1, 1), b3 + hstep, voffB); PG8_STAGE(PG8_SA(1, 0), a3, voffA);
            PG8_WAIT_V(8); PG8_WAIT_L(0); PG8_BAR; PG8_MMA(1, 0, At, B0); PG8_MMA(1, 1, At, B1); PG8_BAR; PG8_SCHED;
            } else {
            PG8_LDB(B0, 0, 0); PG8_SCHED; PG8_LDA(At, 0, 0); PG8_STAGE(PG8_SA(1, 1), a1 + hstep, voffA);
            PG8_WAIT_L(8); PG8_BAR; PG8_WAIT_L(0); PG8_MMA(0, 0, At, B0); PG8_BAR; PG8_SCHED;
            PG8_LDB(B1, 0, 1); PG8_STAGE(PG8_SB(0, 0), b2, voffB);
            PG8_BAR; PG8_WAIT_L(0); PG8_MMA(0, 1, At, B1); PG8_BAR;
            PG8_LDA(At, 0, 1); PG8_STAGE(PG8_SA(0, 0), a2, voffA);
            PG8_BAR; PG8_WAIT_L(0); PG8_MMA(1, 0, At, B0); PG8_BAR; PG8_SCHED;
            PG8_STAGE(PG8_SB(0, 1), b2 + hstep, voffB);
            PG8_WAIT_V(6); PG8_BAR; PG8_MMA(1, 1, At, B1); PG8_BAR;
            PG8_LDB(B0, 1, 0); PG8_SCHED; PG8_LDA(At, 1, 0); PG8_STAGE(PG8_SA(0, 1), a2 + hstep, voffA);
            PG8_WAIT_L(8); PG8_BAR; PG8_WAIT_L(0); PG8_MMA(0, 0, At, B0); PG8_BAR; PG8_SCHED;
            PG8_LDB(B1, 1, 1); PG8_STAGE(PG8_SB(1, 0), b3, voffB);
            PG8_BAR; PG8_WAIT_L(0); PG8_MMA(0, 1, At, B1); PG8_BAR;
            PG8_LDA(At, 1, 1); PG8_STAGE(PG8_SA(1, 0), a3, voffA);
            PG8_BAR; PG8_WAIT_L(0); PG8_MMA(1, 0, At, B0); PG8_BAR; PG8_SCHED;
            PG8_STAGE(PG8_SB(1, 1), b3 + hstep, voffB);
            PG8_WAIT_V(6); PG8_BAR; PG8_MMA(1, 1, At, B1); PG8_BAR;
            }
        }
#ifdef KT_PROBE
        if constexpr (Epi::PROBE) { const unsigned long long pe = __builtin_amdgcn_s_memtime(); pall += (unsigned)(pe - pc0); pss += (unsigned)(pe - pc4); ++pn; pce = pe; }
#endif
        if constexpr (ALIGN_EPI) { if (wr == 0) PG8_BAR; }
        if constexpr (!Epi::AFTER_DRAIN) { float rsv[8]; E.load_rs((const PG8_LAS float*)(lds + RSTAB + rslot * 1024), wr, fr, rsv); E(acc, cur, wr, wc, fr, fq, rsv); S.done(cur); }
#ifdef KT_PROBE
        if constexpr (Epi::PROBE) { const unsigned long long px = __builtin_amdgcn_s_memtime(); pepi += (unsigned)(px - pce); }
#endif
        if (!has_next) break;
#pragma unroll
        for (int a = 0; a < 2; ++a)
#pragma unroll
            for (int b = 0; b < 2; ++b)
#pragma unroll
                for (int m = 0; m < 4; ++m)
#pragma unroll
                    for (int n = 0; n < 2; ++n) acc[a][b][m][n] = (f32x4){0.f, 0.f, 0.f, 0.f};
        cur = nxt; cA = nA; cB = nB; ++ui; rslot = rslot_n;
        if constexpr (ALIGN_EPI) { if (wr == 1) PG8_BAR; }
    }
#ifdef KT_PROBE
    if constexpr (Epi::PROBE) if (tid == 0) { PG8_LAS unsigned* pw = (PG8_LAS unsigned*)(lds + 131072 + 640); pw[0] += pall; pw[1] += pss; pw[2] += pn; pw[3] += pepi; }
#endif
    PG8_WAIT_V(0);
    if constexpr (!ALIGN_EPI) { if (wr == 0) PG8_BAR; }
    PG8_BAR;
    if constexpr (Epi::AFTER_DRAIN) { E.fused(acc, cur, wr, wc, fr, fq, lds, wid, lane); S.done(cur); }
#undef PG8_SA
#undef PG8_SB
#undef PG8_STAGE
#undef PG8_LDA
#undef PG8_LDB
#undef PG8_MMA
#undef PG8_WAIT_V
#undef PG8_WAIT_L
#undef PG8_BAR
#undef PG8_SCHED
#undef PG8_STAGE_RS
}
}
#ifndef PG8_SP2
#define PG8_SP2 true
#endif
#ifndef PG8_ALIGN
#define PG8_ALIGN true
#endif
#define GAS __attribute__((address_space(1)))
#define LAS __attribute__((address_space(3)))
typedef unsigned short bf16;
typedef unsigned v4u __attribute__((ext_vector_type(4)));
typedef float f32x4 __attribute__((ext_vector_type(4)));
typedef short bf16x8 __attribute__((ext_vector_type(8)));
typedef GAS unsigned gu32;
typedef GAS unsigned long long gu64;
#define RLX_AGENT __ATOMIC_RELAXED, __HIP_MEMORY_SCOPE_AGENT
#define LDS_WAIT() asm volatile("s_waitcnt lgkmcnt(0)" ::: "memory")
#define VM_WAIT() asm volatile("s_waitcnt vmcnt(0)" ::: "memory")
__device__ __forceinline__ unsigned long long rt() { return __builtin_amdgcn_s_memrealtime(); }
__device__ __forceinline__ unsigned f2bf(float f) { unsigned u = __builtin_bit_cast(unsigned, f); return (u + 0x7fffu + ((u >> 16) & 1u)) >> 16; }
__device__ __forceinline__ unsigned pk2(float lo, float hi) { return f2bf(lo) | (f2bf(hi) << 16); }

#define XB_TMO      128
#define XB_XCNT(j)  (256  + 64 * (j))
#define XB_XSUB(j)  (1280 + 64 * (j))
#define XB_XGEN(j)  (2304 + 64 * (j))
#define XB_TOP      3328
#define XB_TOPGEN   3392
#define XCD_BAR_WORDS 3456
#define XB_SPIN_CAP (1u << 18)

__device__ __forceinline__ unsigned xb_ld(unsigned* p)              { return __hip_atomic_load(p, __ATOMIC_RELAXED, __HIP_MEMORY_SCOPE_AGENT); }
__device__ __forceinline__ unsigned xb_add(unsigned* p, unsigned v) { return __hip_atomic_fetch_add(p, v, __ATOMIC_RELAXED, __HIP_MEMORY_SCOPE_AGENT); }
__device__ __forceinline__ unsigned xb_xcc_id() { return (unsigned)__builtin_amdgcn_s_getreg((3 << 11) | 20) & 0xFu; }
#define XB_SPIN(cond, bar) do { unsigned _sp = 0; while (cond) { __builtin_amdgcn_s_sleep(1); \
    if ((++_sp & 255u) == 0u) { if (xb_ld(&(bar)[XB_TMO])) break; if (_sp > XB_SPIN_CAP) { atomicAdd(&(bar)[XB_TMO], 1u); break; } } } } while (0)

struct XcdBarrier {
    unsigned* bar; unsigned x;
    volatile LAS unsigned* st;
};

__device__ __forceinline__ XcdBarrier xcd_barrier_post(unsigned* bar, volatile LAS unsigned* st) {
    XcdBarrier b; b.bar = bar; b.x = xb_xcc_id(); b.st = st;
    if (threadIdx.x == 0) (void)xb_add(&bar[XB_XCNT(b.x)], 1u);
    return b;
}
__device__ __forceinline__ void xcd_barrier_complete(unsigned* bar, unsigned x, unsigned& nloc, unsigned& nx) {
    const unsigned G = gridDim.x * gridDim.y * gridDim.z;
    unsigned sum, cnt, mine, sp = 0u;
    for (;;) {
        sum = 0u; cnt = 0u; mine = 0u;
#pragma unroll
        for (unsigned j = 0; j < 16; ++j) { const unsigned c = xb_ld(&bar[XB_XCNT(j)]); sum += c; cnt += (c > 0u) ? 1u : 0u; mine = (j == x) ? c : mine; }
        if (sum == G) break;
        __builtin_amdgcn_s_sleep(1);
        if ((++sp & 255u) == 0u) { if (xb_ld(&bar[XB_TMO])) break; if (sp > XB_SPIN_CAP) { atomicAdd(&bar[XB_TMO], 1u); break; } }
    }
    nloc = mine > 0u ? mine : 1u; nx = cnt > 0u ? cnt : 1u;
}

__device__ __forceinline__ void xcd_barrier(const XcdBarrier& b) {
    asm volatile("s_waitcnt vmcnt(0)" ::: "memory");
    __syncthreads();
    if (threadIdx.x == 0) {
        unsigned* bar = b.bar;
        __builtin_amdgcn_s_waitcnt(0);
        unsigned nloc = b.st[0], nx = b.st[1];
        if (nloc == 0u) { xcd_barrier_complete(bar, b.x, nloc, nx); b.st[0] = nloc; b.st[1] = nx; }
        const unsigned old = xb_add(&bar[XB_XSUB(b.x)], 1u);
        const unsigned gen = old / nloc;
        if (old + 1u == (gen + 1u) * nloc) {
            __builtin_amdgcn_fence(__ATOMIC_RELEASE, "agent");
            asm volatile("s_waitcnt vmcnt(0)" ::: "memory");
            const unsigned og = xb_add(&bar[XB_TOP], 1u);
            const unsigned tg = og / nx;
            if (og + 1u == (tg + 1u) * nx) xb_add(&bar[XB_TOPGEN], 1u);
            else XB_SPIN(xb_ld(&bar[XB_TOPGEN]) == tg, bar);
            __builtin_amdgcn_fence(__ATOMIC_ACQUIRE, "agent");
            xb_add(&bar[XB_XGEN(b.x)], 1u);
            asm volatile("s_waitcnt vmcnt(0)" ::: "memory");
        } else {
            XB_SPIN(xb_ld(&bar[XB_XGEN(b.x)]) == gen, bar);
            __builtin_amdgcn_fence(__ATOMIC_ACQUIRE, "agent");
            asm volatile("s_waitcnt vmcnt(0)" ::: "memory");
        }
    }
    __syncthreads();
}
constexpr int NWAVES = 8;
constexpr int BATCH = 4, SEQ = 8192, DM = 1024, M = BATCH * SEQ, DEPTH = 4;
constexpr int PP = 2560;
constexpr int QA_OFF = 0, KA_OFF = 512, VA_OFF = 576, QI_OFF = 640, KI_OFF = 896, QB_OFF = 960, KB_OFF = 1472, VB_OFF = 1984, WI_OFF = 2496;
constexpr int EVEN_IN = 2500, DFF = 2816, CWID = 2048, TOPK = 256;
constexpr float EPS = 1e-6f;
constexpr int N_PHASES = 1 + 7 * DEPTH;

constexpr size_t MiB = 1u << 20;
constexpr size_t WS_CTL = 0, CTL_ZERO_BYTES = 64 * 1024;
constexpr size_t WS_WINE = 1 * MiB, WS_WOUTE = 11 * MiB, WS_WINO = 15 * MiB, WS_WOUTO = 31 * MiB, WS_WFFI = 39 * MiB, WS_WFFO = 83 * MiB, WS_WSP = 105 * MiB;
constexpr size_t WS_STATS = 106 * MiB, WS_A = 114 * MiB, WS_R1 = 178 * MiB, WS_Y = WS_R1 + 192 * MiB, WS_KT = 434 * MiB, WS_END = 438 * MiB;
constexpr size_t SZ_WINE = (size_t)PP * DM * 2, SZ_WOUTE = (size_t)DM * DM * 2, SZ_WINO = (size_t)4096 * DM * 2, SZ_WOUTO = (size_t)DM * CWID * 2, SZ_WFFI = (size_t)2 * DFF * DM * 2, SZ_WFFO = (size_t)DM * DFF * 2, SZ_WSP = (size_t)16 * 128 * 128 * 2;
static_assert(WS_WINE + 2 * SZ_WINE <= WS_WOUTE && WS_WOUTE + 2 * SZ_WOUTE <= WS_WINO && WS_WINO + 2 * SZ_WINO <= WS_WOUTO && WS_WOUTO + 2 * SZ_WOUTO <= WS_WFFI && WS_WFFI + 4 * SZ_WFFI <= WS_WFFO && WS_WFFO + 4 * SZ_WFFO <= WS_WSP && WS_WSP + 2 * SZ_WSP <= WS_STATS, "weights map");
static_assert(WS_STATS + (size_t)M * 32 * 8 <= WS_A && WS_A + (size_t)M * DM * 2 <= WS_R1 && WS_R1 + (size_t)M * PP * 2 <= WS_Y && WS_R1 + (size_t)M * DFF * 2 <= WS_Y && WS_Y + (size_t)M * DM * 2 <= WS_KT && WS_KT + (size_t)M * 64 * 2 <= WS_END, "activation map");
constexpr int CW_BAR = 4096;
constexpr int SBQ_OFF = 10240;

constexpr int RING_OFF = 0, RING_BYTES = 131072;
constexpr int LDSCTL_OFF = RING_BYTES, MISC_OFF = LDSCTL_OFF + 320;
constexpr int LDS_BYTES = 147456;
constexpr int LIST_OFF = RING_BYTES + 1024;
constexpr int LB_OFF = RING_BYTES + 512;
constexpr int HIST_OFF = LIST_OFF + 4096;
static_assert(HIST_OFF + 8192 <= LDS_BYTES, "LDS map");

typedef float f32x16 __attribute__((ext_vector_type(16)));
typedef __bf16 bf16x2_t __attribute__((ext_vector_type(2)));
typedef unsigned u32x2 __attribute__((ext_vector_type(2)));
typedef float f32x2 __attribute__((ext_vector_type(2)));
typedef short s16x2_t __attribute__((ext_vector_type(2)));
typedef unsigned short u16x2_t __attribute__((ext_vector_type(2)));

__device__ __forceinline__ f32x16 zero16() { f32x16 z;
#pragma unroll
    for (int i = 0; i < 16; ++i) z[i] = 0.f;
    asm volatile("" : "+v"(z)); return z; }
__device__ __forceinline__ float bflo(unsigned u) { return __uint_as_float(u << 16); }
__device__ __forceinline__ float bfhi(unsigned u) { return __uint_as_float(u & 0xffff0000u); }
__device__ __forceinline__ unsigned cvtpk(float lo, float hi) { const f32x2 v = {lo, hi}; const bf16x2_t b = __builtin_convertvector(v, bf16x2_t); return __builtin_bit_cast(unsigned, b); }
#define DPP_ADD(V, CTRL, RMASK) V += __builtin_bit_cast(float, __builtin_amdgcn_update_dpp(0, __builtin_bit_cast(int, V), CTRL, RMASK, 0xf, false))
__device__ __forceinline__ float wave_sum(float v) {
    DPP_ADD(v, 0x111, 0xf); DPP_ADD(v, 0x112, 0xf); DPP_ADD(v, 0x114, 0xf); DPP_ADD(v, 0x118, 0xf); DPP_ADD(v, 0x142, 0xa); DPP_ADD(v, 0x143, 0xc);
    return __builtin_bit_cast(float, __builtin_amdgcn_readlane(__builtin_bit_cast(int, v), 63));
}
__device__ __forceinline__ float xsum32(float v) { const auto rr = __builtin_amdgcn_permlane32_swap(__float_as_uint(v), __float_as_uint(v), false, false); return __uint_as_float(rr[0]) + __uint_as_float(rr[1]); }
__device__ __forceinline__ float xsum16(float v) { const auto rr = __builtin_amdgcn_permlane16_swap(__float_as_uint(v), __float_as_uint(v), false, false); return __uint_as_float(rr[0]) + __uint_as_float(rr[1]); }
__device__ __forceinline__ float xmax32(float v) { const auto rr = __builtin_amdgcn_permlane32_swap(__float_as_uint(v), __float_as_uint(v), false, false); return fmaxf(__uint_as_float(rr[0]), __uint_as_float(rr[1])); }
__device__ __forceinline__ float xmax16(float v) { const auto rr = __builtin_amdgcn_permlane16_swap(__float_as_uint(v), __float_as_uint(v), false, false); return fmaxf(__uint_as_float(rr[0]), __uint_as_float(rr[1])); }
__device__ __forceinline__ float wave_max(float v) {
#pragma unroll
    for (int o = 1; o < 64; o <<= 1) v = fmaxf(v, __shfl_xor(v, o));
    return v;
}
__device__ __forceinline__ unsigned wave_sum_u(unsigned v) {
#pragma unroll
    for (int o = 1; o < 64; o <<= 1) v += (unsigned)__shfl_xor((int)v, o);
    return v;
}

struct Frame {
    LAS unsigned char* lds;
    volatile LAS unsigned* MISC;
    gu32* ctl;
    int tid, lane, wave, G, c;
    const float *x, *gains, *w_in_even, *w_out_even, *w_in_odd, *spatial_w, *spatial_b, *vgain, *vbias, *w_out_odd, *w_ffn_in, *w_ffn_out;
    float* out;
    bf16 *WinE, *WoutE, *WinO, *WoutO, *Wffi, *Wffo, *Wsp;
    float* stats;
    bf16 *A, *R1, *Y, *MIX, *KT;
    float* RS;
    float* WSUM;
};

__device__ __forceinline__ int src_col(int mode, int d) {
    if (mode == 0) return d;
    if (mode == 1) { if (d < 960) return d; if (d < 2496) return d + 4; if (d < 2500) return d - 2496 + 960; return -1; }
    const int pn = d >> 8, xx = d & 255; return (xx >> 7) * DFF + 128 * pn + (xx & 127);
}
struct TItem { const float* W; bf16* WT; const float* gain; const float* gsafe; int K, Nsrc, ND, mode, item; };
__device__ __forceinline__ void titem_load(const TItem& d, int lane, f32x4 (&v)[8], float (&gv)[8]) {
    const int nblk = d.ND / 32, kb = d.item / nblk, nb = d.item % nblk, k0 = 64 * kb, n0 = 32 * nb;
    const int n4 = 4 * (lane & 7), sc = src_col(d.mode, n0 + n4), scl = sc >= 0 ? sc : 0;
    const float* gp = d.gain ? d.gain : d.gsafe;
#pragma unroll
    for (int i = 0; i < 8; ++i) { const int kk = (lane >> 3) + 8 * i; v[i] = *(const f32x4*)(d.W + (size_t)(k0 + kk) * d.Nsrc + scl); gv[i] = gp[k0 + kk]; }
}
__device__ __forceinline__ void titem_process(const TItem& d, LAS float* scr, int lane, const f32x4 (&v)[8], const float (&gv)[8]) {
    const int nblk = d.ND / 32, kb = d.item / nblk, nb = d.item % nblk, k0 = 64 * kb, n0 = 32 * nb;
    const int n4 = 4 * (lane & 7), sc = src_col(d.mode, n0 + n4);
#pragma unroll
    for (int i = 0; i < 8; ++i) { const int kk = (lane >> 3) + 8 * i; const float gm = sc >= 0 ? (d.gain ? gv[i] : 1.0f) : 0.f;
        const f32x4 w = v[i] * gm; LAS float* sp = scr + kk * 33 + n4; sp[0] = w.x; sp[1] = w.y; sp[2] = w.z; sp[3] = w.w; }
    LDS_WAIT(); asm volatile("" ::: "memory");
    const int c = lane & 7;
#pragma unroll
    for (int j = 0; j < 4; ++j) { const int n = (lane >> 3) + 8 * j; const LAS float* s = scr + (8 * c) * 33 + n;
        v4u o; o.x = cvtpk(s[0 * 33], s[1 * 33]); o.y = cvtpk(s[2 * 33], s[3 * 33]); o.z = cvtpk(s[4 * 33], s[5 * 33]); o.w = cvtpk(s[6 * 33], s[7 * 33]);
        *(GAS v4u*)(d.WT + (size_t)(n0 + n) * d.K + k0 + 8 * c) = o; }
    LDS_WAIT(); asm volatile("" ::: "memory");
}
__device__ __forceinline__ void x_row_to_bf16(const float* xrow, bf16* orow, float* rs, int lane) {
    const f32x4* xr = (const f32x4*)xrow + lane; f32x4 v[4]; float s = 0.f;
#pragma unroll
    for (int j = 0; j < 4; ++j) { v[j] = xr[64 * j]; s += (v[j].x * v[j].x + v[j].y * v[j].y) + (v[j].z * v[j].z + v[j].w * v[j].w); }
    const float r = 1.0f / sqrtf(wave_sum(s) * (1.f / DM) + EPS);
#pragma unroll
    for (int j = 0; j < 4; ++j) { u32x2 o; o.x = cvtpk(v[j].x, v[j].y); o.y = cvtpk(v[j].z, v[j].w); ((u32x2*)orow)[lane + 64 * j] = o; }
    if (lane == 0) *rs = r;
}
template <bool HF32, bool LAST, int R> __device__ __forceinline__ void res_rows(const void* hin, const bf16* yin, const float (&gp)[2][8], void* hout, float* rs, size_t m0, size_t mstep, int lane) {
    float h[R][2][8], y[R][2][8], s[R];
#pragma unroll
    for (int q = 0; q < R; ++q) { const size_t m = m0 + q * mstep; s[q] = 0.f;
#pragma unroll
        for (int j = 0; j < 2; ++j) {
            if (HF32) { const f32x4* hp = (const f32x4*)((const float*)hin + m * DM); const f32x4 a = hp[2 * lane + 128 * j], c = hp[2 * lane + 128 * j + 1];
                h[q][j][0] = a.x; h[q][j][1] = a.y; h[q][j][2] = a.z; h[q][j][3] = a.w; h[q][j][4] = c.x; h[q][j][5] = c.y; h[q][j][6] = c.z; h[q][j][7] = c.w; }
            else { const v4u hh = ((const v4u*)((const bf16*)hin + m * DM))[lane + 64 * j];
                h[q][j][0] = bflo(hh.x); h[q][j][1] = bfhi(hh.x); h[q][j][2] = bflo(hh.y); h[q][j][3] = bfhi(hh.y); h[q][j][4] = bflo(hh.z); h[q][j][5] = bfhi(hh.z); h[q][j][6] = bflo(hh.w); h[q][j][7] = bfhi(hh.w); }
            const v4u yy = ((const v4u*)(yin + m * DM))[lane + 64 * j];
            y[q][j][0] = bflo(yy.x); y[q][j][1] = bfhi(yy.x); y[q][j][2] = bflo(yy.y); y[q][j][3] = bfhi(yy.y); y[q][j][4] = bflo(yy.z); y[q][j][5] = bfhi(yy.z); y[q][j][6] = bflo(yy.w); y[q][j][7] = bfhi(yy.w);
#pragma unroll
            for (int e = 0; e < 8; ++e) s[q] += y[q][j][e] * y[q][j][e]; } }
#pragma unroll
    for (int q = 0; q < R; ++q) s[q] = wave_sum(s[q]);
    float s2[R];
#pragma unroll
    for (int q = 0; q < R; ++q) { const size_t m = m0 + q * mstep; const float r = 1.0f / sqrtf(s[q] * (1.f / DM) + EPS); s2[q] = 0.f;
#pragma unroll
        for (int j = 0; j < 2; ++j) {
#pragma unroll
            for (int e = 0; e < 8; ++e) { h[q][j][e] = h[q][j][e] + (y[q][j][e] * r) * gp[j][e]; s2[q] += h[q][j][e] * h[q][j][e]; }
            if (LAST) { f32x4* op = (f32x4*)((float*)hout + m * DM);
                __builtin_nontemporal_store((f32x4){h[q][j][0], h[q][j][1], h[q][j][2], h[q][j][3]}, op + 2 * lane + 128 * j); __builtin_nontemporal_store((f32x4){h[q][j][4], h[q][j][5], h[q][j][6], h[q][j][7]}, op + 2 * lane + 128 * j + 1); }
            else { v4u o; o.x = cvtpk(h[q][j][0], h[q][j][1]); o.y = cvtpk(h[q][j][2], h[q][j][3]); o.z = cvtpk(h[q][j][4], h[q][j][5]); o.w = cvtpk(h[q][j][6], h[q][j][7]); ((v4u*)((bf16*)hout + m * DM))[lane + 64 * j] = o; } } }
    if (!LAST) {
#pragma unroll
        for (int q = 0; q < R; ++q) { const float r2 = 1.0f / sqrtf(wave_sum(s2[q]) * (1.f / DM) + EPS); if (lane == 0) rs[m0 + q * mstep] = r2; } }
}
constexpr int I_WINE = 16 * 80, I_WOUTE = 16 * 32, I_WINO = 16 * 128, I_WOUTO = 32 * 32, I_WFFI = 16 * 176, I_WFFO = 44 * 32;
__device__ __forceinline__ void p0_prologue(Frame& F) {
    LAS float* scr = (LAS float*)(F.lds + RING_OFF + F.wave * 16384);
    const int gw = F.c * NWAVES + F.wave, NGW = F.G * NWAVES;
    constexpr int NITEMS = 2 * (I_WINE + I_WOUTE + I_WINO + I_WOUTO) + 4 * (I_WFFI + I_WFFO);
    auto decode = [&](int it) -> TItem { int r = it; TItem d; d.gsafe = F.gains; d.gain = nullptr;
        if (r < 2 * I_WINE) { const int i = r / I_WINE; r -= i * I_WINE; d.W = F.w_in_even + (size_t)i * DM * EVEN_IN; d.K = DM; d.Nsrc = EVEN_IN; d.ND = PP; d.mode = 1; d.WT = F.WinE + (size_t)i * PP * DM; d.gain = F.gains + (size_t)(2 * i) * 4 * DM; d.item = r; return d; } r -= 2 * I_WINE;
        if (r < 2 * I_WOUTE) { const int i = r / I_WOUTE; r -= i * I_WOUTE; d.W = F.w_out_even + (size_t)i * DM * DM; d.K = DM; d.Nsrc = DM; d.ND = DM; d.mode = 0; d.WT = F.WoutE + (size_t)i * DM * DM; d.item = r; return d; } r -= 2 * I_WOUTE;
        if (r < 2 * I_WINO) { const int i = r / I_WINO; r -= i * I_WINO; d.W = F.w_in_odd + (size_t)i * DM * 4096; d.K = DM; d.Nsrc = 4096; d.ND = 4096; d.mode = 0; d.WT = F.WinO + (size_t)i * 4096 * DM; d.gain = F.gains + (size_t)(2 * i + 1) * 4 * DM; d.item = r; return d; } r -= 2 * I_WINO;
        if (r < 2 * I_WOUTO) { const int i = r / I_WOUTO; r -= i * I_WOUTO; d.W = F.w_out_odd + (size_t)i * CWID * DM; d.K = CWID; d.Nsrc = DM; d.ND = DM; d.mode = 0; d.WT = F.WoutO + (size_t)i * DM * CWID; d.item = r; return d; } r -= 2 * I_WOUTO;
        if (r < 4 * I_WFFI) { const int i = r / I_WFFI; r -= i * I_WFFI; d.W = F.w_ffn_in + (size_t)i * DM * 2 * DFF; d.K = DM; d.Nsrc = 2 * DFF; d.ND = 2 * DFF; d.mode = 2; d.WT = F.Wffi + (size_t)i * 2 * DFF * DM; d.gain = F.gains + (size_t)i * 4 * DM + 2 * DM; d.item = r; return d; } r -= 4 * I_WFFI;
        { const int i = r / I_WFFO; r -= i * I_WFFO; d.W = F.w_ffn_out + (size_t)i * DFF * DM; d.K = DFF; d.Nsrc = DM; d.ND = DM; d.mode = 0; d.WT = F.Wffo + (size_t)i * DM * DFF; d.item = r; return d; } };
#define TPIN(v) asm volatile("" : "+v"(v[0]), "+v"(v[1]), "+v"(v[2]), "+v"(v[3]), "+v"(v[4]), "+v"(v[5]), "+v"(v[6]), "+v"(v[7]) :: "memory")
    if (gw < NITEMS) { int it = gw; f32x4 va[8], vb[8]; float ga[8], gb[8]; TItem da = decode(it), db; titem_load(da, F.lane, va, ga);
        for (;;) { const int itb = it + NGW; const bool hb = itb < NITEMS; db = decode(hb ? itb : it); titem_load(db, F.lane, vb, gb);
            TPIN(va); titem_process(da, scr, F.lane, va, ga);
            if (!hb) break;
            it = itb + NGW; const bool ha = it < NITEMS; da = decode(ha ? it : itb); titem_load(da, F.lane, va, ga);
            TPIN(vb); titem_process(db, scr, F.lane, vb, gb);
            if (!ha) break; } }
#undef TPIN
    for (int idx = (F.c * NWAVES * 64 + F.tid); idx < 2 * 16 * 128 * 128 / 2; idx += F.G * NWAVES * 64) {
        const int e0 = 2 * idx, t = (e0 >> 7) & 127, s = e0 & 127; const f32x2 wv = *(const f32x2*)(F.spatial_w + e0);
        const unsigned pk = cvtpk(s <= t ? wv.x : 0.f, (s + 1) <= t ? wv.y : 0.f); ((unsigned*)F.Wsp)[idx] = pk;
        const float rsum = wave_sum(bflo(pk) + bfhi(pk)); if (F.lane == 0) F.WSUM[idx >> 6] = rsum; }
    for (int m = gw; m < M; m += 2 * NGW) {
        const f32x4* x0 = (const f32x4*)(F.x + (size_t)m * DM) + F.lane; const f32x4* x1 = (const f32x4*)(F.x + (size_t)(m + NGW) * DM) + F.lane;
        f32x4 v0[4], v1[4]; float s0 = 0.f, s1 = 0.f;
#pragma unroll
        for (int j = 0; j < 4; ++j) { v0[j] = x0[64 * j]; v1[j] = x1[64 * j]; }
#pragma unroll
        for (int j = 0; j < 4; ++j) { s0 += (v0[j].x * v0[j].x + v0[j].y * v0[j].y) + (v0[j].z * v0[j].z + v0[j].w * v0[j].w); s1 += (v1[j].x * v1[j].x + v1[j].y * v1[j].y) + (v1[j].z * v1[j].z + v1[j].w * v1[j].w); }
        s0 = wave_sum(s0); s1 = wave_sum(s1);
        u32x2* o0 = (u32x2*)(F.A + (size_t)m * DM) + F.lane; u32x2* o1 = (u32x2*)(F.A + (size_t)(m + NGW) * DM) + F.lane;
#pragma unroll
        for (int j = 0; j < 4; ++j) { u32x2 a; a.x = cvtpk(v0[j].x, v0[j].y); a.y = cvtpk(v0[j].z, v0[j].w); o0[64 * j] = a; u32x2 b; b.x = cvtpk(v1[j].x, v1[j].y); b.y = cvtpk(v1[j].z, v1[j].w); o1[64 * j] = b; }
        if (F.lane == 0) { F.RS[m] = 1.0f / sqrtf(s0 * (1.f / DM) + EPS); F.RS[m + NGW] = 1.0f / sqrtf(s1 * (1.f / DM) + EPS); }
    }
}
template <bool HF32, bool LAST> __device__ __forceinline__ void thin_phase(Frame& F, const float* gpost, bool dry = false) {
    const int gw = F.c * NWAVES + F.wave, NGW = F.G * NWAVES;
    const void* hin = HF32 ? (const void*)F.x : (const void*)F.A;
    void* hout = dry ? (void*)F.R1 : (LAST ? (void*)F.out : (void*)F.A);
    float* rs = dry ? F.stats : F.RS;
    float gp[2][8];
#pragma unroll
    for (int j = 0; j < 2; ++j) { const f32x4 g0 = ((const f32x4*)gpost)[2 * F.lane + 128 * j], g1 = ((const f32x4*)gpost)[2 * F.lane + 128 * j + 1];
        gp[j][0] = g0.x; gp[j][1] = g0.y; gp[j][2] = g0.z; gp[j][3] = g0.w; gp[j][4] = g1.x; gp[j][5] = g1.y; gp[j][6] = g1.z; gp[j][7] = g1.w; }
    for (int m = gw; m < M; m += 2 * NGW) res_rows<HF32, LAST, 2>(hin, F.Y, gp, hout, rs, (size_t)m, (size_t)NGW, F.lane);
}

#ifdef DBG_SB_FULL
constexpr float SB_STOP = -1e30f;
#else
constexpr float SB_STOP = -60.0f;
#endif
__device__ __forceinline__ void sb_task(const bf16* P, bf16* mix, int task, int lane) {
    const int b = task >> 10, h = (task >> 7) & 7, t = ((task & 127) << 6) + lane;
    const size_t rowq = (size_t)b * SEQ + t;
    float q[64], o[64];
    { const v4u* qp = (const v4u*)(P + rowq * PP + QB_OFF + h * 64);
#pragma unroll
      for (int i = 0; i < 8; ++i) { const v4u w = qp[i]; q[8 * i + 0] = bflo(w.x) * 0.125f; q[8 * i + 1] = bfhi(w.x) * 0.125f; q[8 * i + 2] = bflo(w.y) * 0.125f; q[8 * i + 3] = bfhi(w.y) * 0.125f;
          q[8 * i + 4] = bflo(w.z) * 0.125f; q[8 * i + 5] = bfhi(w.z) * 0.125f; q[8 * i + 6] = bflo(w.w) * 0.125f; q[8 * i + 7] = bfhi(w.w) * 0.125f; } }
#pragma unroll
    for (int d = 0; d < 64; ++d) o[d] = 0.f;
    float after = 0.f; int s = t - 1; bool act = s >= 0;
    while (__any(act)) {
        if (act) {
            const v4u* kp = (const v4u*)(P + ((size_t)b * SEQ + s) * PP + KB_OFF + h * 64);
            const v4u* vp = (const v4u*)(P + ((size_t)b * SEQ + s) * PP + VB_OFF + h * 64);
            float z = 0.f;
#pragma unroll
            for (int i = 0; i < 8; ++i) { const v4u w = kp[i]; z += q[8 * i + 0] * bflo(w.x) + q[8 * i + 1] * bfhi(w.x) + q[8 * i + 2] * bflo(w.y) + q[8 * i + 3] * bfhi(w.y)
                                                                 + q[8 * i + 4] * bflo(w.z) + q[8 * i + 5] * bfhi(w.z) + q[8 * i + 6] * bflo(w.w) + q[8 * i + 7] * bfhi(w.w); }
            const float l1p = __logf(1.0f + __expf(-fabsf(z)));
            const float ls_pos = fminf(z, 0.f) - l1p, ls_neg = fminf(-z, 0.f) - l1p;
            const float wgt = __expf(ls_pos + after);
#pragma unroll
            for (int i = 0; i < 8; ++i) { const v4u w = vp[i]; o[8 * i + 0] += wgt * bflo(w.x); o[8 * i + 1] += wgt * bfhi(w.x); o[8 * i + 2] += wgt * bflo(w.y); o[8 * i + 3] += wgt * bfhi(w.y);
                                           o[8 * i + 4] += wgt * bflo(w.z); o[8 * i + 5] += wgt * bfhi(w.z); o[8 * i + 6] += wgt * bflo(w.w); o[8 * i + 7] += wgt * bfhi(w.w); }
            after += ls_neg; --s; act = (s >= 0) && (after > SB_STOP);
        }
    }
    v4u* op = (v4u*)(mix + rowq * DM + 512 + h * 64);
#ifdef DBG_ZERO_YB
#pragma unroll
    for (int d = 0; d < 64; ++d) o[d] = 0.f;
#endif
#pragma unroll
    for (int i = 0; i < 8; ++i) { v4u w; w.x = cvtpk(o[8 * i + 0], o[8 * i + 1]); w.y = cvtpk(o[8 * i + 2], o[8 * i + 3]); w.z = cvtpk(o[8 * i + 4], o[8 * i + 5]); w.w = cvtpk(o[8 * i + 6], o[8 * i + 7]); op[i] = w; }
}

typedef short v4i16_t __attribute__((ext_vector_type(4)));
constexpr int SB_ROWB = 192, SB_VBUF = 32 * SB_ROWB;
struct SbPre { pg8::bf16x8 Bq[4], Ak[4]; v4u Vn[4]; };
__device__ __forceinline__ void sb_prefetch(Frame& F, const bf16* P, int u, SbPre& pre) {
    int lane = F.lane; asm volatile("" : "+v"(lane)); const int r = lane & 31, hh = lane >> 5;
    const int b = u >> 11, h = (u >> 3) & 7, qb = ((u >> 6) & 31) * 8 + (u & 7), t0 = qb * 32; const size_t rowb = (size_t)b * SEQ;
    { const bf16* qp = P + (rowb + t0 + r) * PP + QB_OFF + h * 64 + 8 * hh;
#pragma unroll
      for (int s = 0; s < 4; ++s) pre.Bq[s] = *(const pg8::bf16x8*)(qp + 16 * s); }
    { const bf16* kp = P + (rowb + 32 * qb + r) * PP + KB_OFF + h * 64 + 8 * hh;
#pragma unroll
      for (int s = 0; s < 4; ++s) pre.Ak[s] = *(const pg8::bf16x8*)(kp + 16 * s);
#pragma unroll
      for (int i = 0; i < 4; ++i) { const int c = lane + 64 * i; pre.Vn[i] = *(const v4u*)(P + (rowb + 32 * qb + (c >> 3)) * PP + VB_OFF + h * 64 + 8 * (c & 7)); } }
}
__device__ __forceinline__ void sb_unit(Frame& F, const bf16* P, bf16* mix, int u, SbPre& pre, int u_next) {
    const int lane = F.lane, r = lane & 31, hh = lane >> 5;
    const int b = u >> 11, h = (u >> 3) & 7, qb = ((u >> 6) & 31) * 8 + (u & 7), t0 = qb * 32;
    const size_t rowb = (size_t)b * SEQ;
    LAS unsigned char* vb = F.lds + RING_OFF + F.wave * (2 * SB_VBUF);
    pg8::bf16x8 Bq[4];
#pragma unroll
    for (int s = 0; s < 4; ++s) Bq[s] = pre.Bq[s];
    pg8::bf16x8 Uf[2];
#pragma unroll
    for (int s = 0; s < 2; ++s)
#pragma unroll
        for (int j = 0; j < 8; ++j) Uf[s][j] = ((16 * s + 8 * (j >> 2) + 4 * hh + (j & 3)) > r) ? (short)0x3F80 : (short)0;
    f32x16 oacc[2];
#pragma unroll
    for (int d = 0; d < 2; ++d)
#pragma unroll
        for (int i = 0; i < 16; ++i) oacc[d][i] = 0.f;
    float carry = 0.f;
    const int q4 = (lane & 15) >> 2, p4 = lane & 3, g1 = (lane >> 4) & 1;
    const int troff = (4 * hh + q4) * SB_ROWB + (16 * g1 + 4 * p4) * 2;
    pg8::bf16x8 Akn[4]; v4u Vn[4];
#define SB_LOAD(KT) do { const bf16* kp_ = P + (rowb + 32 * (KT) + r) * PP + KB_OFF + h * 64 + 8 * hh; \
        _Pragma("unroll") for (int s_ = 0; s_ < 4; ++s_) Akn[s_] = *(const pg8::bf16x8*)(kp_ + 16 * s_); \
        _Pragma("unroll") for (int i_ = 0; i_ < 4; ++i_) { const int c_ = lane + 64 * i_; Vn[i_] = *(const v4u*)(P + (rowb + 32 * (KT) + (c_ >> 3)) * PP + VB_OFF + h * 64 + 8 * (c_ & 7)); } } while (0)
#pragma unroll
    for (int s = 0; s < 4; ++s) Akn[s] = pre.Ak[s];
#pragma unroll
    for (int i = 0; i < 4; ++i) Vn[i] = pre.Vn[i];
    asm volatile("" : "+v"(Bq[0]), "+v"(Bq[1]), "+v"(Bq[2]), "+v"(Bq[3]), "+v"(Akn[0]), "+v"(Akn[1]), "+v"(Akn[2]), "+v"(Akn[3]), "+v"(Vn[0]), "+v"(Vn[1]), "+v"(Vn[2]), "+v"(Vn[3]) :: "memory");
    sb_prefetch(F, P, u_next, pre);
    for (int kt = qb; kt >= 0; --kt) {
        LAS unsigned char* vt = vb + (kt & 1) * SB_VBUF;
        pg8::bf16x8 Ak[4];
#pragma unroll
        for (int s = 0; s < 4; ++s) Ak[s] = Akn[s];
#pragma unroll
        for (int i = 0; i < 4; ++i) { const int c = lane + 64 * i; *(LAS v4u*)(vt + (c >> 3) * SB_ROWB + (c & 7) * 16) = Vn[i]; }
        if (kt > 0) SB_LOAD(kt - 1);
        f32x16 d1;
#pragma unroll
        for (int i = 0; i < 16; ++i) d1[i] = 0.f;
#pragma unroll
        for (int s = 0; s < 4; ++s) d1 = __builtin_amdgcn_mfma_f32_32x32x16_bf16(Ak[s], Bq[s], d1, 0, 0, 0);
        const bool diag = (kt == qb);
        float tot = 0.f;
        v4u hi[2], lo[2];
#pragma unroll
        for (int s = 0; s < 2; ++s)
#pragma unroll
            for (int mm = 0; mm < 4; ++mm) { const int i0 = 8 * s + 2 * mm;
                const f32x2 z = (f32x2){d1[i0], d1[i0 + 1]} * 0.18033688011112042f;
                f32x2 l; l.x = __builtin_amdgcn_logf(1.0f + __builtin_amdgcn_exp2f(z.x)); l.y = __builtin_amdgcn_logf(1.0f + __builtin_amdgcn_exp2f(z.y));
                f32x2 a = -l, sg = z - l;
                if (diag) {
                    if ((8 * (i0 >> 2) + 4 * hh + (i0 & 3)) >= r) { a.x = 0.f; sg.x = -INFINITY; }
                    if ((8 * ((i0 + 1) >> 2) + 4 * hh + ((i0 + 1) & 3)) >= r) { a.y = 0.f; sg.y = -INFINITY; } }
                tot += a.x + a.y; d1[i0] = sg.x; d1[i0 + 1] = sg.y;
                const unsigned hp = cvtpk(a.x, a.y); hi[s][mm] = hp; lo[s][mm] = cvtpk(a.x - bflo(hp), a.y - bfhi(hp)); }
        tot = xsum32(tot);
        f32x16 aft;
#pragma unroll
        for (int i = 0; i < 16; ++i) aft[i] = 0.f;
#pragma unroll
        for (int s = 0; s < 2; ++s) {
            aft = __builtin_amdgcn_mfma_f32_32x32x16_bf16(Uf[s], __builtin_bit_cast(pg8::bf16x8, hi[s]), aft, 0, 0, 0);
            aft = __builtin_amdgcn_mfma_f32_32x32x16_bf16(Uf[s], __builtin_bit_cast(pg8::bf16x8, lo[s]), aft, 0, 0, 0); }
        asm volatile("s_waitcnt lgkmcnt(0)" ::: "memory");
#pragma unroll
        for (int s = 0; s < 2; ++s) { v4u wf;
#pragma unroll
            for (int mm = 0; mm < 4; ++mm) { const int i0 = 8 * s + 2 * mm;
                const f32x2 ev = ((f32x2){d1[i0], d1[i0 + 1]} + (f32x2){aft[i0], aft[i0 + 1]}) + carry;
                wf[mm] = cvtpk(__builtin_amdgcn_exp2f(ev.x), __builtin_amdgcn_exp2f(ev.y)); }
            const pg8::bf16x8 wfrag = __builtin_bit_cast(pg8::bf16x8, wf);
#pragma unroll
            for (int db = 0; db < 2; ++db) { LAS unsigned char* ta = vt + troff + 16 * s * SB_ROWB + 64 * db;
                const v4i16_t v0 = __builtin_amdgcn_ds_read_tr16_b64_v4i16((LAS v4i16_t*)ta), v1 = __builtin_amdgcn_ds_read_tr16_b64_v4i16((LAS v4i16_t*)(ta + 8 * SB_ROWB));
                pg8::bf16x8 va; va[0] = v0[0]; va[1] = v0[1]; va[2] = v0[2]; va[3] = v0[3]; va[4] = v1[0]; va[5] = v1[1]; va[6] = v1[2]; va[7] = v1[3];
                oacc[db] = __builtin_amdgcn_mfma_f32_32x32x16_bf16(va, wfrag, oacc[db], 0, 0, 0); } }
        carry += tot;
        if (__ballot(carry > SB_STOP * 1.4426950408889634f) == 0ull) break;
    }
#undef SB_LOAD
    bf16* op = mix + (rowb + t0 + r) * DM + 512 + h * 64 + 4 * hh;
#pragma unroll
    for (int db = 0; db < 2; ++db)
#pragma unroll
        for (int ig = 0; ig < 4; ++ig) { u32x2 o; o.x = cvtpk(oacc[db][4 * ig], oacc[db][4 * ig + 1]); o.y = cvtpk(oacc[db][4 * ig + 2], oacc[db][4 * ig + 3]);
            *(u32x2*)(op + 32 * db + 8 * ig) = o; }
}

__device__ __forceinline__ unsigned f2key16(float x) {
    const unsigned bits = (unsigned)__builtin_bit_cast(unsigned short, (_Float16)x);
    const int m = ((int)(bits << 16)) >> 31;
    return bits ^ (0x8000u | ((unsigned)m & 0x7fffu));
}
__device__ __forceinline__ float relu_bits(float x) { const int xi = __builtin_bit_cast(int, x); return __builtin_bit_cast(float, xi > 0 ? xi : 0); }
__device__ __forceinline__ float relu2_f(float x) { return x + __builtin_fabsf(x); }
__device__ __forceinline__ unsigned wave_prefix_incl(unsigned v) {
    v += (unsigned)__builtin_amdgcn_update_dpp(0, (int)v, 0x111, 0xf, 0xf, false);
    v += (unsigned)__builtin_amdgcn_update_dpp(0, (int)v, 0x112, 0xf, 0xf, false);
    v += (unsigned)__builtin_amdgcn_update_dpp(0, (int)v, 0x114, 0xf, 0xf, false);
    v += (unsigned)__builtin_amdgcn_update_dpp(0, (int)v, 0x118, 0xf, 0xf, false);
    v += (unsigned)__builtin_amdgcn_update_dpp(0, (int)v, 0x142, 0xa, 0xf, false);
    v += (unsigned)__builtin_amdgcn_update_dpp(0, (int)v, 0x143, 0xc, 0xf, false);
    return v;
}
__device__ __forceinline__ unsigned half_min_u(unsigned v) {
#define HM_STEP(CTRL, RM) { const unsigned o_ = (unsigned)__builtin_amdgcn_update_dpp(-1, (int)v, CTRL, RM, 0xf, false); v = o_ < v ? o_ : v; }
    HM_STEP(0x111, 0xf) HM_STEP(0x112, 0xf) HM_STEP(0x114, 0xf) HM_STEP(0x118, 0xf) HM_STEP(0x142, 0xa)
#undef HM_STEP
    return v;
}
__device__ __forceinline__ int opq(int x) { asm volatile("" : "+v"(x)); return x; }
__device__ __forceinline__ void hist_zero(LAS unsigned* H, int lane) { unsigned z = 0u; asm volatile("" : "+v"(z)); *(LAS v4u*)(H + 4 * lane) = (v4u){z, z, z, z}; }
__device__ __forceinline__ void hist_find(const LAS unsigned* H, int lane_in, unsigned want, unsigned& bin, unsigned& n_above, unsigned& n_in) {
    const int lane = opq(lane_in), grp = 63 - lane;
    const v4u h4 = *(const LAS v4u*)(H + 4 * grp);
    const unsigned s = h4[0] + h4[1] + h4[2] + h4[3];
    const unsigned suf = wave_prefix_incl(s);
    const unsigned above = suf - s;
    const bool mine = (suf >= want) && (above < want);
    unsigned bl = 0, na = above, ni = 0;
    { unsigned cum = above; bool found = false;
#pragma unroll
      for (int i = 3; i >= 0; --i) { const unsigned hv = h4[i]; if (!found && cum + hv >= want) { bl = (unsigned)(4 * grp + i); na = cum; ni = hv; found = true; } cum += found ? 0u : hv; } }
    const unsigned long long mk = __ballot(mine);
    const int src = mk ? (int)__builtin_ctzll(mk) : 0;
    bin = (unsigned)__builtin_amdgcn_readlane((int)bl, src); n_above = (unsigned)__builtin_amdgcn_readlane((int)na, src); n_in = (unsigned)__builtin_amdgcn_readlane((int)ni, src);
}
template <int NB> struct BfBatch { pg8::bf16x8 f[NB][4]; };
struct DsaPre { pg8::bf16x8 Af[4]; u32x2 ww[4]; BfBatch<4> Ba; };
__device__ __forceinline__ void dsa_prefetch(Frame& F, const bf16* P, int b, int qg, DsaPre& pre) {
    const int lane = opq(F.lane), w = F.wave, r = lane & 31, hh = lane >> 5;
    const int t0 = qg * 8; const size_t rowb = (size_t)b * SEQ; const int nreal = (t0 + 8 + 31) >> 5;
    { const bf16* ap = P + (rowb + t0 + (r >> 2)) * PP + QI_OFF + (r & 3) * 64 + 8 * hh;
#pragma unroll
      for (int s = 0; s < 4; ++s) pre.Af[s] = *(const pg8::bf16x8*)(ap + 16 * s); }
#pragma unroll
    for (int bq = 0; bq < 4; ++bq) pre.ww[bq] = *(const u32x2*)(P + (rowb + t0 + 2 * bq + hh) * PP + WI_OFF);
    const bf16* kbase = F.KT + (size_t)b * 256 * 2048 + lane * 8;
#pragma unroll
    for (int i = 0; i < 4; ++i) { const int tq = w + 8 * i, tl = tq < nreal ? tq : nreal - 1; const bf16* kp = kbase + (size_t)tl * 2048;
#pragma unroll
        for (int s = 0; s < 4; ++s) pre.Ba.f[i][s] = *(const pg8::bf16x8*)(kp + 512 * s); }
}
#if defined(PROBE_SEL) && !defined(PROBE_LIGHT)
#define PSTAMP(id) do { if (F.wave == 0) { const unsigned now_ = (unsigned)__builtin_amdgcn_s_memtime(); if (F.lane == 0) { LAS unsigned* pw_ = (LAS unsigned*)(F.lds + 131072 + 640); pw_[id] += now_ - pw_[15]; pw_[15] = now_; } } } while (0)
#else
#define PSTAMP(id) do { } while (0)
#endif
__device__ __forceinline__ void dsa_unit(Frame& F, const bf16* P, bf16* mix, int b, int qg, DsaPre& pre, bool has_next, int qg_next) {
    PSTAMP(4);
    int lane = opq(F.lane); const int w = F.wave, r = lane & 31, hh = lane >> 5;
    const int t0 = qg * 8; const size_t rowb = (size_t)b * SEQ;
    LAS unsigned short* S = (LAS unsigned short*)(F.lds + RING_OFF);
    const int N = t0 + 8, nreal = (N + 31) >> 5, ntiles = ((N + 511) >> 9) << 4;
    pg8::bf16x8 Af[4];
#pragma unroll
    for (int s = 0; s < 4; ++s) Af[s] = pre.Af[s];
    unsigned mxp[2] = {0u, 0u};
    f32x2 wv[2][4];
#pragma unroll
    for (int p = 0; p < 2; ++p) { const u32x2 wa = pre.ww[2 * p], wb = pre.ww[2 * p + 1];
        wv[p][0] = (f32x2){bflo(wa.x) * 0.0625f, bflo(wb.x) * 0.0625f}; wv[p][1] = (f32x2){bfhi(wa.x) * 0.0625f, bfhi(wb.x) * 0.0625f};
        wv[p][2] = (f32x2){bflo(wa.y) * 0.0625f, bflo(wb.y) * 0.0625f}; wv[p][3] = (f32x2){bfhi(wa.y) * 0.0625f, bfhi(wb.y) * 0.0625f}; }
    const bf16* kbase = F.KT + (size_t)b * 256 * 2048 + lane * 8;
#define DSA_LOAD1(B, I, TL) do { const int tl_ = (TL); if (tl_ < nreal) { const bf16* kp_ = kbase + (size_t)tl_ * 2048; \
        _Pragma("unroll") for (int s_ = 0; s_ < 4; ++s_) (B).f[I][s_] = *(const pg8::bf16x8*)(kp_ + 512 * s_); } } while (0)
    {   BfBatch<4>& Ba = pre.Ba;
        for (int tb = w; tb < nreal; tb += 32) {
#pragma unroll
            for (int i = 0; i < 4; ++i) { const int tl = tb + 8 * i; if (tl < nreal) { const int key = tl * 32 + r; f32x16 acc;
#pragma unroll
                for (int z = 0; z < 16; ++z) acc[z] = 0.f;
#pragma unroll
                for (int s = 0; s < 4; ++s) acc = __builtin_amdgcn_mfma_f32_32x32x16_bf16(Af[s], Ba.f[i][s], acc, 0, 0, 0);
                DSA_LOAD1(Ba, i, tl + 32);
                const int pos = (key & ~511) + (key & 63) * 8 + ((key & 511) >> 6);
                const bool tail = tl * 32 + 31 > t0;
#pragma unroll
                for (int p = 0; p < 2; ++p) {
#define RELU1(x) relu_bits(x)
                    f32x2 s2 = wv[p][0] * (f32x2){RELU1(acc[8 * p + 0]), RELU1(acc[8 * p + 4])};
                    s2 = wv[p][1] * (f32x2){RELU1(acc[8 * p + 1]), RELU1(acc[8 * p + 5])} + s2;
                    s2 = wv[p][2] * (f32x2){RELU1(acc[8 * p + 2]), RELU1(acc[8 * p + 6])} + s2;
                    s2 = wv[p][3] * (f32x2){RELU1(acc[8 * p + 3]), RELU1(acc[8 * p + 7])} + s2;
#undef RELU1
                    const s16x2_t hb = __builtin_bit_cast(s16x2_t, __builtin_amdgcn_cvt_pkrtz(s2.x, s2.y));
                    const unsigned sm = __builtin_bit_cast(unsigned, (s16x2_t)(hb >> (short)15));
                    unsigned kp = __builtin_bit_cast(unsigned, hb) ^ ((sm & 0x7fff7fffu) | 0x80008000u);
                    if (tail) { asm volatile("" ::: "memory");
                        const unsigned mlo = (key <= t0 + 4 * p + hh) ? 0xffffu : 0u, mhi = (key <= t0 + 4 * p + 2 + hh) ? 0xffff0000u : 0u; kp &= (mlo | mhi); }
                    mxp[p] = __builtin_bit_cast(unsigned, __builtin_elementwise_max(__builtin_bit_cast(u16x2_t, mxp[p]), __builtin_bit_cast(u16x2_t, kp)));
                    S[(4 * p + hh) * 8192 + pos] = (unsigned short)kp; S[(4 * p + 2 + hh) * 8192 + pos] = (unsigned short)(kp >> 16); } } }
        }
    }
#undef DSA_LOAD1
    for (int tile = nreal + w; tile < ntiles; tile += 8) { const int key = tile * 32 + r; const int pos = (key & ~511) + (key & 63) * 8 + ((key & 511) >> 6);
#pragma unroll
        for (int bq = 0; bq < 4; ++bq) S[(2 * bq + hh) * 8192 + pos] = (unsigned short)0; }
    { LAS unsigned short* LB = (LAS unsigned short*)(F.lds + LB_OFF);
#pragma unroll
      for (int bq = 0; bq < 4; ++bq) { const unsigned v = half_min_u((bq & 1) ? (mxp[bq >> 1] >> 16) : (mxp[bq >> 1] & 0xffffu)); if ((lane & 31) == 31) LB[(2 * bq + hh) * 8 + w] = (unsigned short)v; } }
    __syncthreads();
    PSTAMP(5);
    lane = opq(lane);
    const int t = t0 + w, nch = (t >> 9) + 1;
    LAS unsigned short* Sw = S + w * 8192;
    LAS unsigned short* Lw = (LAS unsigned short*)(F.lds + LIST_OFF) + w * 256;
    LAS unsigned* H = (LAS unsigned*)(F.lds + HIST_OFF) + w * 256;
    int count = 0;
#ifndef DSA_REP_SEL
#define DSA_REP_SEL 1
#endif
#pragma unroll 1
    for (int rep_ = 0; rep_ < DSA_REP_SEL; ++rep_)
    if (t + 1 <= TOPK) {
        count = t + 1;
#pragma unroll
        for (int j = 0; j < 4; ++j) if (lane + 64 * j < count) Lw[lane + 64 * j] = (unsigned short)(lane + 64 * j);
    } else {
        count = TOPK;
        unsigned Lq;
        { const v4u lb4 = *(const LAS v4u*)((LAS unsigned short*)(F.lds + LB_OFF) + w * 8); unsigned mn = 0xffffu;
#pragma unroll
          for (int d = 0; d < 4; ++d) { const unsigned lo = lb4[d] & 0xffffu, hi = lb4[d] >> 16; mn = lo < mn ? lo : mn; mn = hi < mn ? hi : mn; }
          Lq = (unsigned)__builtin_amdgcn_readfirstlane((int)(mn ? mn : 1u)); }
        hist_zero(H, lane);
        for (int c = 0; c < nch; ++c) { const v4u x4 = *(const LAS v4u*)(Sw + c * 512 + 8 * lane);
#pragma unroll
            for (int d = 0; d < 4; ++d) { const unsigned x = x4[d], xl = x & 0xffffu, xh = x >> 16;
                if (xl >= Lq) __hip_atomic_fetch_add(H + (xl >> 8), 1u, __ATOMIC_RELAXED, __HIP_MEMORY_SCOPE_WAVEFRONT);
                if (xh >= Lq) __hip_atomic_fetch_add(H + (xh >> 8), 1u, __ATOMIC_RELAXED, __HIP_MEMORY_SCOPE_WAVEFRONT); } }
        asm volatile("s_waitcnt lgkmcnt(0)" ::: "memory");
        unsigned b1, above1, in1; hist_find(H, lane, (unsigned)TOPK, b1, above1, in1);
        PSTAMP(11);
        asm volatile("s_waitcnt lgkmcnt(0)" ::: "memory");
        hist_zero(H, lane);
        for (int c = 0; c < nch; ++c) { const v4u x4 = *(const LAS v4u*)(Sw + c * 512 + 8 * lane);
#pragma unroll
            for (int d = 0; d < 4; ++d) { const unsigned x = x4[d], xl = x & 0xffffu, xh = x >> 16;
                if ((xl >> 8) == b1) __hip_atomic_fetch_add(H + (xl & 0xffu), 1u, __ATOMIC_RELAXED, __HIP_MEMORY_SCOPE_WAVEFRONT);
                if ((xh >> 8) == b1) __hip_atomic_fetch_add(H + (xh & 0xffu), 1u, __ATOMIC_RELAXED, __HIP_MEMORY_SCOPE_WAVEFRONT); } }
        asm volatile("s_waitcnt lgkmcnt(0)" ::: "memory");
        unsigned b2, above2, in2; hist_find(H, lane, (unsigned)TOPK - above1, b2, above2, in2);
        PSTAMP(12);
        const unsigned T = (b1 << 8) | b2, need = (unsigned)TOPK - above1 - above2;
        const unsigned n_gt = above1 + above2;
        const bool ordered = in2 > need;
        const unsigned Tsel = ordered ? T + 1u : T;
        unsigned ebase = 0u;
        for (int c = 0; c < nch; ++c) { const v4u x4 = *(const LAS v4u*)(Sw + c * 512 + 8 * lane);
#pragma unroll
            for (int e = 0; e < 8; ++e) { const unsigned x = (e & 1) ? (x4[e >> 1] >> 16) : (x4[e >> 1] & 0xffffu);
                const bool ge = x >= Tsel; const unsigned long long mge = __ballot(ge);
                if (mge) { const unsigned rk = __builtin_amdgcn_mbcnt_hi((unsigned)(mge >> 32), __builtin_amdgcn_mbcnt_lo((unsigned)mge, ebase));
                    if (ge) Lw[rk] = (unsigned short)(c * 512 + e * 64 + lane);
                    ebase += (unsigned)__builtin_popcountll(mge); } } }
        if (ordered) { unsigned eqc = 0u;
            for (int c = 0; c < nch && eqc < need; ++c) { const v4u x4 = *(const LAS v4u*)(Sw + c * 512 + 8 * lane);
#pragma unroll
                for (int e = 0; e < 8; ++e) { const unsigned x = (e & 1) ? (x4[e >> 1] >> 16) : (x4[e >> 1] & 0xffffu);
                    const bool eq = (x == T); const unsigned long long meq = __ballot(eq);
                    if (meq) { const unsigned rk = eqc + __builtin_amdgcn_mbcnt_hi((unsigned)(meq >> 32), __builtin_amdgcn_mbcnt_lo((unsigned)meq, 0u));
                        if (eq && rk < need) Lw[n_gt + rk] = (unsigned short)(c * 512 + e * 64 + lane);
                        eqc += (unsigned)__builtin_popcountll(meq); } } } }
    }
    asm volatile("s_waitcnt lgkmcnt(0)" ::: "memory");
    PSTAMP(6);
    {
        lane = opq(lane);
        const int hcol = lane & 15, g = lane >> 4, q4 = (lane & 15) >> 2, p4 = lane & 3;
        LAS unsigned char* vimg = (LAS unsigned char*)Sw;
        pg8::bf16x8 Qf[2];
        { const bf16* qp = P + (rowb + t) * PP + QA_OFF + (hcol & 7) * 64 + 8 * g; Qf[0] = *(const pg8::bf16x8*)qp; Qf[1] = *(const pg8::bf16x8*)(qp + 32); }
        f32x4 lg[16]; v4u vrA[8], vrB[8];
        pg8::bf16x8 KfA[4][2], KfB[4][2];
#define DSA_KLOAD(KF, QT) do { _Pragma("unroll") for (int aa = 0; aa < 4; ++aa) { const int jp = (4 * (QT) + aa) * 16 + hcol; const int idx = jp < count ? (int)Lw[jp] : 0; \
            const bf16* kp = P + (rowb + idx) * PP + KA_OFF + 8 * g; KF[aa][0] = *(const pg8::bf16x8*)kp; KF[aa][1] = *(const pg8::bf16x8*)(kp + 32); } } while (0)
#define DSA_KMMA(KF, QT) do { asm volatile("" : "+v"(KF[0][0]), "+v"(KF[0][1]), "+v"(KF[1][0]), "+v"(KF[1][1]), "+v"(KF[2][0]), "+v"(KF[2][1]), "+v"(KF[3][0]), "+v"(KF[3][1]) :: "memory"); \
            _Pragma("unroll") for (int aa = 0; aa < 4; ++aa) { f32x4 acc = {0.f, 0.f, 0.f, 0.f}; \
                acc = __builtin_amdgcn_mfma_f32_16x16x32_bf16(KF[aa][0], Qf[0], acc, 0, 0, 0); acc = __builtin_amdgcn_mfma_f32_16x16x32_bf16(KF[aa][1], Qf[1], acc, 0, 0, 0); \
                lg[4 * (QT) + aa] = acc; } } while (0)
#define DSA_VLOAD(VR, CK) do { _Pragma("unroll") for (int i = 0; i < 8; ++i) { const int c8 = lane + 64 * i, row = c8 >> 3, ch = c8 & 7; const int jp = 64 * (CK) + row; const int idx = jp < count ? (int)Lw[jp] : 0; \
            VR[i] = *(const v4u*)(P + (rowb + idx) * PP + VA_OFF + 8 * ch); } } while (0)
        DSA_KLOAD(KfA, 0); DSA_KLOAD(KfB, 1);
        DSA_KMMA(KfA, 0); DSA_KLOAD(KfA, 2);
        DSA_KMMA(KfB, 1); DSA_KLOAD(KfB, 3);
        DSA_VLOAD(vrA, 0);
        DSA_KMMA(KfA, 2); DSA_VLOAD(vrB, 1);
        DSA_KMMA(KfB, 3);
#undef DSA_KLOAD
#undef DSA_KMMA
        PSTAMP(9);
        if (count < TOPK) {
#pragma unroll
            for (int aa = 0; aa < 16; ++aa)
#pragma unroll
                for (int i = 0; i < 4; ++i) if ((16 * aa + 4 * g + i) >= count) lg[aa][i] = -INFINITY; }
        float mx = -INFINITY;
#pragma unroll
        for (int aa = 0; aa < 16; ++aa) { lg[aa] = lg[aa] * 0.18033688011112042f; mx = fmaxf(fmaxf(mx, lg[aa][0]), lg[aa][1]); mx = fmaxf(fmaxf(mx, lg[aa][2]), lg[aa][3]); }
        mx = xmax16(mx); mx = xmax32(mx);
        f32x4 sm4 = {0.f, 0.f, 0.f, 0.f};
#pragma unroll
        for (int aa = 0; aa < 16; ++aa) { const f32x4 d = lg[aa] - mx; f32x4 pv; pv[0] = __builtin_amdgcn_exp2f(d[0]); pv[1] = __builtin_amdgcn_exp2f(d[1]); pv[2] = __builtin_amdgcn_exp2f(d[2]); pv[3] = __builtin_amdgcn_exp2f(d[3]); lg[aa] = pv; sm4 += pv; }
        float sm = (sm4[0] + sm4[1]) + (sm4[2] + sm4[3]);
        sm = xsum16(sm); sm = xsum32(sm);
        const float inv = 1.0f / sm;
        PSTAMP(10);
        f32x4 oacc[4];
#pragma unroll
        for (int db = 0; db < 4; ++db) oacc[db] = (f32x4){0.f, 0.f, 0.f, 0.f};
        const int troff = (4 * g + q4) * 160 + 8 * p4;
#define DSA_VCHUNK(VR, CK) do { constexpr int ck = (CK); \
            asm volatile("" : "+v"(VR[0]), "+v"(VR[1]), "+v"(VR[2]), "+v"(VR[3]), "+v"(VR[4]), "+v"(VR[5]), "+v"(VR[6]), "+v"(VR[7]) :: "memory"); \
            _Pragma("unroll") for (int i = 0; i < 8; ++i) { const int c8 = lane + 64 * i, row = c8 >> 3, ch = c8 & 7; *(LAS v4u*)(vimg + row * 160 + ch * 16) = VR[i]; } \
            if (ck + 2 < 4) DSA_VLOAD(VR, ck + 2); \
            DSA_VMMA(ck); } while (0)
#define DSA_VMMA(ck) do { \
                asm volatile("s_waitcnt lgkmcnt(0)" ::: "memory"); \
    _Pragma("unroll") \
                for (int ks = 0; ks < 2; ++ks) { \
                    v4u pw;                                                         \
                    { float e0[4], e1[4]; \
    _Pragma("unroll") \
                      for (int i = 0; i < 4; ++i) { e0[i] = 0.f; e1[i] = 0.f; } \
    _Pragma("unroll") \
                      for (int aa = 0; aa < 16; aa += 2) if (aa == 4 * ck + 2 * ks) { \
    _Pragma("unroll") \
                          for (int i = 0; i < 4; ++i) { e0[i] = lg[aa][i]; e1[i] = lg[aa + 1][i]; } } \
                      pw[0] = cvtpk(e0[0], e0[1]); pw[1] = cvtpk(e0[2], e0[3]); pw[2] = cvtpk(e1[0], e1[1]); pw[3] = cvtpk(e1[2], e1[3]); } \
                    const pg8::bf16x8 pfrag = __builtin_bit_cast(pg8::bf16x8, pw); \
    _Pragma("unroll") \
                    for (int db = 0; db < 4; ++db) { LAS unsigned char* ta = vimg + troff + (32 * ks) * 160 + 32 * db; \
                        const v4i16_t v0 = __builtin_amdgcn_ds_read_tr16_b64_v4i16((LAS v4i16_t*)ta), v1 = __builtin_amdgcn_ds_read_tr16_b64_v4i16((LAS v4i16_t*)(ta + 16 * 160)); \
                        pg8::bf16x8 va; va[0] = v0[0]; va[1] = v0[1]; va[2] = v0[2]; va[3] = v0[3]; va[4] = v1[0]; va[5] = v1[1]; va[6] = v1[2]; va[7] = v1[3]; \
                        oacc[db] = __builtin_amdgcn_mfma_f32_16x16x32_bf16(va, pfrag, oacc[db], 0, 0, 0); } } \
                asm volatile("s_waitcnt lgkmcnt(0)" ::: "memory"); \
        } while (0)
        DSA_VCHUNK(vrA, 0); DSA_VCHUNK(vrB, 1); DSA_VCHUNK(vrA, 2); DSA_VCHUNK(vrB, 3);
#undef DSA_VCHUNK
#undef DSA_VMMA
#undef DSA_VLOAD
        if (hcol < 8) { bf16* op = mix + (rowb + t) * DM + hcol * 64 + 4 * g;
#pragma unroll
            for (int db = 0; db < 4; ++db) { u32x2 o; o.x = cvtpk(oacc[db][0] * inv, oacc[db][1] * inv); o.y = cvtpk(oacc[db][2] * inv, oacc[db][3] * inv); *(u32x2*)(op + 16 * db) = o; } }
    }
    PSTAMP(7);
    dsa_prefetch(F, P, b, qg_next, pre);
    asm volatile("s_waitcnt lgkmcnt(0)" ::: "memory"); __builtin_amdgcn_s_barrier(); asm volatile("" ::: "memory");
    PSTAMP(8);
}

constexpr int SP_PITCH = 320, SP_IMG = 128 * SP_PITCH;
constexpr int SP_SPITCH = 272, SP_STAGE = 128 * SP_SPITCH;
__device__ __forceinline__ void spatial_chunk(Frame& F, int li, int ch, const bf16* U, const bf16* V, bf16* UO) {
    LAS unsigned char* img = F.lds + RING_OFF;
    LAS unsigned char* stg = F.lds + RING_OFF + 2 * SP_IMG;
    LAS float* NB = (LAS float*)(F.lds + RING_OFF + 2 * SP_IMG + SP_STAGE); LAS float* RS = NB + 128;
    const size_t r0 = (size_t)ch * 128; const int lane = F.lane;
    { const int row = F.tid >> 2, part = F.tid & 3; const f32x2* sp = (const f32x2*)F.stats + (r0 + row) * 32 + part * 8; float s = 0.f, q = 0.f;
#pragma unroll
      for (int k = 0; k < 8; ++k) { const f32x2 a = sp[k]; s += a.x; q += a.y; }
      s += __shfl_xor(s, 1); s += __shfl_xor(s, 2); q += __shfl_xor(q, 1); q += __shfl_xor(q, 2);
      if (part == 0) { const float mu = s * (1.f / CWID); const float var = fmaxf(q * (1.f / CWID) - mu * mu, 0.f); const float rs = 1.0f / sqrtf(var + EPS); RS[row] = rs; NB[row] = -mu * rs; } }
    const int cb = F.wave >> 1, tk0 = F.wave & 1, tk1 = 3 - tk0, r = lane & 31, hh = lane >> 5, q4 = (lane & 15) >> 2, p4 = lane & 3, g1 = (lane >> 4) & 1;
    const int troff = (8 * hh + q4) * SP_PITCH + (32 * cb + 16 * g1 + 4 * p4) * 2;
    const int prow = F.tid >> 4, pcol = 8 * (F.tid & 15);
    const size_t tb = (size_t)ch * 16 * 16384 + prow * 128 + pcol; const bf16* vp = V + tb; const bf16* up = U + tb; bf16* uop = UO + tb;
    const float* gvp = F.vgain + li * CWID + 32 * cb + 4 * hh; const float* bvp = F.vbias + li * CWID + 32 * cb + 4 * hh;
    const float* bsp = F.spatial_b + li * 16 * 128; const float* wsp = F.WSUM + li * 16 * 128;
    const bf16* wb0 = F.Wsp + (size_t)li * 16 * 128 * 128 + (32 * tk0 + r) * 128 + 8 * hh; const bf16* wb1 = F.Wsp + (size_t)li * 16 * 128 * 128 + (32 * tk1 + r) * 128 + 8 * hh;
    v4u vreg[4], ureg[4]; pg8::bf16x8 bf0[4], bf1[8]; float bs[2], ws[2];
#pragma unroll
    for (int it = 0; it < 4; ++it) vreg[it] = *(const v4u*)(vp + it * 32 * 128);
#pragma unroll
    for (int ks = 0; ks < 4; ++ks) bf0[ks] = *(const pg8::bf16x8*)(wb0 + 16 * ks);
#pragma unroll
    for (int ks = 0; ks < 8; ++ks) bf1[ks] = *(const pg8::bf16x8*)(wb1 + 16 * ks);
    bs[0] = bsp[32 * tk0 + r]; bs[1] = bsp[32 * tk1 + r]; ws[0] = wsp[32 * tk0 + r]; ws[1] = wsp[32 * tk1 + r];
#pragma unroll
    for (int it = 0; it < 4; ++it) ureg[it] = *(const v4u*)(up + it * 32 * 128);
    __syncthreads();
#pragma unroll 1
    for (int g = 0; g < 16; ++g) {
        const int c0 = g * 128, gn = g < 15 ? g + 1 : 15; LAS unsigned char* buf = img + (g & 1) * SP_IMG;
        f32x4 gv[4], bv[4];
#pragma unroll
        for (int ig = 0; ig < 4; ++ig) { gv[ig] = *(const f32x4*)(gvp + c0 + 8 * ig); bv[ig] = *(const f32x4*)(bvp + c0 + 8 * ig); }
#pragma unroll
        for (int it = 0; it < 4; ++it) { const int s = prow + 32 * it; const v4u raw = vreg[it]; const float rs = RS[s], nb = NB[s];
            v4u o;
            o.x = cvtpk(__builtin_fmaf(bflo(raw.x), rs, nb), __builtin_fmaf(bfhi(raw.x), rs, nb)); o.y = cvtpk(__builtin_fmaf(bflo(raw.y), rs, nb), __builtin_fmaf(bfhi(raw.y), rs, nb));
            o.z = cvtpk(__builtin_fmaf(bflo(raw.z), rs, nb), __builtin_fmaf(bfhi(raw.z), rs, nb)); o.w = cvtpk(__builtin_fmaf(bflo(raw.w), rs, nb), __builtin_fmaf(bfhi(raw.w), rs, nb));
            *(LAS v4u*)(buf + s * SP_PITCH + pcol * 2) = o; }
#pragma unroll
        for (int it = 0; it < 4; ++it) vreg[it] = *(const v4u*)(vp + it * 32 * 128 + gn * 16384);
        __syncthreads();
        f32x16 acc[2];
#pragma unroll
        for (int x = 0; x < 2; ++x)
#pragma unroll
            for (int i = 0; i < 16; ++i) acc[x][i] = 0.f;
#pragma unroll
        for (int ks = 0; ks < 8; ++ks) { LAS unsigned char* ta = buf + troff + 16 * ks * SP_PITCH;
            const v4i16_t v0 = __builtin_amdgcn_ds_read_tr16_b64_v4i16((LAS v4i16_t*)ta), v1 = __builtin_amdgcn_ds_read_tr16_b64_v4i16((LAS v4i16_t*)(ta + 4 * SP_PITCH));
            pg8::bf16x8 va; va[0] = v0[0]; va[1] = v0[1]; va[2] = v0[2]; va[3] = v0[3]; va[4] = v1[0]; va[5] = v1[1]; va[6] = v1[2]; va[7] = v1[3];
            if (ks < 4) acc[0] = __builtin_amdgcn_mfma_f32_32x32x16_bf16(va, bf0[ks], acc[0], 0, 0, 0);
            acc[1] = __builtin_amdgcn_mfma_f32_32x32x16_bf16(va, bf1[ks], acc[1], 0, 0, 0); }
        { const size_t wo = (size_t)gn * 128 * 128;
#pragma unroll
          for (int ks = 0; ks < 4; ++ks) bf0[ks] = *(const pg8::bf16x8*)(wb0 + wo + 16 * ks);
#pragma unroll
          for (int ks = 0; ks < 8; ++ks) bf1[ks] = *(const pg8::bf16x8*)(wb1 + wo + 16 * ks); }
#pragma unroll
        for (int x = 0; x < 2; ++x) { const int t = 32 * (x ? tk1 : tk0) + r; const float wsx = ws[x], bsx = bs[x];
#pragma unroll
            for (int ig = 0; ig < 4; ++ig) { const f32x4 a = {acc[x][4 * ig + 0], acc[x][4 * ig + 1], acc[x][4 * ig + 2], acc[x][4 * ig + 3]}; const f32x4 e = gv[ig] * a + (bv[ig] * wsx + bsx);
                u32x2 o; o.x = cvtpk(e[0], e[1]); o.y = cvtpk(e[2], e[3]);
                *(LAS u32x2*)(stg + t * SP_SPITCH + (32 * cb + 8 * ig + 4 * hh) * 2) = o; } }
        bs[0] = bsp[gn * 128 + 32 * tk0 + r]; bs[1] = bsp[gn * 128 + 32 * tk1 + r]; ws[0] = wsp[gn * 128 + 32 * tk0 + r]; ws[1] = wsp[gn * 128 + 32 * tk1 + r];
        __syncthreads();
#pragma unroll
        for (int it = 0; it < 4; ++it) { const int t = prow + 32 * it; const v4u sv = *(const LAS v4u*)(stg + t * SP_SPITCH + pcol * 2); const v4u uv = ureg[it];
            v4u o; o.x = cvtpk(bflo(uv.x) * bflo(sv.x), bfhi(uv.x) * bfhi(sv.x)); o.y = cvtpk(bflo(uv.y) * bflo(sv.y), bfhi(uv.y) * bfhi(sv.y));
            o.z = cvtpk(bflo(uv.z) * bflo(sv.z), bfhi(uv.z) * bfhi(sv.z)); o.w = cvtpk(bflo(uv.w) * bflo(sv.w), bfhi(uv.w) * bfhi(sv.w));
            *(v4u*)(uop + it * 32 * 128 + g * 16384) = o; }
#pragma unroll
        for (int it = 0; it < 4; ++it) ureg[it] = *(const v4u*)(up + it * 32 * 128 + gn * 16384);
    }
    __syncthreads();
}

#ifdef DBG_DUMB_SP
__device__ __forceinline__ void dumb_stats(Frame& F, const bf16* V) {
    const int gw = F.c * NWAVES + F.wave, NGW = F.G * NWAVES;
    for (int m = gw; m < M; m += NGW) { float s = 0.f, q = 0.f;
        for (int c = F.lane; c < CWID; c += 64) { const float x = bflo((unsigned)V[(size_t)m * CWID + c]); s += x; q += x * x; }
        s = wave_sum(s); q = wave_sum(q); const float mu = s / CWID, var = fmaxf(q / CWID - mu * mu, 0.f);
        if (F.lane == 0) { F.stats[(size_t)m * 2] = mu; F.stats[(size_t)m * 2 + 1] = 1.0f / sqrtf(var + EPS); } }
}
__device__ __forceinline__ void dumb_spatial(Frame& F, int li, bf16* U, const bf16* V) {
    const size_t total = (size_t)M * CWID;
    for (size_t e = (size_t)F.c * 512 + F.tid; e < total; e += (size_t)F.G * 512) {
        const size_t row = e / CWID; const int c = (int)(e % CWID), g = c >> 7, t = (int)(row & 127); const size_t rb = row - t;
        float acc = 0.f;
        for (int s = 0; s <= t; ++s) { const float x = bflo((unsigned)V[(rb + s) * CWID + c]); const float mu = F.stats[(rb + s) * 2], rs = F.stats[(rb + s) * 2 + 1];
            const float vn = (x - mu) * rs * F.vgain[li * CWID + c] + F.vbias[li * CWID + c];
            acc += F.spatial_w[(((size_t)li * 16 + g) * 128 + t) * 128 + s] * vn; }
        const float sv = acc + F.spatial_b[(li * 16 + g) * 128 + t];
        const float u = bflo((unsigned)U[e]);
        U[e] = (bf16)(cvtpk(u * sv, 0.f) & 0xffffu);
    }
}
#endif

#ifdef DBG_DUMB_GEMM
template <int MODE> __device__ __forceinline__ void dumb_gemm(Frame& F, const bf16* A, int lda, const float* W, int ldw, int K, int N, bf16* O, int ldo) {
    const size_t total = (size_t)(M / 4) * N;
    for (size_t idx = (size_t)F.c * 512 + F.tid; idx < total; idx += (size_t)F.G * 512) {
        const int mb = (int)(idx / N), n = (int)(idx % N);
        float acc[4] = {0.f, 0.f, 0.f, 0.f}, acu[4] = {0.f, 0.f, 0.f, 0.f};
        for (int k = 0; k < K; ++k) { const float w = W[(size_t)k * ldw + n]; const float w2 = MODE == 2 ? W[(size_t)k * ldw + N + n] : 0.f;
#pragma unroll
            for (int i = 0; i < 4; ++i) { const float a = bflo((unsigned)A[(size_t)(4 * mb + i) * lda + k]); acc[i] += a * w; if (MODE == 2) acu[i] += a * w2; } }
#pragma unroll
        for (int i = 0; i < 4; ++i) { const size_t row = (size_t)(4 * mb + i); float v = acc[i]; size_t off;
            if (MODE == 0) off = row * ldo + n;
            else if (MODE == 1) off = row * ldo + (n < 960 ? n : (n < 964 ? 2496 + (n - 960) : n - 4));
            else if (MODE == 2) { v = v / (1.0f + expf(-v)) * acu[i]; off = row * ldo + n; }
            else { const float y = 0.7978845608028654f * (v + 0.044715f * v * v * v); v = 0.5f * v * (1.0f + tanhf(y)); off = (n < 2048 ? 0 : (size_t)M * 2048) + row * 2048 + (n & 2047); }
            O[off] = (bf16)(cvtpk(v, 0.f) & 0xffffu); }
    }
}
#endif
struct Args { const float* in[12]; float* out; unsigned char* ws; int ph_lo, ph_hi; };
__global__ void __launch_bounds__(NWAVES * 64, 2) fwd_kernel(Args args) {
    extern __shared__ __attribute__((aligned(16))) unsigned char lds[];
    Frame F;
    F.lds = (LAS unsigned char*)lds;
    F.MISC = (volatile LAS unsigned*)(F.lds + MISC_OFF);
    F.tid = threadIdx.x; F.lane = F.tid & 63; F.wave = __builtin_amdgcn_readfirstlane(F.tid >> 6);
    F.G = gridDim.x; F.c = blockIdx.x;
    unsigned char* ws = args.ws;
    F.ctl = (gu32*)(ws + WS_CTL);
    F.x = args.in[0]; F.gains = args.in[1]; F.w_in_even = args.in[2]; F.w_out_even = args.in[3]; F.w_in_odd = args.in[4]; F.spatial_w = args.in[5]; F.spatial_b = args.in[6];
    F.vgain = args.in[7]; F.vbias = args.in[8]; F.w_out_odd = args.in[9]; F.w_ffn_in = args.in[10]; F.w_ffn_out = args.in[11]; F.out = args.out;
    F.WinE = (bf16*)(ws + WS_WINE); F.WoutE = (bf16*)(ws + WS_WOUTE); F.WinO = (bf16*)(ws + WS_WINO); F.WoutO = (bf16*)(ws + WS_WOUTO); F.Wffi = (bf16*)(ws + WS_WFFI); F.Wffo = (bf16*)(ws + WS_WFFO); F.Wsp = (bf16*)(ws + WS_WSP);
    F.stats = (float*)(ws + WS_STATS); F.A = (bf16*)(ws + WS_A); F.R1 = (bf16*)(ws + WS_R1); F.Y = (bf16*)(ws + WS_Y); F.MIX = (bf16*)args.out; F.KT = (bf16*)(ws + WS_KT); F.RS = (float*)(ws + WS_CTL + 512 * 1024); F.WSUM = (float*)(ws + WS_CTL + 768 * 1024);
    for (int u = F.tid; u < (LDS_BYTES - LDSCTL_OFF) / 4; u += NWAVES * 64) ((LAS unsigned*)(F.lds + LDSCTL_OFF))[u] = 0u;
    __syncthreads();
#ifdef PROBE_SEL
    const unsigned long long probe_c0 = __builtin_amdgcn_s_memtime(), probe_w0 = __builtin_amdgcn_s_memrealtime();
    if (F.tid == 0) ((LAS unsigned*)(F.lds + 131072 + 640))[15] = (unsigned)probe_c0;
#endif
    const bool dry = args.ph_lo >= 1000;
    const int lo = dry ? args.ph_lo - 1000 : args.ph_lo, hi = dry ? args.ph_hi - 1000 : args.ph_hi;
    XcdBarrier bar; bar.bar = (unsigned*)(F.ctl + CW_BAR); bar.x = 0; bar.st = nullptr;
    if (hi - lo > 1) bar = xcd_barrier_post((unsigned*)(F.ctl + CW_BAR), F.MISC + 8);
#define IN(k) (lo <= (k) && (k) < hi)
#define REFRESH() do { int l_; asm volatile("v_mbcnt_lo_u32_b32 %0, -1, 0\n\tv_mbcnt_hi_u32_b32 %0, -1, %0" : "=v"(l_)); F.lane = l_; F.tid = (F.wave << 6) | l_; } while (0)
#define SEAM_IDX(k) ((k) == 0 ? 14 : (((k) - 1) % 14))
#define SEAM(k) do { if (IN(k) && IN((k) + 1)) { PSTAMP(48 + SEAM_IDX(k)); xcd_barrier(bar); PSTAMP(16 + SEAM_IDX(k)); } } while (0)

    #ifndef NO_P0
#ifdef DBG_DUMB_SP
    if (lo >= 100) { dumb_stats(F, F.R1 + (size_t)M * CWID); return; }
#endif
    if (IN(0)) { REFRESH(); p0_prologue(F); SEAM(0); }
#endif
    for (int L = 0; L < DEPTH; ++L) {
        const int pb = 1 + 7 * L, li = L >> 1;
        const float* gl = F.gains + (size_t)L * 4 * DM;
        if ((L & 1) == 0) {
            if (IN(pb + 0)) {
                pg8::Gemm g{F.A, F.WinE + (size_t)li * PP * DM, M, PP, DM}; pg8::StaticOrder S; S.init(M, PP, F.G, F.c);
                pg8::EpiBf16R E{F.R1, PP, F.RS, F.KT};
#if defined(DBG_DUMB_GEMM) && (DBG_DUMB_GEMM & (1 << 1))
                dumb_gemm<1>(F, F.A, DM, F.w_in_even + (size_t)li * DM * EVEN_IN, EVEN_IN, DM, EVEN_IN, F.R1, PP);
#else
                pg8::gemm_phase<pg8::EpiBf16R, pg8::StaticOrder, PG8_ALIGN, PG8_SP2>(F.lds + RING_OFF, g, S, E, F.wave);
#endif
                SEAM(pb + 0);
            }
            if (IN(pb + 1)) {
                REFRESH();
                if (F.G == 256) {
                    const int b = (F.c & 7) >> 1, j = ((F.c & 1) << 5) | (F.c >> 3);
                    #ifndef NO_DSA
                    { DsaPre pre; PSTAMP(14); dsa_prefetch(F, F.R1, b, j, pre);
#pragma unroll 1
                      for (int k = 0; k < 16; ++k) { const int kn = k + 1; const int kq = kn < 16 ? kn : 15; dsa_unit(F, F.R1, F.MIX, b, (k & 1) ? (64 * k + 63 - j) : (64 * k + j), pre, kn < 16, (kq & 1) ? (64 * kq + 63 - j) : (64 * kq + j)); } }
#ifdef DUP_DSA
                    for (int k = 0; k < 16; ++k) dsa_unit(F, F.R1, F.MIX, b, (k & 1) ? (64 * k + 63 - j) : (64 * k + j));
#endif
#endif
                    #ifndef NO_SB
                    REFRESH();
#ifdef SB_NAIVE
                    for (int task = F.c * NWAVES + F.wave; task < 4096; task += 256 * NWAVES) sb_task(F.R1, F.MIX, task, F.lane);
#else
#ifdef SB_STATIC
                    for (int u = F.c * NWAVES + F.wave; u < 8192; u += 256 * NWAVES) { SbPre sp_; sb_prefetch(F, F.R1, u, sp_); sb_unit(F, F.R1, F.MIX, u, sp_, u); }
#else
                    {
                        unsigned* qctr = (unsigned*)(F.ctl + SBQ_OFF + (li * 8 + (F.c & 7)) * 32); const int hq = F.c & 7;
#define SBQ_UNIT(q_) (2048 * ((q_) & 3) + 8 * (8 * ((255 - ((q_) >> 2)) >> 3) + hq) + ((255 - ((q_) >> 2)) & 7))
                        unsigned qv = 0u; if (F.lane == 0) qv = __hip_atomic_fetch_add(qctr, 1u, __ATOMIC_RELAXED, __HIP_MEMORY_SCOPE_AGENT);
                        int q = __builtin_amdgcn_readfirstlane((int)qv);
                        if (q < 1024) { SbPre spre; int u = SBQ_UNIT(q); sb_prefetch(F, F.R1, u, spre);
                            unsigned qn = 0u; if (F.lane == 0) qn = __hip_atomic_fetch_add(qctr, 1u, __ATOMIC_RELAXED, __HIP_MEMORY_SCOPE_AGENT);
                            for (;;) { const int qnv = __builtin_amdgcn_readfirstlane((int)qn); const bool hn = qnv < 1024; const int un = hn ? SBQ_UNIT(qnv) : u;
                                qn = 0u; if (hn && F.lane == 0) qn = __hip_atomic_fetch_add(qctr, 1u, __ATOMIC_RELAXED, __HIP_MEMORY_SCOPE_AGENT);
                                sb_unit(F, F.R1, F.MIX, u, spre, un);
                                if (!hn) break;
                                u = un; } } }
#undef SBQ_UNIT
#endif
#ifdef DUP_SB
                    for (int u = F.c * NWAVES + F.wave; u < 8192; u += 256 * NWAVES) { SbPre sp_; sb_prefetch(F, F.R1, u, sp_); sb_unit(F, F.R1, F.MIX, u, sp_, u); }
#endif
#endif
#endif
                }
                SEAM(pb + 1);
            }
            if (IN(pb + 2)) {
                pg8::Gemm g{F.MIX, F.WoutE + (size_t)li * DM * DM, M, DM, DM}; pg8::StaticOrder S; S.init(M, DM, F.G, F.c);
                pg8::EpiBf16<0> E{F.Y, DM, nullptr, 0, 0, 1.f};
#if defined(DBG_DUMB_GEMM) && (DBG_DUMB_GEMM & (1 << 2))
                dumb_gemm<0>(F, F.A, DM, F.w_out_even + (size_t)li * DM * DM, DM, DM, DM, F.Y, DM);
#else
                pg8::gemm_phase<pg8::EpiBf16<0>, pg8::StaticOrder, PG8_ALIGN, PG8_SP2>(F.lds + RING_OFF, g, S, E, F.wave);
#endif
                SEAM(pb + 2);
            }
        } else {
            bf16* U = F.R1; bf16* V = F.R1 + (size_t)M * CWID;
            if (IN(pb + 0)) {
                pg8::Gemm g{F.A, F.WinO + (size_t)li * 4096 * DM, M, 4096, DM}; pg8::StaticOrder S; S.init(M, 4096, F.G, F.c);
                pg8::EpiGeluStats E{U, V, F.stats, F.RS};
#if defined(DBG_DUMB_GEMM) && (DBG_DUMB_GEMM & (1 << 3))
                dumb_gemm<3>(F, F.A, DM, F.w_in_odd + (size_t)li * DM * 4096, 4096, DM, 4096, F.R1, 0);
#else
                pg8::gemm_phase<pg8::EpiGeluStats, pg8::StaticOrder, PG8_ALIGN, PG8_SP2>(F.lds + RING_OFF, g, S, E, F.wave);
#endif
                SEAM(pb + 0);
            }
            if (IN(pb + 1)) {
                REFRESH();
#ifndef NO_SP
#ifdef DBG_DUMB_SP
                dumb_spatial(F, li, U, V);
#else
                for (int ch = F.c; ch < 256; ch += F.G) spatial_chunk(F, li, ch, U, V, dry ? (bf16*)F.out : U);
#endif
#endif
                SEAM(pb + 1);
            }
            if (IN(pb + 2)) {
                pg8::Gemm g{U, F.WoutO + (size_t)li * DM * CWID, M, DM, CWID, 128, 32768}; pg8::StaticOrder S; S.init(M, DM, F.G, F.c);
                pg8::EpiBf16<0> E{F.Y, DM, nullptr, 0, 0, 1.f};
#if defined(DBG_DUMB_GEMM) && (DBG_DUMB_GEMM & (1 << 4))
                dumb_gemm<0>(F, U, CWID, F.w_out_odd + (size_t)li * CWID * DM, DM, CWID, DM, F.Y, DM);
#else
                pg8::gemm_phase<pg8::EpiBf16<0>, pg8::StaticOrder, PG8_ALIGN, PG8_SP2>(F.lds + RING_OFF, g, S, E, F.wave);
#endif
                SEAM(pb + 2);
            }
        }
#ifndef NO_THIN
        if (IN(pb + 3)) { REFRESH(); thin_phase<false, false>(F, gl + DM, dry);        SEAM(pb + 3); }
#endif
        if (IN(pb + 4)) {
            pg8::Gemm g{F.A, F.Wffi + (size_t)L * 2 * DFF * DM, M, 2 * DFF, DM}; pg8::StaticOrder S; S.init(M, 2 * DFF, F.G, F.c);
            pg8::EpiSwiglu E{F.R1, DFF, F.RS};
#if defined(DBG_DUMB_GEMM) && (DBG_DUMB_GEMM & (1 << 5))
                dumb_gemm<2>(F, F.A, DM, F.w_ffn_in + (size_t)L * DM * 2 * DFF, 2 * DFF, DM, DFF, F.R1, DFF);
#else
#ifdef FFI_CHUNKS
            {
                const bf16* Bt = F.Wffi + (size_t)L * 2 * DFF * DM;
                { pg8::Gemm g1{F.A, Bt, M, 8 * 256, DM}; pg8::StaticOrder S1; S1.init(M, 8 * 256, F.G, F.c); pg8::EpiSwiglu E1{F.R1, DFF, F.RS};
                  pg8::gemm_phase<pg8::EpiSwiglu, pg8::StaticOrder, PG8_ALIGN, PG8_SP2>(F.lds + RING_OFF, g1, S1, E1, F.wave); }
                { pg8::Gemm g2{F.A, Bt + (size_t)8 * 256 * DM, M, 8 * 256, DM}; pg8::StaticOrder S2; S2.init(M, 8 * 256, F.G, F.c); pg8::EpiSwiglu E2{F.R1 + 8 * 128, DFF, F.RS};
                  pg8::gemm_phase<pg8::EpiSwiglu, pg8::StaticOrder, PG8_ALIGN, PG8_SP2>(F.lds + RING_OFF, g2, S2, E2, F.wave); }
                { pg8::Gemm g3{F.A, Bt + (size_t)16 * 256 * DM, M, 6 * 256, DM}; pg8::StaticOrder S3; S3.init(M, 6 * 256, F.G, F.c); pg8::EpiSwiglu E3{F.R1 + 16 * 128, DFF, F.RS};
                  pg8::gemm_phase<pg8::EpiSwiglu, pg8::StaticOrder, PG8_ALIGN, PG8_SP2>(F.lds + RING_OFF, g3, S3, E3, F.wave); }
            }
#else
            pg8::gemm_phase<pg8::EpiSwiglu, pg8::StaticOrder, PG8_ALIGN, PG8_SP2>(F.lds + RING_OFF, g, S, E, F.wave);
#endif
#endif
            SEAM(pb + 4);
        }
        if (IN(pb + 5)) {
            pg8::Gemm g{F.R1, F.Wffo + (size_t)L * DM * DFF, M, DM, DFF, 128, 32768}; pg8::StaticOrder S; S.init(M, DM, F.G, F.c);
            pg8::EpiBf16<0> E{F.Y, DM, nullptr, 0, 0, 1.f};
#if defined(DBG_DUMB_GEMM) && (DBG_DUMB_GEMM & (1 << 6))
                dumb_gemm<0>(F, F.R1, DFF, F.w_ffn_out + (size_t)L * DFF * DM, DM, DFF, DM, F.Y, DM);
#else
            pg8::gemm_phase<pg8::EpiBf16<0>, pg8::StaticOrder, PG8_ALIGN, PG8_SP2>(F.lds + RING_OFF, g, S, E, F.wave);
#endif
            SEAM(pb + 5);
        }
#ifndef NO_THIN
        if (IN(pb + 6)) { REFRESH(); if (L + 1 < DEPTH) { thin_phase<false, false>(F, gl + 3 * DM, dry); SEAM(pb + 6); } else thin_phase<false, true>(F, gl + 3 * DM, dry); }
#endif
    }
#ifdef PROBE_SEL
#ifndef PROBE_WG
#define PROBE_WG 0
#endif
    if (blockIdx.x == PROBE_WG && F.wave == 0) {
        LAS unsigned* pw = (LAS unsigned*)(F.lds + 131072 + 640);
        const unsigned long long c_tot = __builtin_amdgcn_s_memtime() - probe_c0, w_tot = __builtin_amdgcn_s_memrealtime() - probe_w0;
        unsigned long long cyc = 0;
        if (PROBE_SEL == 1) cyc = pw[41]; else if (PROBE_SEL == 2) cyc = pw[42]; else if (PROBE_SEL == 3) cyc = pw[43]; else if (PROBE_SEL >= 4 && PROBE_SEL < 96) cyc = pw[PROBE_SEL];
        else if (PROBE_SEL == 100) { for (int i = 0; i < 15; ++i) cyc += pw[16 + i]; }
        else if (PROBE_SEL == 101) { cyc = (unsigned long long)pw[16 + 0] + pw[16 + 2] + pw[16 + 4] + pw[16 + 5] + pw[16 + 7] + pw[16 + 9] + pw[16 + 11] + pw[16 + 12]; }
        else if (PROBE_SEL == 102) cyc = pw[16 + 1]; else if (PROBE_SEL == 103) cyc = pw[16 + 8];
        else if (PROBE_SEL == 104) { cyc = (unsigned long long)pw[16 + 3] + pw[16 + 6] + pw[16 + 10] + pw[16 + 13]; }
        else if (PROBE_SEL == 105) cyc = pw[16 + 14];
        else if (PROBE_SEL == 110) { for (int i = 0; i < 15; ++i) cyc += pw[48 + i]; }
        else if (PROBE_SEL == 111) { cyc = (unsigned long long)pw[48 + 0] + pw[48 + 2] + pw[48 + 4] + pw[48 + 5] + pw[48 + 7] + pw[48 + 9] + pw[48 + 11] + pw[48 + 12]; }
        unsigned long long spin_ticks;
        if (PROBE_SEL == 0) spin_ticks = (c_tot * 100ull / w_tot) * 400ull;
        else spin_ticks = cyc * w_tot / c_tot * 10ull;
        const unsigned long long w0 = __builtin_amdgcn_s_memrealtime();
        while (__builtin_amdgcn_s_memrealtime() - w0 < spin_ticks) __builtin_amdgcn_s_sleep(10);
    }
#endif
#undef IN
#undef SEAM
}

#ifndef MK_ONE_LAUNCH
#define MK_ONE_LAUNCH 1
#endif
extern "C" void kernel_launch(void* const* d_in, const int* in_sizes, int n_in, void* d_out, int out_size, void* d_ws, size_t ws_size, hipStream_t stream) {
    static int ready = 0;
    if (ready == 0) {
        if (n_in != 12 || in_sizes[0] != M * DM || out_size != M * DM || ws_size < WS_END) { fprintf(stderr, "kernel_launch: unexpected shapes (n_in %d, in0 %d, out %d, ws %zu)\n", n_in, n_in > 0 ? in_sizes[0] : -1, out_size, ws_size); ready = -1; return; }
        if (hipFuncSetAttribute((const void*)fwd_kernel, hipFuncAttributeMaxDynamicSharedMemorySize, LDS_BYTES) != hipSuccess) { fprintf(stderr, "kernel_launch: hipFuncSetAttribute failed\n"); ready = -1; return; }
        int per_cu = 0;
        if (hipOccupancyMaxActiveBlocksPerMultiprocessor(&per_cu, (const void*)fwd_kernel, NWAVES * 64, LDS_BYTES) != hipSuccess || per_cu < 1) fprintf(stderr, "kernel_launch: note: occupancy query reports %d blocks per CU\n", per_cu);
        (void)hipGetLastError();
        ready = 1;
    }
    if (ready < 0) return;
    if (hipMemsetAsync((char*)d_ws + WS_CTL, 0, CTL_ZERO_BYTES, stream) != hipSuccess) { fprintf(stderr, "kernel_launch: memset failed\n"); return; }
    Args a{};
    for (int i = 0; i < 12; ++i) a.in[i] = (const float*)d_in[i];
    a.out = (float*)d_out; a.ws = (unsigned char*)d_ws;
#if MK_ONE_LAUNCH
    a.ph_lo = 0; a.ph_hi = N_PHASES;
    hipLaunchKernelGGL(fwd_kernel, dim3(256), dim3(NWAVES * 64), LDS_BYTES, stream, a);
#else
    for (int k = 0; k < N_PHASES; ++k) {
#ifdef DBG_DUMB_SP
        if (k == 9 || k == 23) { a.ph_lo = 100; a.ph_hi = 101; hipLaunchKernelGGL(fwd_kernel, dim3(256), dim3(NWAVES * 64), LDS_BYTES, stream, a); }
#endif
#ifdef DUP_MASK
        { const int j = k == 0 ? 7 : (k - 1) % 7, L = k == 0 ? 0 : (k - 1) / 7; const bool idem = (j == 0 || j == 2 || j == 4 || j == 5 || (j == 1 && (L & 1) == 0) || j == 7);
          if ((DUP_MASK >> j) & 1) { if ((DUP_MASK >> 8) & 1) { if (j == 1 && (L & 1) == 0) goto nodup; } else if (j == 1 && (L & 1) == 1) goto nodup;
              a.ph_lo = idem ? k : k + 1000; a.ph_hi = a.ph_lo + 1; hipLaunchKernelGGL(fwd_kernel, dim3(256), dim3(NWAVES * 64), LDS_BYTES, stream, a); }
          nodup:; }
#endif
        a.ph_lo = k; a.ph_hi = k + 1; hipLaunchKernelGGL(fwd_kernel, dim3(256), dim3(NWAVES * 64), LDS_BYTES, stream, a); }
#endif
}
```
